# Optimizing an MI355X kernel written in HIP

```python
import jax, jax.numpy as jnp
from jax import lax
import numpy as np

D_MODEL = 2048
BATCH = 4
SEQ = 2048
DEPTH = 1

MIX_WIDTH = D_MODEL
RET_WIDTH = D_MODEL // 2
POOL_WIDTH = MIX_WIDTH - RET_WIDTH
RET_HEADS = 8
RET_HEAD_DIM = RET_WIDTH // RET_HEADS
CHUNK = 128
ROPE_BASE = 10000.0
POOL_WINDOWS = (2, 4, 8, 16)
POOL_GROUP = POOL_WIDTH // len(POOL_WINDOWS)
IN_WIDTH = 4 * RET_WIDTH + POOL_WIDTH
N_EXPERTS = 32
TOP_K = 4
D_FF = D_MODEL
SWIGLU_LIMIT = 7.0
SWIGLU_ALPHA = 1.702
LN_EPS = 1e-5
GN_EPS = 1e-6
DEEPNORM_ALPHA = (2.0 * DEPTH) ** 0.25
DEEPNORM_BETA = (8.0 * DEPTH) ** -0.25

kernel_name = "hybrid_retention_pool_moe_deepnorm"


def layer_norm(x, g, b):
    xf = x.astype(jnp.float32)
    mu = jnp.mean(xf, axis=-1, keepdims=True)
    xc = xf - mu
    var = jnp.mean(xc * xc, axis=-1, keepdims=True)
    y = xc * lax.rsqrt(var + LN_EPS) * g.astype(jnp.float32) + b.astype(jnp.float32)
    return y.astype(x.dtype)


def rotary(t, pos):
    half = t.shape[-1] // 2
    inv = ROPE_BASE ** (-jnp.arange(half, dtype=jnp.float32) / half)
    ang = pos.astype(jnp.float32)[:, None] * inv[None, :]
    cos = jnp.cos(ang)[None, :, None, :]
    sin = jnp.sin(ang)[None, :, None, :]
    t1, t2 = t[..., :half], t[..., half:]
    return jnp.concatenate([t1 * cos - t2 * sin, t1 * sin + t2 * cos], axis=-1)


def retention_chunkwise(q, k, v):
    B, S, H, dh = q.shape
    nc = S // CHUNK
    log_g = jnp.log(1.0 - 2.0 ** (-5.0 - jnp.arange(H, dtype=jnp.float32)))
    def to_chunks(t):
        return t.reshape(B, nc, CHUNK, H, dh).transpose(0, 3, 1, 2, 4)
    qc, kc, vc = to_chunks(q), to_chunks(k), to_chunks(v)
    idx = jnp.arange(CHUNK, dtype=jnp.float32)
    diff = idx[:, None] - idx[None, :]
    decay = jnp.where(diff[None] >= 0, jnp.exp(diff[None] * log_g[:, None, None]), 0.0)
    scores = jnp.einsum('bhncd,bhnmd->bhncm', qc, kc) * decay[None, :, None]
    y_in = jnp.einsum('bhncm,bhnme->bhnce', scores, vc)
    zeta = jnp.exp((CHUNK - 1.0 - idx)[None, :] * log_g[:, None])
    kv = jnp.einsum('bhncd,hc,bhnce->nbhde', kc, zeta, vc)
    g_chunk = jnp.exp(CHUNK * log_g)[None, :, None, None]
    def step(R, kv_n):
        return R * g_chunk + kv_n, R
    _, r_prev = lax.scan(step, jnp.zeros_like(kv[0]), kv)
    xi = jnp.exp((idx + 1.0)[None, :] * log_g[:, None])
    y_cross = jnp.einsum('bhncd,hc,nbhde->bhnce', qc, xi, r_prev)
    y = y_in + y_cross
    return y.transpose(0, 2, 3, 1, 4).reshape(B, S, H, dh)


def multiscale_pool(u, pool_w, pool_scale):
    B, S, _ = u.shape
    uf = u.astype(jnp.float32)
    cs = jnp.concatenate([jnp.zeros((B, 1, POOL_WIDTH), jnp.float32), jnp.cumsum(uf, axis=1)], axis=1)
    t = jnp.arange(S)
    outs = []
    for gi, w in enumerate(POOL_WINDOWS):
        lo_c, hi_c = gi * POOL_GROUP, (gi + 1) * POOL_GROUP
        c = cs[:, :, lo_c:hi_c]
        lower = jnp.concatenate([jnp.zeros((B, w - 1, POOL_GROUP), jnp.float32), c[:, :S + 1 - w]], axis=1)
        cnt = jnp.minimum(t + 1, w).astype(jnp.float32)[None, :, None]
        outs.append((c[:, 1:] - lower) / cnt - uf[:, :, lo_c:hi_c])
    p = jnp.stack(outs, axis=2)
    p = jnp.einsum('bsgc,gcd->bsgd', p, pool_w.astype(jnp.float32))
    return (p.reshape(B, S, POOL_WIDTH) * pool_scale.astype(jnp.float32)).astype(u.dtype)


def token_mixer(x, w_in, gn_gain, pool_w, pool_scale, w_out):
    B, S, _ = x.shape
    proj = x @ w_in
    q, k, v, g, u = jnp.split(proj, [RET_WIDTH, 2 * RET_WIDTH, 3 * RET_WIDTH, 4 * RET_WIDTH], axis=-1)
    pos = jnp.arange(S)
    shp = (B, S, RET_HEADS, RET_HEAD_DIM)
    qf = rotary(q.astype(jnp.float32).reshape(shp), pos)
    kf = rotary(k.astype(jnp.float32).reshape(shp), pos) * (RET_HEAD_DIM ** -0.5)
    vf = v.astype(jnp.float32).reshape(shp)
    y = retention_chunkwise(qf, kf, vf)
    mu = jnp.mean(y, axis=-1, keepdims=True)
    yc = y - mu
    y = yc * lax.rsqrt(jnp.mean(yc * yc, axis=-1, keepdims=True) + GN_EPS)
    y = y.reshape(B, S, RET_WIDTH) * gn_gain.astype(jnp.float32)
    ret_out = (jax.nn.silu(g.astype(jnp.float32)) * y).astype(x.dtype)
    pool_out = multiscale_pool(u, pool_w, pool_scale)
    mixed = jnp.concatenate([ret_out, pool_out], axis=-1)
    return mixed @ w_out


def moe_ffn(x, router_w, router_b, w_gate_up, b_gate_up, w_down, b_down):
    B, S, D = x.shape
    T = B * S
    h = x.reshape(T, D)
    logits = (h @ router_w).astype(jnp.float32) + router_b.astype(jnp.float32)
    top_vals, top_idx = lax.top_k(logits, TOP_K)
    gates = jax.nn.softmax(top_vals, axis=-1)
    flat_e = top_idx.reshape(-1)
    order = jnp.argsort(flat_e)
    tok = order // TOP_K
    e_sorted = flat_e[order]
    group_sizes = jnp.bincount(flat_e, length=N_EXPERTS).astype(jnp.int32)
    xs = h[tok]
    hgu = lax.ragged_dot(xs, w_gate_up, group_sizes) + b_gate_up[e_sorted]
    hgu = hgu.astype(jnp.float32)
    x_glu = jnp.minimum(hgu[:, 0::2], SWIGLU_LIMIT)
    x_lin = jnp.clip(hgu[:, 1::2], -SWIGLU_LIMIT, SWIGLU_LIMIT)
    act = (x_glu * jax.nn.sigmoid(SWIGLU_ALPHA * x_glu) * (x_lin + 1.0)).astype(x.dtype)
    out = lax.ragged_dot(act, w_down, group_sizes) + b_down[e_sorted]
    out = out * gates.reshape(-1)[order][:, None].astype(out.dtype)
    y = jnp.zeros((T, D), out.dtype).at[tok].add(out)
    return y.reshape(B, S, D)


def setup_inputs(seed: int = 0) -> dict:
    key = jax.random.key(seed)
    ks = jax.random.split(key, 16)
    f32 = jnp.float32
    nrm = lambda k, s: jax.random.normal(k, s, f32)
    return {
        "x": nrm(ks[0], (BATCH, SEQ, D_MODEL)),
        "w_in": nrm(ks[1], (DEPTH, D_MODEL, IN_WIDTH)) * D_MODEL ** -0.5,
        "ret_gn_gain": 1.0 + 0.02 * nrm(ks[2], (DEPTH, RET_WIDTH)),
        "pool_w": nrm(ks[3], (DEPTH, len(POOL_WINDOWS), POOL_GROUP, POOL_GROUP)) * POOL_GROUP ** -0.5,
        "pool_scale": 1.0 + 0.02 * nrm(ks[4], (DEPTH, POOL_WIDTH)),
        "w_out": nrm(ks[5], (DEPTH, MIX_WIDTH, D_MODEL)) * (MIX_WIDTH ** -0.5 * DEEPNORM_BETA),
        "ln1_g": 1.0 + 0.02 * nrm(ks[6], (DEPTH, D_MODEL)),
        "ln1_b": 0.02 * nrm(ks[7], (DEPTH, D_MODEL)),
        "router_w": nrm(ks[8], (DEPTH, D_MODEL, N_EXPERTS)) * D_MODEL ** -0.5,
        "router_b": 0.01 * nrm(ks[9], (DEPTH, N_EXPERTS)),
        "w_gate_up": nrm(ks[10], (DEPTH, N_EXPERTS, D_MODEL, 2 * D_FF)) * D_MODEL ** -0.5,
        "b_gate_up": 0.01 * nrm(ks[11], (DEPTH, N_EXPERTS, 2 * D_FF)),
        "w_down": nrm(ks[12], (DEPTH, N_EXPERTS, D_FF, D_MODEL)) * (D_FF ** -0.5 * DEEPNORM_BETA),
        "b_down": 0.01 * nrm(ks[13], (DEPTH, N_EXPERTS, D_MODEL)),
        "ln2_g": 1.0 + 0.02 * nrm(ks[14], (DEPTH, D_MODEL)),
        "ln2_b": 0.02 * nrm(ks[15], (DEPTH, D_MODEL)),
    }


def reference(x, w_in, ret_gn_gain, pool_w, pool_scale, w_out, ln1_g, ln1_b,
              router_w, router_b, w_gate_up, b_gate_up, w_down, b_down, ln2_g, ln2_b):
    h = x
    for l in range(DEPTH):
        mix = token_mixer(h, w_in[l], ret_gn_gain[l], pool_w[l], pool_scale[l], w_out[l])
        h = layer_norm(DEEPNORM_ALPHA * h + mix, ln1_g[l], ln1_b[l])
        ffn = moe_ffn(h, router_w[l], router_b[l], w_gate_up[l], b_gate_up[l], w_down[l], b_down[l])
        h = layer_norm(DEEPNORM_ALPHA * h + ffn, ln2_g[l], ln2_b[l])
    return h
```

```cpp
#include <hip/hip_runtime.h>
#include <cstdio>
#include <cstdint>
#include <cmath>
#define MOE_FP8 1
#define F8_SCALED 1
namespace pg8 {
#define PG8_LAS __attribute__((address_space(3)))
typedef unsigned short bf16_t;
typedef short bf16x8 __attribute__((ext_vector_type(8)));
typedef float f32x4 __attribute__((ext_vector_type(4)));
typedef float f32x2 __attribute__((ext_vector_type(2)));
typedef unsigned u32x4 __attribute__((ext_vector_type(4)));
typedef unsigned u32x2 __attribute__((ext_vector_type(2)));
constexpr int BM = 256, BK = 64, HALF = 128, HTB = HALF * BK * 2, STAGE_BYTES = 8 * HTB, NXCD = 8;
typedef int v8i32 __attribute__((ext_vector_type(8)));
typedef short v2i16 __attribute__((ext_vector_type(2)));
typedef int v4i32 __attribute__((ext_vector_type(4)));
typedef long v2i64 __attribute__((ext_vector_type(2)));
__device__ __forceinline__ v8i32 cat8(const bf16x8 a, const bf16x8 b) { return __builtin_shufflevector(__builtin_bit_cast(v4i32, a), __builtin_bit_cast(v4i32, b), 0, 1, 2, 3, 4, 5, 6, 7); }

__host__ __device__ __forceinline__ int lds_byte(int r, int c) { const int st = (r >> 4) * 2 + (c >> 5), rr = r & 15, cc = c & 31, ob = rr * 64 + cc * 2; return st * 1024 + (ob ^ (((ob >> 9) & 1) << 5)); }
__host__ __device__ __forceinline__ void stage_rc(int b, int& R, int& C) { const int st = b / 1024, sb = b % 1024, swz = sb ^ (((sb >> 9) & 1) << 5); R = (st >> 1) * 16 + swz / 64; C = (st & 1) * 32 + (swz % 64) / 2; }
__host__ __device__ __forceinline__ int perm32(int rho) { const int n = rho >> 4, i = rho & 15; return 8 * (i >> 2) + 4 * n + (i & 3); }

struct Unit { int pm, pn, e, lm, aux, hn, par; };

__device__ __forceinline__ int fresh_lane() { int l; asm volatile("v_mbcnt_lo_u32_b32 %0, -1, 0\n\tv_mbcnt_hi_u32_b32 %0, -1, %0" : "=v"(l)); return l; }
__device__ __forceinline__ unsigned cvt_pk_bf16(float lo, float hi) { unsigned r; asm volatile("v_cvt_pk_bf16_f32 %0, %1, %2" : "=v"(r) : "v"(lo), "v"(hi)); return r; }

__device__ __forceinline__ int xcd_remap(int L, int nwg) { const int q = nwg / NXCD, r = nwg % NXCD, xcd = L % NXCD, off = L / NXCD; return (xcd < r ? xcd * (q + 1) : r * (q + 1) + (xcd - r) * q) + off; }

template <class Epi, class Sched, bool ALIGN_EPI = true, bool F8 = false>
__device__ __forceinline__ void gemm_phase(PG8_LAS unsigned char* lds, int wid, const bf16_t* Abase, int lda, int acol0, int K, const Sched& S, const Epi& E) {
    const int lane = fresh_lane(), tid = wid * 64 + lane, wr = wid >> 2, wc = wid & 3, fr = lane & 15, fq = lane >> 4;
    const int nt = K / BK;
    int sR[2], sC[2]; unsigned voffB[2];
#pragma unroll
    for (int i = 0; i < 2; ++i) { stage_rc(tid * 16 + i * 8192, sR[i], sC[i]); const int Rb = Epi::PERM ? ((sR[i] & ~31) + perm32(sR[i] & 31)) : sR[i];
        voffB[i] = (unsigned)(Rb * K + sC[i]) * 2u; }
    const size_t kstep = (size_t)(BK * 2);
    const size_t hstepB = (size_t)HALF * K * 2;
    const unsigned ldsw = (unsigned)wid * 1024u;
    const int aoff = lds_byte(wr * 64 + fr, fq * 8), boff = lds_byte(wc * 32 + fr, fq * 8);
#define PG8_SA(b, h) (((b) * 2 + (h)) * HTB)
#define PG8_SB(b, h) ((4 + (b) * 2 + (h)) * HTB)
#define PG8_STAGE(bufoff, gbase, voff) do { _Pragma("unroll") for (int _i = 0; _i < 2; ++_i) \
        __builtin_amdgcn_global_load_lds((const unsigned*)((const char*)(gbase) + (voff)[_i]), (PG8_LAS unsigned*)(lds + (bufoff) + ldsw + _i * 8192), 16, 0, 0); } while (0)
#ifndef PG8_A_AUX
#define PG8_A_AUX 0
#endif
#define PG8_STAGE_A(bufoff, gbase, voff) do { _Pragma("unroll") for (int _i = 0; _i < 2; ++_i) \
        __builtin_amdgcn_global_load_lds((const unsigned*)((const char*)(gbase) + (voff)[_i]), (PG8_LAS unsigned*)(lds + (bufoff) + ldsw + _i * 8192), 16, 0, PG8_A_AUX); } while (0)
#define PG8_STAGEX(bufoff, gbase, voff) do { if constexpr (F8) { _Pragma("unroll") for (int _i = 0; _i < 2; ++_i) { unsigned _m0s; \
        asm volatile("s_mov_b32 %0, m0\n\ts_mov_b32 m0, %3\n\ts_nop 0\n\tglobal_load_lds_dwordx4 %1, %2\n\ts_mov_b32 m0, %0" : "=&s"(_m0s) : "v"((voff)[_i]), "s"(gbase), "s"((unsigned)(size_t)lds + ldsw + (unsigned)((bufoff) + _i * 8192)) : "memory"); } } \
        else PG8_STAGE(bufoff, gbase, voff); } while (0)
#define PG8_MMA_X(ai, bj, At, Bt) do { if constexpr (!(ABL & 1)) PG8_MMA(ai, bj, At, Bt); } while (0)
#define PG8_LDA_X(dst, b, h) do { if constexpr (!(ABL & 8)) PG8_LDA(dst, b, h); } while (0)
#define PG8_LDB_X(dst, b, h) do { if constexpr (!(ABL & 8)) PG8_LDB(dst, b, h); } while (0)
#define PG8_STAGE_AX(bufoff, gbase, voff) do { if constexpr (!(ABL & 4)) PG8_STAGE_A(bufoff, gbase, voff); } while (0)
#define PG8_LDA(dst, b, h) do { _Pragma("unroll") for (int m = 0; m < 4; ++m) _Pragma("unroll") for (int k = 0; k < 2; ++k) dst[m][k] = *(const PG8_LAS bf16x8*)(lds + PG8_SA(b, h) + aoff + m * 2048 + k * 1024); } while (0)
#define PG8_LDB(dst, b, h) do { _Pragma("unroll") for (int n = 0; n < 2; ++n) _Pragma("unroll") for (int k = 0; k < 2; ++k) dst[n][k] = *(const PG8_LAS bf16x8*)(lds + PG8_SB(b, h) + boff + n * 2048 + k * 1024); } while (0)
#define PG8_MMA(ai, bj, At, Bt) do { __builtin_amdgcn_s_setprio(1); _Pragma("unroll") for (int m = 0; m < 4; ++m) _Pragma("unroll") for (int n = 0; n < 2; ++n) _Pragma("unroll") for (int k = 0; k < 2; ++k) \
        acc[ai][bj][m][n] = __builtin_amdgcn_mfma_f32_16x16x32_bf16(Bt[n][k], At[m][k], acc[ai][bj][m][n], 0, 0, 0); __builtin_amdgcn_s_setprio(0); } while (0)
#define PG8_MMAF(ai, bj, At, Bt) do { if constexpr (F8) { __builtin_amdgcn_s_setprio(1); _Pragma("unroll") for (int m = 0; m < 4; ++m) _Pragma("unroll") for (int n = 0; n < 2; ++n) \
        acc[ai][bj][m][n] = __builtin_amdgcn_mfma_scale_f32_16x16x128_f8f6f4(cat8(Bt[n][0], Bt[n][1]), cat8(At[m][0], At[m][1]), acc[ai][bj][m][n], 0, 0, 0, 0x7f7f7f7f, 0, 0x7f7f7f7f); \
        __builtin_amdgcn_s_setprio(0); } else PG8_MMA(ai, bj, At, Bt); } while (0)
#define PG8_WAIT_V(n) asm volatile("s_waitcnt vmcnt(" #n ")" ::: "memory")
#define PG8_WAIT_L(n) asm volatile("s_waitcnt lgkmcnt(" #n ")" ::: "memory")
#define PG8_BAR __builtin_amdgcn_s_barrier()
#define PG8_SCHED __builtin_amdgcn_sched_barrier(0)
#define PG8_AOFF0(dst, u) do { _Pragma("unroll") for (int _h = 0; _h < 2; ++_h) _Pragma("unroll") for (int _i = 0; _i < 2; ++_i) \
        dst[_h][_i] = (unsigned)(S.arow0(u, _h * HALF + sR[_i]) * lda + acol0 + sC[_i]) * 2u; } while (0)
#define PG8_AOFF1(dst, u, par) do { _Pragma("unroll") for (int _h = 0; _h < 2; ++_h) _Pragma("unroll") for (int _i = 0; _i < 2; ++_i) \
        dst[_h][_i] = (unsigned)(S.arow1(u, _h * HALF + sR[_i], par, lds) * lda + acol0 + sC[_i]) * 2u; } while (0)
    Unit cur, nxt; int ui = 0;
    if (!S.next(0, cur)) return;
    f32x4 acc[2][2][4][2];
#pragma unroll
    for (int a = 0; a < 2; ++a)
#pragma unroll
        for (int b = 0; b < 2; ++b)
#pragma unroll
            for (int m = 0; m < 4; ++m)
#pragma unroll
                for (int n = 0; n < 2; ++n) acc[a][b][m][n] = (f32x4){0.f, 0.f, 0.f, 0.f};
    bf16x8 At[4][2], B0[2][2], B1[2][2];
    unsigned va[2][2], vn[2][2];
    PG8_AOFF0(va, cur);
    const char* const cA = (const char*)Abase;
    const char* cB = S.bbase(cur);
    PG8_STAGEX(PG8_SB(0, 0), cB, voffB); PG8_STAGEX(PG8_SB(0, 1), cB + hstepB, voffB); PG8_STAGEX(PG8_SA(0, 0), cA, va[0]); PG8_STAGEX(PG8_SA(0, 1), cA, va[1]);
    if (wr == 1) PG8_BAR;
    PG8_WAIT_V(2); PG8_BAR;
    PG8_STAGEX(PG8_SB(1, 0), cB + kstep, voffB); PG8_STAGEX(PG8_SA(1, 0), cA + kstep, va[0]); PG8_STAGEX(PG8_SB(1, 1), cB + hstepB + kstep, voffB);
    PG8_WAIT_V(6); PG8_BAR;
    for (;;) {
        const bool has_next = S.next(ui + 1, nxt);
        const char* nB = cB;
        if (has_next) { nB = S.bbase(nxt); S.prefetch(nxt, ui & 1, lds, wid, lane); }
#pragma unroll
        for (int h = 0; h < 2; ++h)
#pragma unroll
            for (int i = 0; i < 2; ++i) vn[h][i] = va[h][i];
#pragma unroll 1
        for (int t = 0; t < nt; t += 2) {
            const bool last = (t == nt - 2);
            const char* a1 = cA + (size_t)(t + 1) * kstep;
            const char* a2 = last ? cA : cA + (size_t)(t + 2) * kstep; const char* b2 = last ? nB : cB + (size_t)(t + 2) * kstep;
            const char* a3 = a2 + kstep; const char* b3 = b2 + kstep;
            if (last && has_next) PG8_AOFF1(vn, nxt, ui & 1);
            unsigned w0[2], w1[2];
            w0[0] = last ? vn[0][0] : va[0][0]; w0[1] = last ? vn[0][1] : va[0][1]; w1[0] = last ? vn[1][0] : va[1][0]; w1[1] = last ? vn[1][1] : va[1][1];
            PG8_LDB(B0, 0, 0); PG8_LDB(B1, 0, 1); PG8_SCHED; PG8_LDA(At, 0, 0); PG8_STAGEX(PG8_SA(1, 1), a1, va[1]);
            PG8_WAIT_V(8); PG8_WAIT_L(0); PG8_BAR; PG8_MMAF(0, 0, At, B0); PG8_MMAF(0, 1, At, B1); PG8_BAR; PG8_SCHED;
            PG8_LDA(At, 0, 1); PG8_STAGEX(PG8_SB(0, 0), b2, voffB); PG8_STAGEX(PG8_SB(0, 1), b2 + hstepB, voffB); PG8_STAGEX(PG8_SA(0, 0), a2, w0);
            PG8_WAIT_V(8); PG8_WAIT_L(0); PG8_BAR; PG8_MMAF(1, 0, At, B0); PG8_MMAF(1, 1, At, B1); PG8_BAR; PG8_SCHED;
            PG8_LDB(B0, 1, 0); PG8_LDB(B1, 1, 1); PG8_SCHED; PG8_LDA(At, 1, 0); PG8_STAGEX(PG8_SA(0, 1), a2, w1);
            PG8_WAIT_V(8); PG8_WAIT_L(0); PG8_BAR; PG8_MMAF(0, 0, At, B0); PG8_MMAF(0, 1, At, B1); PG8_BAR; PG8_SCHED;
            PG8_LDA(At, 1, 1); PG8_STAGEX(PG8_SB(1, 0), b3, voffB); PG8_STAGEX(PG8_SB(1, 1), b3 + hstepB, voffB); PG8_STAGEX(PG8_SA(1, 0), a3, w0);
            PG8_WAIT_V(8); PG8_WAIT_L(0); PG8_BAR; PG8_MMAF(1, 0, At, B0); PG8_MMAF(1, 1, At, B1); PG8_BAR; PG8_SCHED;
        }
        if constexpr (ALIGN_EPI) { if (wr == 0) PG8_BAR; }
        asm volatile("s_nop 15\n\ts_nop 15" : "+v"(acc[1][1][3][1]), "+v"(acc[1][0][3][1]));
        E(acc, cur, wr, wc, fr, fq);
        if (!has_next) break;
#pragma unroll
        for (int a = 0; a < 2; ++a)
#pragma unroll
            for (int b = 0; b < 2; ++b)
#pragma unroll
                for (int m = 0; m < 4; ++m)
#pragma unroll
                    for (int n = 0; n < 2; ++n) acc[a][b][m][n] = (f32x4){0.f, 0.f, 0.f, 0.f};
        cur = nxt; cB = nB; ++ui;
#pragma unroll
        for (int h = 0; h < 2; ++h)
#pragma unroll
            for (int i = 0; i < 2; ++i) va[h][i] = vn[h][i];
        if constexpr (ALIGN_EPI) { if (wr == 1) PG8_BAR; }
    }
    PG8_WAIT_V(0);
    if constexpr (!ALIGN_EPI) { if (wr == 0) PG8_BAR; }
    PG8_BAR;

}
__device__ __forceinline__ __amdgpu_buffer_rsrc_t make_rsrc_uniform(const char* p, int bytes) {
    const unsigned long long a = (unsigned long long)p;
    const unsigned lo = __builtin_amdgcn_readfirstlane((unsigned)a), hi = __builtin_amdgcn_readfirstlane((unsigned)(a >> 32));
    return __builtin_amdgcn_make_buffer_rsrc((void*)(((unsigned long long)hi << 32) | lo), 0, bytes, 0x00020000);
}
__device__ __forceinline__ unsigned cvt_pk_bf16_nv(float lo, float hi) { unsigned r; asm("v_cvt_pk_bf16_f32 %0, %1, %2" : "=v"(r) : "v"(lo), "v"(hi)); return r; }
template <class Epi, class Sched, bool WB = false, int ABL = 0>
__device__ __forceinline__ void gemm_phase_f32b(PG8_LAS unsigned char* lds, int wid, const bf16_t* Abase, int lda, int K, int N, const Sched& S, const Epi& E) {
    static_assert(Epi::PERM, "f32-B body: PERM epilogues only");
    const int lane = fresh_lane(), tid = wid * 64 + lane, wr = wid >> 2, wc = wid & 3, fr = lane & 15, fq = lane >> 4;
    const int nt = K / BK;
    const int acol0 = 0;
    const size_t kstep = (size_t)(BK * 2);
    const unsigned ldsw = (unsigned)wid * 1024u;
    const int aoff = lds_byte(wr * 64 + fr, fq * 8), boff = lds_byte(wc * 32 + fr, fq * 8);
    const int n4 = (lane & 15) + 16 * (wid & 3), kq = (lane >> 4) + 4 * (wid >> 2);
    const unsigned vb = (unsigned)(kq * 8 * N + 4 * n4) * 4u;
    const int browb = N * 4, bkstep = BK * browb;
    const int tline = wid * 16 + (lane & 15);
    const unsigned vtouch = (unsigned)((tid >> 3) * browb + (tid & 7) * 128);
    const int bn = 4 * n4, brow0 = ((bn & 127) & ~31) + (((n4 & 1) << 4) | (((n4 & 7) >> 1) << 2));
    const int wb0 = (bn >> 7) * HTB + lds_byte(brow0, kq * 8);
    const unsigned wbaddr = (unsigned)(size_t)lds + (unsigned)wb0;
    const unsigned vwb = (unsigned)((4 * n4) * K + kq * 8) * 2u;
    Unit cur, nxt; int ui = 0;
    if (!S.next(0, cur)) return;
    f32x4 acc[2][2][4][2];
#pragma unroll
    for (int a = 0; a < 2; ++a)
#pragma unroll
        for (int b = 0; b < 2; ++b)
#pragma unroll
            for (int m = 0; m < 4; ++m)
#pragma unroll
                for (int n = 0; n < 2; ++n) acc[a][b][m][n] = (f32x4){0.f, 0.f, 0.f, 0.f};
    bf16x8 At[4][2], B0[2][2], B1[2][2];
    f32x4 RB[8];
    unsigned va[2][2];
    { int sR[2], sC[2];
_Pragma("unroll") for (int i = 0; i < 2; ++i) stage_rc(tid * 16 + i * 8192, sR[i], sC[i]);
      PG8_AOFF0(va, cur); }
    const char* const cA = (const char*)Abase;
    const char* cB = S.bbase(cur);
    __amdgpu_buffer_rsrc_t rC = make_rsrc_uniform(cB, K * browb), rN = rC;
    __amdgpu_buffer_rsrc_t wC = rC, wN = rC;
    if constexpr (WB) { wC = make_rsrc_uniform(S.wbbase(cur), 256 * K * 2); wN = wC; }
#define PG8_LOADB(rs, so) do { if constexpr (ABL & 2) break; _Pragma("unroll") for (int _j = 0; _j < 8; ++_j) { \
        if constexpr (ABL & 128) asm volatile("buffer_load_dword %0, %1, %2, %3 offen" : "=v"(RB[_j][0]) : "v"(vb), "s"(rs), "s"((so) + _j * browb) : "memory"); \
        else if constexpr (ABL & 256) asm volatile("buffer_load_dwordx4 %0, %1, %2, %3 offen" : "=v"(RB[_j]) : "v"(0u), "s"(rs), "s"((so) + _j * browb) : "memory"); \
        else asm volatile("buffer_load_dwordx4 %0, %1, %2, %3 offen" : "=v"(RB[_j]) : "v"(vb), "s"(rs), "s"((so) + _j * browb) : "memory"); } } while (0)
#define PG8_TOUCH(rs, so, q) do { if (lane < 16) { const unsigned _vt = (unsigned)((((q) * 128 + tline) >> 3) * browb + (((q) * 128 + tline) & 7) * 128); \
        asm volatile("buffer_load_dword %0, %1, %2, %3 offen" : "+v"(touchreg) : "v"(_vt), "s"(rs), "s"(so) : "memory"); } } while (0)
#define PG8_WAITB(n) asm volatile("s_waitcnt vmcnt(" #n ")" : "+v"(RB[0]), "+v"(RB[1]), "+v"(RB[2]), "+v"(RB[3]), "+v"(RB[4]), "+v"(RB[5]), "+v"(RB[6]), "+v"(RB[7]) :: "memory")
#define PG8_WRITEB(b, wrs, wso) do { if constexpr (ABL & 16) break; _Pragma("unroll") for (int _i = 0; _i < 4; ++_i) { u32x4 _w; _w.x = cvt_pk_bf16_nv(RB[0][_i], RB[1][_i]); _w.y = cvt_pk_bf16_nv(RB[2][_i], RB[3][_i]); \
        _w.z = cvt_pk_bf16_nv(RB[4][_i], RB[5][_i]); _w.w = cvt_pk_bf16_nv(RB[6][_i], RB[7][_i]); \
        asm volatile("ds_write_b128 %0, %1 offset:%2" :: "v"(wbaddr + PG8_SB(b, 0)), "v"(_w), "n"(64 * _i) : "memory"); \
        if constexpr (WB) asm volatile("buffer_store_dwordx4 %0, %1, %2, %3 offen" :: "v"(_w), "v"(vwb), "s"(wrs), "s"(wso + _i * K * 2) : "memory"); } } while (0)
    PG8_LOADB(rC, 0); PG8_STAGE_AX(PG8_SA(0, 0), cA, va[0]); PG8_STAGE_AX(PG8_SA(0, 1), cA, va[1]);
    PG8_WAITB(4); PG8_WRITEB(0, wC, 0);
    PG8_STAGE_AX(PG8_SA(1, 0), cA + kstep, va[0]); PG8_LOADB(rC, bkstep);
    if (wr == 1) PG8_BAR;
    if constexpr (WB) PG8_WAIT_V(14); else PG8_WAIT_V(10); PG8_WAIT_L(0); PG8_BAR;
    PG8_BAR;
    for (;;) {
        const bool has_next = S.next(ui + 1, nxt);
        rN = rC; wN = wC;
        if (has_next) { rN = make_rsrc_uniform(S.bbase(nxt), K * browb); if constexpr (WB) wN = make_rsrc_uniform(S.wbbase(nxt), 256 * K * 2); S.prefetch(nxt, ui & 1, lds, wid, lane); }
#pragma unroll 1
        for (int t = 0; t < nt; t += 2) {
            const bool last = (t == nt - 2);
            const char* a1 = cA + (size_t)(t + 1) * kstep;
            const char* a2 = last ? cA : cA + (size_t)(t + 2) * kstep; const char* a3 = a2 + kstep;
            const __amdgpu_buffer_rsrc_t r2 = last ? rN : rC; const int so2 = last ? 0 : (t + 2) * bkstep;
            const __amdgpu_buffer_rsrc_t w2 = last ? wN : wC; const int wso2 = last ? 0 : (t + 2) * (BK * 2);
            PG8_LDB_X(B0, 0, 0); PG8_LDB_X(B1, 0, 1); PG8_SCHED; PG8_LDA_X(At, 0, 0); if constexpr (!(ABL & 64)) PG8_STAGE_AX(PG8_SA(1, 1), a1, va[1]);
            if (last && has_next) { int sR[2], sC[2]; const int tz = wid * 64 + fresh_lane(); _Pragma("unroll") for (int i = 0; i < 2; ++i) stage_rc(tz * 16 + i * 8192, sR[i], sC[i]); PG8_AOFF1(va, nxt, ui & 1); }
            if constexpr (WB) PG8_WAIT_V(16); else PG8_WAIT_V(12);
            PG8_WAIT_L(0); PG8_BAR; PG8_MMA_X(0, 0, At, B0); PG8_MMA_X(0, 1, At, B1); PG8_BAR; PG8_SCHED;
            PG8_LDA_X(At, 0, 1); PG8_WAITB(2); PG8_WRITEB(1, wC, (t + 1) * (BK * 2)); PG8_STAGE_AX(PG8_SA(0, 0), a2, va[0]); PG8_LOADB(r2, so2);
            PG8_WAIT_L(0); PG8_BAR; PG8_MMA_X(1, 0, At, B0); PG8_MMA_X(1, 1, At, B1); PG8_BAR; PG8_SCHED;
            PG8_LDB_X(B0, 1, 0); PG8_LDB_X(B1, 1, 1); PG8_SCHED; PG8_LDA_X(At, 1, 0); if constexpr (!(ABL & 64)) PG8_STAGE_AX(PG8_SA(0, 1), a2, va[1]);
            if constexpr (WB) PG8_WAIT_V(16); else PG8_WAIT_V(12);
            PG8_WAIT_L(0); PG8_BAR; PG8_MMA_X(0, 0, At, B0); PG8_MMA_X(0, 1, At, B1); PG8_BAR; PG8_SCHED;
            PG8_LDA_X(At, 1, 1); PG8_WAITB(2); PG8_WRITEB(0, w2, wso2); PG8_STAGE_AX(PG8_SA(1, 0), a3, va[0]); PG8_LOADB(r2, so2 + bkstep);
            PG8_WAIT_L(0); PG8_BAR; PG8_MMA_X(1, 0, At, B0); PG8_MMA_X(1, 1, At, B1); PG8_BAR; PG8_SCHED;
        }
        if (wr == 0) PG8_BAR;
        asm volatile("s_nop 15\n\ts_nop 15" : "+v"(acc[1][1][3][1]), "+v"(acc[1][0][3][1]));
        if constexpr (!(ABL & 32)) E(acc, cur, wr, wc, fr, fq);
        if (!has_next) break;
#pragma unroll
        for (int a = 0; a < 2; ++a)
#pragma unroll
            for (int b = 0; b < 2; ++b)
#pragma unroll
                for (int m = 0; m < 4; ++m)
#pragma unroll
                    for (int n = 0; n < 2; ++n) acc[a][b][m][n] = (f32x4){0.f, 0.f, 0.f, 0.f};
        cur = nxt; rC = rN; wC = wN; ++ui;
        S.round_sync(ui, wid, lane);
        if (wr == 1) PG8_BAR;
    }
    PG8_WAIT_V(0);
    asm volatile("" :: "v"(RB[0]), "v"(RB[1]), "v"(RB[2]), "v"(RB[3]), "v"(RB[4]), "v"(RB[5]), "v"(RB[6]), "v"(RB[7]));
    PG8_BAR;
#undef PG8_LOADB
#undef PG8_WAITB
#undef PG8_TOUCH
#undef PG8_TOUCH
#undef PG8_WRITEB
}

template <class Epi, class Sched>
__device__ __forceinline__ void gemm_phase_f32b_half(PG8_LAS unsigned char* lds, int wid, const bf16_t* Abase, int lda, int K, int N, const Sched& S, const Epi& E) {
    static_assert(Epi::PERM, "f32-B body: PERM epilogues only");
    const int lane = fresh_lane(), tid = wid * 64 + lane, wr = wid >> 2, wc = wid & 3, fr = lane & 15, fq = lane >> 4;
    const int nt = K / BK;
    const int acol0 = 0;
    const size_t kstep = (size_t)(BK * 2);
    const unsigned ldsw = (unsigned)wid * 1024u;
    const int aoff = lds_byte(wr * 64 + fr, fq * 8), boff = lds_byte(wc * 32 + fr, fq * 8);
    const int n4 = (lane & 15) + 16 * (wid & 1), kq = (lane >> 4) + 4 * (wid >> 1);
    const unsigned vb = (unsigned)(kq * 4 * N + 4 * n4) * 4u;
    const int browb = N * 4, bkstep = BK * browb;
    const int bn = 4 * n4, brow0 = (bn & ~31) + (((n4 & 1) << 4) | (((n4 & 7) >> 1) << 2));
    const unsigned wbaddr = (unsigned)(size_t)lds + (unsigned)lds_byte(brow0, kq * 4);
    Unit cur, nxt; int ui = 0;
    if (!S.next(0, cur)) return;
    f32x4 acc[2][2][4][2];
#pragma unroll
    for (int a = 0; a < 2; ++a)
#pragma unroll
        for (int b = 0; b < 2; ++b)
#pragma unroll
            for (int m = 0; m < 4; ++m)
#pragma unroll
                for (int n = 0; n < 2; ++n) acc[a][b][m][n] = (f32x4){0.f, 0.f, 0.f, 0.f};
    bf16x8 At[4][2], B0[2][2];
    f32x4 RB[4];
    unsigned va[2][2];
    { int sR[2], sC[2];
_Pragma("unroll") for (int i = 0; i < 2; ++i) stage_rc(tid * 16 + i * 8192, sR[i], sC[i]);
      PG8_AOFF0(va, cur); }
    const char* const cA = (const char*)Abase;
    __amdgpu_buffer_rsrc_t rC = make_rsrc_uniform(S.bbase(cur), K * browb), rN = rC;
#define PG8_HLOADB(rs, so) do { _Pragma("unroll") for (int _j = 0; _j < 4; ++_j) asm volatile("buffer_load_dwordx4 %0, %1, %2, %3 offen" : "=v"(RB[_j]) : "v"(vb), "s"(rs), "s"((so) + _j * browb) : "memory"); } while (0)
#define PG8_HWAITB(n) asm volatile("s_waitcnt vmcnt(" #n ")" : "+v"(RB[0]), "+v"(RB[1]), "+v"(RB[2]), "+v"(RB[3]) :: "memory")
#define PG8_HWRITEB(b) do { _Pragma("unroll") for (int _i = 0; _i < 4; ++_i) { u32x2 _w; _w.x = cvt_pk_bf16_nv(RB[0][_i], RB[1][_i]); _w.y = cvt_pk_bf16_nv(RB[2][_i], RB[3][_i]); \
        asm volatile("ds_write_b64 %0, %1 offset:%2" :: "v"(wbaddr + PG8_SB(b, 0)), "v"(_w), "n"(64 * _i) : "memory"); } } while (0)
    PG8_HLOADB(rC, 0); PG8_STAGE_A(PG8_SA(0, 0), cA, va[0]); PG8_STAGE_A(PG8_SA(0, 1), cA, va[1]);
    PG8_HWAITB(4); PG8_HWRITEB(0);
    PG8_STAGE_A(PG8_SA(1, 0), cA + kstep, va[0]); PG8_HLOADB(rC, bkstep);
    if (wr == 1) PG8_BAR;
    PG8_WAIT_V(6); PG8_WAIT_L(0); PG8_BAR;
    PG8_BAR;
    for (;;) {
        const bool has_next = S.next(ui + 1, nxt);
        rN = rC;
        if (has_next) { rN = make_rsrc_uniform(S.bbase(nxt), K * browb); S.prefetch(nxt, ui & 1, lds, wid, lane); }
#pragma unroll 1
        for (int t = 0; t < nt; t += 2) {
            const bool last = (t == nt - 2);
            const char* a1 = cA + (size_t)(t + 1) * kstep;
            const char* a2 = last ? cA : cA + (size_t)(t + 2) * kstep; const char* a3 = a2 + kstep;
            const __amdgpu_buffer_rsrc_t r2 = last ? rN : rC; const int so2 = last ? 0 : (t + 2) * bkstep;
            PG8_LDB(B0, 0, 0); PG8_SCHED; PG8_LDA(At, 0, 0); PG8_STAGE_A(PG8_SA(1, 1), a1, va[1]);
            if (last && has_next) { int sR[2], sC[2]; const int tz = wid * 64 + fresh_lane(); _Pragma("unroll") for (int i = 0; i < 2; ++i) stage_rc(tz * 16 + i * 8192, sR[i], sC[i]); PG8_AOFF1(va, nxt, ui & 1); }
            PG8_WAIT_V(8); PG8_WAIT_L(0); PG8_BAR; PG8_MMA(0, 0, At, B0); PG8_BAR; PG8_SCHED;
            PG8_LDA(At, 0, 1); PG8_HWAITB(2); PG8_HWRITEB(1); PG8_STAGE_A(PG8_SA(0, 0), a2, va[0]); PG8_HLOADB(r2, so2);
            PG8_WAIT_L(0); PG8_BAR; PG8_MMA(1, 0, At, B0); PG8_BAR; PG8_SCHED;
            PG8_LDB(B0, 1, 0); PG8_SCHED; PG8_LDA(At, 1, 0); PG8_STAGE_A(PG8_SA(0, 1), a2, va[1]);
            PG8_WAIT_V(8); PG8_WAIT_L(0); PG8_BAR; PG8_MMA(0, 0, At, B0); PG8_BAR; PG8_SCHED;
            PG8_LDA(At, 1, 1); PG8_HWAITB(2); PG8_HWRITEB(0); PG8_STAGE_A(PG8_SA(1, 0), a3, va[0]); PG8_HLOADB(r2, so2 + bkstep);
            PG8_WAIT_L(0); PG8_BAR; PG8_MMA(1, 0, At, B0); PG8_BAR; PG8_SCHED;
        }
        if (wr == 0) PG8_BAR;
        asm volatile("s_nop 15\n\ts_nop 15" : "+v"(acc[1][1][3][1]), "+v"(acc[1][0][3][1]));
        E.half(acc, cur, wr, wc, fr, fq);
        if (!has_next) break;
#pragma unroll
        for (int a = 0; a < 2; ++a)
#pragma unroll
            for (int m = 0; m < 4; ++m)
#pragma unroll
                for (int n = 0; n < 2; ++n) acc[a][0][m][n] = (f32x4){0.f, 0.f, 0.f, 0.f};
        cur = nxt; rC = rN; ++ui;
        if (wr == 1) PG8_BAR;
    }
    PG8_WAIT_V(0);
    asm volatile("" :: "v"(RB[0]), "v"(RB[1]), "v"(RB[2]), "v"(RB[3]));
    PG8_BAR;
#undef PG8_HLOADB
#undef PG8_HWAITB
#undef PG8_HWRITEB
}
template <class Epi, class Sched, bool F8 = false>
__device__ __forceinline__ void gemm_phase_half(PG8_LAS unsigned char* lds, int wid, const bf16_t* Abase, int lda, int acol0, int K, const Sched& S, const Epi& E) {
    const int lane = fresh_lane(), tid = wid * 64 + lane, wr = wid >> 2, wc = wid & 3, fr = lane & 15, fq = lane >> 4;
    const int nt = K / BK;
    int sR[2], sC[2]; unsigned voffB[2];
#pragma unroll
    for (int i = 0; i < 2; ++i) { stage_rc(tid * 16 + i * 8192, sR[i], sC[i]); const int Rb = Epi::PERM ? ((sR[i] & ~31) + perm32(sR[i] & 31)) : sR[i];
        voffB[i] = (unsigned)(Rb * K + sC[i]) * 2u; }
    const size_t kstep = (size_t)(BK * 2);
    const unsigned ldsw = (unsigned)wid * 1024u;
    const int aoff = lds_byte(wr * 64 + fr, fq * 8), boff = lds_byte(wc * 32 + fr, fq * 8);
    Unit cur, nxt; int ui = 0;
    if (!S.next(0, cur)) return;
    f32x4 acc[2][2][4][2];
#pragma unroll
    for (int a = 0; a < 2; ++a)
#pragma unroll
        for (int b = 0; b < 2; ++b)
#pragma unroll
            for (int m = 0; m < 4; ++m)
#pragma unroll
                for (int n = 0; n < 2; ++n) acc[a][b][m][n] = (f32x4){0.f, 0.f, 0.f, 0.f};
    bf16x8 At[4][2], B0[2][2];
    unsigned va[2][2], vn[2][2];
    PG8_AOFF0(va, cur);
    const char* const cA = (const char*)Abase;
    const char* cB = S.bbase(cur);
    PG8_STAGEX(PG8_SB(0, 0), cB, voffB); PG8_STAGEX(PG8_SA(0, 0), cA, va[0]); PG8_STAGEX(PG8_SA(0, 1), cA, va[1]);
    if (wr == 1) PG8_BAR;
    PG8_WAIT_V(2); PG8_BAR;
    PG8_STAGEX(PG8_SB(1, 0), cB + kstep, voffB); PG8_STAGEX(PG8_SA(1, 0), cA + kstep, va[0]);
    PG8_WAIT_V(4); PG8_BAR;
    for (;;) {
        const bool has_next = S.next(ui + 1, nxt);
        const char* nB = cB;
        if (has_next) { nB = S.bbase(nxt); S.prefetch(nxt, ui & 1, lds, wid, lane); }
#pragma unroll
        for (int h = 0; h < 2; ++h)
#pragma unroll
            for (int i = 0; i < 2; ++i) vn[h][i] = va[h][i];
#pragma unroll 1
        for (int t = 0; t < nt; t += 2) {
            const bool last = (t == nt - 2);
            const char* a1 = cA + (size_t)(t + 1) * kstep;
            const char* a2 = last ? cA : cA + (size_t)(t + 2) * kstep; const char* b2 = last ? nB : cB + (size_t)(t + 2) * kstep;
            const char* a3 = a2 + kstep; const char* b3 = b2 + kstep;
            if (last && has_next) PG8_AOFF1(vn, nxt, ui & 1);
            unsigned w0[2], w1[2];
            w0[0] = last ? vn[0][0] : va[0][0]; w0[1] = last ? vn[0][1] : va[0][1]; w1[0] = last ? vn[1][0] : va[1][0]; w1[1] = last ? vn[1][1] : va[1][1];
            PG8_LDB(B0, 0, 0); PG8_SCHED; PG8_LDA(At, 0, 0); PG8_STAGEX(PG8_SA(1, 1), a1, va[1]);
            PG8_WAIT_V(6); PG8_WAIT_L(0); PG8_BAR; PG8_MMAF(0, 0, At, B0); PG8_BAR; PG8_SCHED;
            PG8_LDA(At, 0, 1); PG8_STAGEX(PG8_SB(0, 0), b2, voffB); PG8_STAGEX(PG8_SA(0, 0), a2, w0);
            PG8_WAIT_V(6); PG8_WAIT_L(0); PG8_BAR; PG8_MMAF(1, 0, At, B0); PG8_BAR; PG8_SCHED;
            PG8_LDB(B0, 1, 0); PG8_SCHED; PG8_LDA(At, 1, 0); PG8_STAGEX(PG8_SA(0, 1), a2, w1);
            PG8_WAIT_V(6); PG8_WAIT_L(0); PG8_BAR; PG8_MMAF(0, 0, At, B0); PG8_BAR; PG8_SCHED;
            PG8_LDA(At, 1, 1); PG8_STAGEX(PG8_SB(1, 0), b3, voffB); PG8_STAGEX(PG8_SA(1, 0), a3, w0);
            PG8_WAIT_V(6); PG8_WAIT_L(0); PG8_BAR; PG8_MMAF(1, 0, At, B0); PG8_BAR; PG8_SCHED;
        }
        if (wr == 0) PG8_BAR;
        asm volatile("s_nop 15\n\ts_nop 15" : "+v"(acc[1][1][3][1]), "+v"(acc[1][0][3][1]));
        E.half(acc, cur, wr, wc, fr, fq);
        if (!has_next) break;
#pragma unroll
        for (int a = 0; a < 2; ++a)
#pragma unroll
            for (int m = 0; m < 4; ++m)
#pragma unroll
                for (int n = 0; n < 2; ++n) acc[a][0][m][n] = (f32x4){0.f, 0.f, 0.f, 0.f};
        cur = nxt; cB = nB; ++ui;
#pragma unroll
        for (int h = 0; h < 2; ++h)
#pragma unroll
            for (int i = 0; i < 2; ++i) va[h][i] = vn[h][i];
        if (wr == 1) PG8_BAR;
    }
    PG8_WAIT_V(0);
    PG8_BAR;
}
template <class Epi, class Sched>
__device__ __forceinline__ void gemm_phase_f8(PG8_LAS unsigned char* lds, int wid, const unsigned char* Abase, int K, int N, float wscale, const Sched& S, const Epi& E) {
    static_assert(Epi::PERM, "fp8 body: PERM epilogues only");
    const int lane = fresh_lane(), tid = wid * 64 + lane, wr = wid >> 2, wc = wid & 3, fr = lane & 15, fq = lane >> 4;
    const int nt = K / 128;
    const int lda = K / 2, acol0 = 0;
    const size_t kstep = 128;
    const unsigned ldsw = (unsigned)wid * 1024u;
    const int aoff = lds_byte(wr * 64 + fr, fq * 8), boff = lds_byte(wc * 32 + fr, fq * 8);
    const int n4 = (lane & 15) + 16 * (wid & 3), kq = (lane >> 4) + 4 * (wid >> 2);
    const unsigned vb = (unsigned)(kq * 8 * N + 4 * n4) * 4u;
    const int browb = N * 4, bhstep = 64 * browb, bkstep = 128 * browb;
    const int bn = 4 * n4, brow0 = ((bn & 127) & ~31) + (((n4 & 1) << 4) | (((n4 & 7) >> 1) << 2));
    const unsigned wbaddr = (unsigned)(size_t)lds + (unsigned)(4 * HTB + (bn >> 7) * HTB + lds_byte(brow0, kq * 4));
    const unsigned ldsm0 = (unsigned)(size_t)lds + ldsw;
    Unit cur, nxt; int ui = 0;
    if (!S.next(0, cur)) return;
    nxt = cur;
    f32x4 acc[2][2][4][2];
#pragma unroll
    for (int a = 0; a < 2; ++a)
#pragma unroll
        for (int b = 0; b < 2; ++b)
#pragma unroll
            for (int m = 0; m < 4; ++m)
#pragma unroll
                for (int n = 0; n < 2; ++n) acc[a][b][m][n] = (f32x4){0.f, 0.f, 0.f, 0.f};
    bf16x8 Aa[2], B0[2][2], B1[2][2];
    f32x4 RB[8];
    unsigned va[2][2];
    { int sR[2], sC[2];
_Pragma("unroll") for (int i = 0; i < 2; ++i) stage_rc(tid * 16 + i * 8192, sR[i], sC[i]);
      PG8_AOFF0(va, cur); }
    const char* const cA = (const char*)Abase;
    __amdgpu_buffer_rsrc_t rC = make_rsrc_uniform(S.bbase(cur), K * browb), rN = rC;
#define PG8_STAGE_A8(bufoff, gbase, voff) do { _Pragma("unroll") for (int _i = 0; _i < 2; ++_i) { unsigned _m0s; \
        asm volatile("s_mov_b32 %0, m0\n\ts_mov_b32 m0, %3\n\ts_nop 0\n\tglobal_load_lds_dwordx4 %1, %2\n\ts_mov_b32 m0, %0" : "=&s"(_m0s) : "v"((voff)[_i]), "s"(gbase), "s"(ldsm0 + (unsigned)((bufoff) + _i * 8192)) : "memory"); } } while (0)
#define PG8_FLOADB(rs, so) do { _Pragma("unroll") for (int _j = 0; _j < 8; ++_j) asm volatile("buffer_load_dwordx4 %0, %1, %2, %3 offen sc0" : "=v"(RB[_j]) : "v"(vb), "s"(rs), "s"((so) + _j * browb) : "memory"); } while (0)
#define PG8_FWAITB(n) asm volatile("s_waitcnt vmcnt(" #n ")" : "+v"(RB[0]), "+v"(RB[1]), "+v"(RB[2]), "+v"(RB[3]), "+v"(RB[4]), "+v"(RB[5]), "+v"(RB[6]), "+v"(RB[7]) :: "memory")
#define PG8_FWRITEB(b, h) do { _Pragma("unroll") for (int _i = 0; _i < 4; ++_i) { u32x2 _w; v2i16 _lo, _hi; \
        _lo = __builtin_amdgcn_cvt_scalef32_pk_fp8_f32(_lo, RB[0][_i], RB[1][_i], 1.0f / wscale, false); _lo = __builtin_amdgcn_cvt_scalef32_pk_fp8_f32(_lo, RB[2][_i], RB[3][_i], 1.0f / wscale, true); \
        _hi = __builtin_amdgcn_cvt_scalef32_pk_fp8_f32(_hi, RB[4][_i], RB[5][_i], 1.0f / wscale, false); _hi = __builtin_amdgcn_cvt_scalef32_pk_fp8_f32(_hi, RB[6][_i], RB[7][_i], 1.0f / wscale, true); \
        _w.x = __builtin_bit_cast(unsigned, _lo); _w.y = __builtin_bit_cast(unsigned, _hi); \
        asm volatile("ds_write_b64 %0, %1 offset:%2" :: "v"(wbaddr), "v"(_w), "n"((b) * 2 * HTB + (h) * 1024 + 64 * _i) : "memory"); } } while (0)
#define PG8_LDA1(dst, b, h, m) do { dst[0] = *(const PG8_LAS bf16x8*)(lds + PG8_SA(b, h) + aoff + (m) * 2048); dst[1] = *(const PG8_LAS bf16x8*)(lds + PG8_SA(b, h) + aoff + (m) * 2048 + 1024); } while (0)
#if defined(F8_SCALED)
#define PG8_MM1(ai, m, A) do { _Pragma("unroll") for (int n = 0; n < 2; ++n) { \
        acc[ai][0][m][n] = __builtin_amdgcn_mfma_scale_f32_16x16x128_f8f6f4(cat8(B0[n][0], B0[n][1]), cat8(A[0], A[1]), acc[ai][0][m][n], 0, 0, 0, 0x7f7f7f7f, 0, 0x7f7f7f7f); \
        acc[ai][1][m][n] = __builtin_amdgcn_mfma_scale_f32_16x16x128_f8f6f4(cat8(B1[n][0], B1[n][1]), cat8(A[0], A[1]), acc[ai][1][m][n], 0, 0, 0, 0x7f7f7f7f, 0, 0x7f7f7f7f); } } while (0)
#else
#define PG8_MM1(ai, m, A) do { _Pragma("unroll") for (int n = 0; n < 2; ++n) _Pragma("unroll") for (int k = 0; k < 2; ++k) { \
        const v2i64 _a = __builtin_bit_cast(v2i64, A[k]), _b0 = __builtin_bit_cast(v2i64, B0[n][k]), _b1 = __builtin_bit_cast(v2i64, B1[n][k]); \
        acc[ai][0][m][n] = __builtin_amdgcn_mfma_f32_16x16x32_fp8_fp8(_b0[0], _a[0], acc[ai][0][m][n], 0, 0, 0); \
        acc[ai][0][m][n] = __builtin_amdgcn_mfma_f32_16x16x32_fp8_fp8(_b0[1], _a[1], acc[ai][0][m][n], 0, 0, 0); \
        acc[ai][1][m][n] = __builtin_amdgcn_mfma_f32_16x16x32_fp8_fp8(_b1[0], _a[0], acc[ai][1][m][n], 0, 0, 0); \
        acc[ai][1][m][n] = __builtin_amdgcn_mfma_f32_16x16x32_fp8_fp8(_b1[1], _a[1], acc[ai][1][m][n], 0, 0, 0); } } while (0)
#endif
#define PG8_MMA8(ai, b) do { __builtin_amdgcn_s_setprio(1); \
        PG8_MM1(ai, 0, Aa); PG8_SCHED; PG8_LDA1(Aa, b, ai, 1); PG8_MM1(ai, 1, Aa); PG8_SCHED; \
        PG8_LDA1(Aa, b, ai, 2); PG8_MM1(ai, 2, Aa); PG8_SCHED; \
        PG8_LDA1(Aa, b, ai, 3); PG8_MM1(ai, 3, Aa); __builtin_amdgcn_s_setprio(0); } while (0)
    PG8_FLOADB(rC, 0); PG8_FWAITB(0); PG8_FWRITEB(0, 0);
    PG8_FLOADB(rC, bhstep); PG8_STAGE_A8(PG8_SA(0, 0), cA, va[0]); PG8_STAGE_A8(PG8_SA(0, 1), cA, va[1]);
    PG8_FWAITB(4); PG8_FWRITEB(0, 1);
    PG8_FLOADB(rC, bkstep); PG8_STAGE_A8(PG8_SA(1, 0), cA + kstep, va[0]);
    if (wr == 1) PG8_BAR;
    PG8_WAIT_V(10); PG8_WAIT_L(0); PG8_BAR;
    PG8_BAR;
    for (;;) {
        const bool has_next = S.next(ui + 1, nxt);
        rN = rC;
        if (has_next) { rN = make_rsrc_uniform(S.bbase(nxt), K * browb); S.prefetch(nxt, ui & 1, lds, wid, lane); }
        E.prefetch(cur, ui & 1, lds, wid, lane);
#pragma unroll 1
        for (int t = 0; t < nt; t += 2) {
            const bool last = (t == nt - 2);
            const char* a1 = cA + (size_t)(t + 1) * kstep;
            const char* a2 = last ? cA : cA + (size_t)(t + 2) * kstep; const char* a3 = a2 + kstep;
            const __amdgpu_buffer_rsrc_t r2 = last ? rN : rC; const int so2 = last ? 0 : (t + 2) * bkstep;
            PG8_LDA1(Aa, 0, 0, 0);
            PG8_FWAITB(2); PG8_FWRITEB(1, 0); PG8_FLOADB(rC, (t + 1) * bkstep + bhstep);
            PG8_SCHED; PG8_LDB(B0, 0, 0); PG8_LDB(B1, 0, 1);
            PG8_WAIT_L(0); PG8_BAR; PG8_STAGE_A8(PG8_SA(1, 1), a1, va[1]); PG8_MMA8(0, 0); PG8_BAR; PG8_SCHED;
            { unsigned vt[2][2]; int sR[2], sC[2]; const int tz = wid * 64 + fresh_lane(); const bool sw = last && has_next;
_Pragma("unroll") for (int i = 0; i < 2; ++i) stage_rc(tz * 16 + i * 8192, sR[i], sC[i]);
              PG8_AOFF1(vt, nxt, ui & 1);
_Pragma("unroll") for (int h = 0; h < 2; ++h) _Pragma("unroll") for (int i = 0; i < 2; ++i) va[h][i] = sw ? vt[h][i] : va[h][i]; }
            PG8_LDA1(Aa, 0, 1, 0);
            PG8_FWAITB(2); PG8_FWRITEB(1, 1); PG8_FLOADB(r2, so2);
            PG8_WAIT_L(0); PG8_BAR; PG8_STAGE_A8(PG8_SA(0, 0), a2, va[0]); PG8_MMA8(1, 0); PG8_BAR; PG8_SCHED;
            PG8_LDA1(Aa, 1, 0, 0);
            PG8_FWAITB(2); PG8_FWRITEB(0, 0); PG8_FLOADB(r2, so2 + bhstep);
            PG8_SCHED; PG8_LDB(B0, 1, 0); PG8_LDB(B1, 1, 1);
            PG8_WAIT_L(0); PG8_BAR; PG8_STAGE_A8(PG8_SA(0, 1), a2, va[1]); PG8_MMA8(0, 1); PG8_BAR; PG8_SCHED;
            PG8_LDA1(Aa, 1, 1, 0);
            PG8_FWAITB(2); PG8_FWRITEB(0, 1); PG8_FLOADB(r2, so2 + bkstep);
            PG8_WAIT_L(0); PG8_BAR; PG8_STAGE_A8(PG8_SA(1, 0), a3, va[0]); PG8_MMA8(1, 1); PG8_BAR; PG8_SCHED;
        }
        if (wr == 0) PG8_BAR;
        asm volatile("s_nop 15\n\ts_nop 15" : "+v"(acc[1][1][3][1]), "+v"(acc[1][0][3][1]));
        cur.par = ui & 1; E(acc, cur, wr, wc, fr, fq);
        if (!has_next) break;
#pragma unroll
        for (int a = 0; a < 2; ++a)
#pragma unroll
            for (int b = 0; b < 2; ++b)
#pragma unroll
                for (int m = 0; m < 4; ++m)
#pragma unroll
                    for (int n = 0; n < 2; ++n) acc[a][b][m][n] = (f32x4){0.f, 0.f, 0.f, 0.f};
        cur = nxt; rC = rN; ++ui;
        if (wr == 1) PG8_BAR;
    }
    PG8_WAIT_V(0);
    asm volatile("" :: "v"(RB[0]), "v"(RB[1]), "v"(RB[2]), "v"(RB[3]), "v"(RB[4]), "v"(RB[5]), "v"(RB[6]), "v"(RB[7]));
    PG8_BAR;
#undef PG8_FLOADB
#undef PG8_STAGE_A8
#undef PG8_FWAITB
#undef PG8_FWRITEB
#undef PG8_MMA8
#undef PG8_MM1
#undef PG8_LDA1
}
template <class Epi, class Sched>
__device__ __forceinline__ void gemm_phase_f8_half(PG8_LAS unsigned char* lds, int wid, const unsigned char* Abase, int K, int N, float wscale, const Sched& S, const Epi& E) {
    static_assert(Epi::PERM, "fp8 body: PERM epilogues only");
    const int lane = fresh_lane(), tid = wid * 64 + lane, wr = wid >> 2, wc = wid & 3, fr = lane & 15, fq = lane >> 4;
    const int nt = K / 128;
    const int lda = K / 2, acol0 = 0;
    const size_t kstep = 128;
    const unsigned ldsw = (unsigned)wid * 1024u;
    const int aoff = lds_byte(wr * 64 + fr, fq * 8), boff = lds_byte(wc * 32 + fr, fq * 8);
    const int n4 = (lane & 15) + 16 * (wid & 1), kq = (lane >> 4) + 4 * (wid >> 1);
    const unsigned vb = (unsigned)(kq * 4 * N + 4 * n4) * 4u;
    const int browb = N * 4, bhstep = 64 * browb, bkstep = 128 * browb;
    const int bn = 4 * n4, brow0 = (bn & ~31) + (((n4 & 1) << 4) | (((n4 & 7) >> 1) << 2));
    const unsigned wbaddr = (unsigned)(size_t)lds + (unsigned)(4 * HTB + lds_byte(brow0, kq * 2));
    const unsigned ldsm0 = (unsigned)(size_t)lds + ldsw;
    Unit cur, nxt; int ui = 0;
    if (!S.next(0, cur)) return;
    f32x4 acc[2][2][4][2];
#pragma unroll
    for (int a = 0; a < 2; ++a)
#pragma unroll
        for (int b = 0; b < 2; ++b)
#pragma unroll
            for (int m = 0; m < 4; ++m)
#pragma unroll
                for (int n = 0; n < 2; ++n) acc[a][b][m][n] = (f32x4){0.f, 0.f, 0.f, 0.f};
    bf16x8 Aa[2], Ab[2], B0[2][2];
    f32x4 RB[4];
    unsigned va[2][2];
    { int sR[2], sC[2];
_Pragma("unroll") for (int i = 0; i < 2; ++i) stage_rc(tid * 16 + i * 8192, sR[i], sC[i]);
      PG8_AOFF0(va, cur); }
    const char* const cA = (const char*)Abase;
    __amdgpu_buffer_rsrc_t rC = make_rsrc_uniform(S.bbase(cur), K * browb), rN = rC;
#define PG8_STAGE_A8(bufoff, gbase, voff) do { _Pragma("unroll") for (int _i = 0; _i < 2; ++_i) { unsigned _m0s; \
        asm volatile("s_mov_b32 %0, m0\n\ts_mov_b32 m0, %3\n\ts_nop 0\n\tglobal_load_lds_dwordx4 %1, %2\n\ts_mov_b32 m0, %0" : "=&s"(_m0s) : "v"((voff)[_i]), "s"(gbase), "s"(ldsm0 + (unsigned)((bufoff) + _i * 8192)) : "memory"); } } while (0)
#define PG8_FLOADB(rs, so) do { _Pragma("unroll") for (int _j = 0; _j < 4; ++_j) asm volatile("buffer_load_dwordx4 %0, %1, %2, %3 offen" : "=v"(RB[_j]) : "v"(vb), "s"(rs), "s"((so) + _j * browb) : "memory"); } while (0)
#define PG8_FWAITB(n) asm volatile("s_waitcnt vmcnt(" #n ")" : "+v"(RB[0]), "+v"(RB[1]), "+v"(RB[2]), "+v"(RB[3]) :: "memory")
#define PG8_FWRITEB(b, h) do { _Pragma("unroll") for (int _i = 0; _i < 4; ++_i) { v2i16 _lo; \
        _lo = __builtin_amdgcn_cvt_scalef32_pk_fp8_f32(_lo, RB[0][_i], RB[1][_i], 1.0f / wscale, false); _lo = __builtin_amdgcn_cvt_scalef32_pk_fp8_f32(_lo, RB[2][_i], RB[3][_i], 1.0f / wscale, true); \
        asm volatile("ds_write_b32 %0, %1 offset:%2" :: "v"(wbaddr), "v"(__builtin_bit_cast(unsigned, _lo)), "n"((b) * 2 * HTB + (h) * 1024 + 64 * _i) : "memory"); } } while (0)
#define PG8_LDA1(dst, b, h, m) do { dst[0] = *(const PG8_LAS bf16x8*)(lds + PG8_SA(b, h) + aoff + (m) * 2048); dst[1] = *(const PG8_LAS bf16x8*)(lds + PG8_SA(b, h) + aoff + (m) * 2048 + 1024); } while (0)
#define PG8_MM1(ai, m, A) do { _Pragma("unroll") for (int n = 0; n < 2; ++n) \
        acc[ai][0][m][n] = __builtin_amdgcn_mfma_scale_f32_16x16x128_f8f6f4(cat8(B0[n][0], B0[n][1]), cat8(A[0], A[1]), acc[ai][0][m][n], 0, 0, 0, 0x7f7f7f7f, 0, 0x7f7f7f7f); } while (0)
#define PG8_MMA8(ai, b) do { __builtin_amdgcn_s_setprio(1); \
        PG8_LDA1(Ab, b, ai, 1); PG8_MM1(ai, 0, Aa); PG8_SCHED; \
        PG8_LDA1(Aa, b, ai, 2); PG8_MM1(ai, 1, Ab); PG8_SCHED; \
        PG8_LDA1(Ab, b, ai, 3); PG8_MM1(ai, 2, Aa); PG8_SCHED; \
        PG8_MM1(ai, 3, Ab); __builtin_amdgcn_s_setprio(0); } while (0)
    PG8_FLOADB(rC, 0); PG8_FWAITB(0); PG8_FWRITEB(0, 0);
    PG8_FLOADB(rC, bhstep); PG8_STAGE_A8(PG8_SA(0, 0), cA, va[0]); PG8_STAGE_A8(PG8_SA(0, 1), cA, va[1]);
    PG8_FWAITB(4); PG8_FWRITEB(0, 1);
    PG8_FLOADB(rC, bkstep); PG8_STAGE_A8(PG8_SA(1, 0), cA + kstep, va[0]);
    if (wr == 1) PG8_BAR;
    PG8_WAIT_V(6); PG8_WAIT_L(0); PG8_BAR;
    PG8_BAR;
    for (;;) {
        const bool has_next = S.next(ui + 1, nxt);
        rN = rC;
        if (has_next) { rN = make_rsrc_uniform(S.bbase(nxt), K * browb); S.prefetch(nxt, ui & 1, lds, wid, lane); }
        E.prefetch(cur, ui & 1, lds, wid, lane);
#pragma unroll 1
        for (int t = 0; t < nt; t += 2) {
            const bool last = (t == nt - 2);
            const char* a1 = cA + (size_t)(t + 1) * kstep;
            const char* a2 = last ? cA : cA + (size_t)(t + 2) * kstep; const char* a3 = a2 + kstep;
            const __amdgpu_buffer_rsrc_t r2 = last ? rN : rC; const int so2 = last ? 0 : (t + 2) * bkstep;
            unsigned vn[2][2];
_Pragma("unroll") for (int h = 0; h < 2; ++h) _Pragma("unroll") for (int i = 0; i < 2; ++i) vn[h][i] = va[h][i];
            if (last && has_next) { int sR[2], sC[2]; const int tz = wid * 64 + fresh_lane(); _Pragma("unroll") for (int i = 0; i < 2; ++i) stage_rc(tz * 16 + i * 8192, sR[i], sC[i]); PG8_AOFF1(vn, nxt, ui & 1); }
            PG8_LDA1(Aa, 0, 0, 0);
            PG8_FWAITB(2); PG8_FWRITEB(1, 0); PG8_FLOADB(rC, (t + 1) * bkstep + bhstep);
            PG8_SCHED; PG8_LDB(B0, 0, 0);
            PG8_WAIT_L(0); PG8_BAR; PG8_STAGE_A8(PG8_SA(1, 1), a1, va[1]); PG8_MMA8(0, 0); PG8_BAR; PG8_SCHED;
_Pragma("unroll") for (int h = 0; h < 2; ++h) _Pragma("unroll") for (int i = 0; i < 2; ++i) va[h][i] = vn[h][i];
            PG8_LDA1(Aa, 0, 1, 0);
            PG8_FWAITB(2); PG8_FWRITEB(1, 1); PG8_FLOADB(r2, so2);
            PG8_WAIT_L(0); PG8_BAR; PG8_STAGE_A8(PG8_SA(0, 0), a2, va[0]); PG8_MMA8(1, 0); PG8_BAR; PG8_SCHED;
            PG8_LDA1(Aa, 1, 0, 0);
            PG8_FWAITB(2); PG8_FWRITEB(0, 0); PG8_FLOADB(r2, so2 + bhstep);
            PG8_SCHED; PG8_LDB(B0, 1, 0);
            PG8_WAIT_L(0); PG8_BAR; PG8_STAGE_A8(PG8_SA(0, 1), a2, va[1]); PG8_MMA8(0, 1); PG8_BAR; PG8_SCHED;
            PG8_LDA1(Aa, 1, 1, 0);
            PG8_FWAITB(2); PG8_FWRITEB(0, 1); PG8_FLOADB(r2, so2 + bkstep);
            PG8_WAIT_L(0); PG8_BAR; PG8_STAGE_A8(PG8_SA(1, 0), a3, va[0]); PG8_MMA8(1, 1); PG8_BAR; PG8_SCHED;
        }
        if (wr == 0) PG8_BAR;
        asm volatile("s_nop 15\n\ts_nop 15" : "+v"(acc[1][0][3][1]), "+v"(acc[0][0][3][1]));
        cur.par = ui & 1; E.half(acc, cur, wr, wc, fr, fq);
        if (!has_next) break;
#pragma unroll
        for (int a = 0; a < 2; ++a)
#pragma unroll
            for (int m = 0; m < 4; ++m)
#pragma unroll
                for (int n = 0; n < 2; ++n) acc[a][0][m][n] = (f32x4){0.f, 0.f, 0.f, 0.f};
        cur = nxt; rC = rN; ++ui;
        if (wr == 1) PG8_BAR;
    }
    PG8_WAIT_V(0);
    asm volatile("" :: "v"(RB[0]), "v"(RB[1]), "v"(RB[2]), "v"(RB[3]));
    PG8_BAR;
#undef PG8_FLOADB
#undef PG8_STAGE_A8
#undef PG8_FWAITB
#undef PG8_FWRITEB
#undef PG8_MMA8
#undef PG8_MM1
#undef PG8_LDA1
}
template <class Epi, class Sched>
__device__ __forceinline__ void gemm_phase_f8d(PG8_LAS unsigned char* lds, int wid, const unsigned char* Abase, int K, const Sched& S, const Epi& E) {
    static_assert(Epi::PERM, "fp8 body: PERM epilogues only");
    const int lane = fresh_lane(), tid = wid * 64 + lane, wr = wid >> 2, wc = wid & 3, fr = lane & 15, fq = lane >> 4;
    const int nt = K / 128;
    const int lda = K / 2, acol0 = 0;
    const size_t kstep = 128;
    const unsigned ldsw = (unsigned)wid * 1024u;
    const int aoff = lds_byte(wr * 64 + fr, fq * 8), boff = lds_byte(wc * 32 + fr, fq * 8);
    unsigned voffB[2];
    { int sR[2], sC[2];
_Pragma("unroll") for (int i = 0; i < 2; ++i) { stage_rc(tid * 16 + i * 8192, sR[i], sC[i]); voffB[i] = (unsigned)(((sR[i] & ~31) + perm32(sR[i] & 31)) * K + sC[i] * 2); } }
    const size_t hstepB = (size_t)HALF * K;
    const unsigned ldsm0 = (unsigned)(size_t)lds + ldsw;
    Unit cur, nxt; int ui = 0;
    if (!S.next(0, cur)) return;
    nxt = cur;
    f32x4 acc[2][2][4][2];
#pragma unroll
    for (int a = 0; a < 2; ++a)
#pragma unroll
        for (int b = 0; b < 2; ++b)
#pragma unroll
            for (int m = 0; m < 4; ++m)
#pragma unroll
                for (int n = 0; n < 2; ++n) acc[a][b][m][n] = (f32x4){0.f, 0.f, 0.f, 0.f};
    bf16x8 Aa[2], Ab[2], Ac[2], B0[2][2], B1[2][2];
    unsigned va[2][2];
    { int sR[2], sC[2];
_Pragma("unroll") for (int i = 0; i < 2; ++i) stage_rc(tid * 16 + i * 8192, sR[i], sC[i]);
      PG8_AOFF0(va, cur); }
    const char* const cA = (const char*)Abase;
    const char* cB = S.bbase(cur);
#define PG8_STAGE_A8(bufoff, gbase, voff) do { _Pragma("unroll") for (int _i = 0; _i < 2; ++_i) { unsigned _m0s; \
        asm volatile("s_mov_b32 %0, m0\n\ts_mov_b32 m0, %3\n\ts_nop 0\n\tglobal_load_lds_dwordx4 %1, %2\n\ts_mov_b32 m0, %0" : "=&s"(_m0s) : "v"((voff)[_i]), "s"(gbase), "s"(ldsm0 + (unsigned)((bufoff) + _i * 8192)) : "memory"); } } while (0)
#define PG8_LDA1(dst, b, h, m) do { dst[0] = *(const PG8_LAS bf16x8*)(lds + PG8_SA(b, h) + aoff + (m) * 2048); dst[1] = *(const PG8_LAS bf16x8*)(lds + PG8_SA(b, h) + aoff + (m) * 2048 + 1024); } while (0)
#if defined(F8_SCALED)
#define PG8_MM1(ai, m, A) do { _Pragma("unroll") for (int n = 0; n < 2; ++n) { \
        acc[ai][0][m][n] = __builtin_amdgcn_mfma_scale_f32_16x16x128_f8f6f4(cat8(B0[n][0], B0[n][1]), cat8(A[0], A[1]), acc[ai][0][m][n], 0, 0, 0, 0x7f7f7f7f, 0, 0x7f7f7f7f); \
        acc[ai][1][m][n] = __builtin_amdgcn_mfma_scale_f32_16x16x128_f8f6f4(cat8(B1[n][0], B1[n][1]), cat8(A[0], A[1]), acc[ai][1][m][n], 0, 0, 0, 0x7f7f7f7f, 0, 0x7f7f7f7f); } } while (0)
#else
#define PG8_MM1(ai, m, A) do { _Pragma("unroll") for (int n = 0; n < 2; ++n) _Pragma("unroll") for (int k = 0; k < 2; ++k) { \
        const v2i64 _a = __builtin_bit_cast(v2i64, A[k]), _b0 = __builtin_bit_cast(v2i64, B0[n][k]), _b1 = __builtin_bit_cast(v2i64, B1[n][k]); \
        acc[ai][0][m][n] = __builtin_amdgcn_mfma_f32_16x16x32_fp8_fp8(_b0[0], _a[0], acc[ai][0][m][n], 0, 0, 0); \
        acc[ai][0][m][n] = __builtin_amdgcn_mfma_f32_16x16x32_fp8_fp8(_b0[1], _a[1], acc[ai][0][m][n], 0, 0, 0); \
        acc[ai][1][m][n] = __builtin_amdgcn_mfma_f32_16x16x32_fp8_fp8(_b1[0], _a[0], acc[ai][1][m][n], 0, 0, 0); \
        acc[ai][1][m][n] = __builtin_amdgcn_mfma_f32_16x16x32_fp8_fp8(_b1[1], _a[1], acc[ai][1][m][n], 0, 0, 0); } } while (0)
#endif
#define PG8_MMA8(ai, b) do { __builtin_amdgcn_s_setprio(1); \
        PG8_LDA1(Ac, b, ai, 2); PG8_MM1(ai, 0, Aa); PG8_SCHED; \
        PG8_LDA1(Aa, b, ai, 3); PG8_MM1(ai, 1, Ab); PG8_SCHED; \
        PG8_MM1(ai, 2, Ac); PG8_SCHED; \
        PG8_MM1(ai, 3, Aa); __builtin_amdgcn_s_setprio(0); } while (0)
    PG8_STAGE_A8(PG8_SB(0, 0), cB, voffB); PG8_STAGE_A8(PG8_SB(0, 1), cB + hstepB, voffB); PG8_STAGE_A8(PG8_SA(0, 0), cA, va[0]); PG8_STAGE_A8(PG8_SA(0, 1), cA, va[1]);
    PG8_STAGE_A8(PG8_SB(1, 0), cB + kstep, voffB); PG8_STAGE_A8(PG8_SB(1, 1), cB + hstepB + kstep, voffB); PG8_STAGE_A8(PG8_SA(1, 0), cA + kstep, va[0]);
    if (wr == 1) PG8_BAR;
    PG8_WAIT_V(6); PG8_BAR;
    PG8_BAR;
    for (;;) {
        const bool has_next = S.next(ui + 1, nxt);
        const char* nB = cB;
        if (has_next) { nB = S.bbase(nxt); S.prefetch(nxt, ui & 1, lds, wid, lane); }
#pragma unroll 1
        for (int t = 0; t < nt; t += 2) {
            const bool last = (t == nt - 2);
            const char* a1 = cA + (size_t)(t + 1) * kstep;
            const char* a2 = last ? cA : cA + (size_t)(t + 2) * kstep; const char* a3 = a2 + kstep;
            const char* b2 = last ? nB : cB + (size_t)(t + 2) * kstep; const char* b3 = b2 + kstep;
            PG8_LDA1(Aa, 0, 0, 0); PG8_LDA1(Ab, 0, 0, 1); PG8_LDB(B0, 0, 0); PG8_LDB(B1, 0, 1);
            PG8_WAIT_V(6); PG8_WAIT_L(0); PG8_BAR; PG8_STAGE_A8(PG8_SA(1, 1), a1, va[1]); PG8_MMA8(0, 0); PG8_BAR; PG8_SCHED;
            { unsigned vt[2][2]; int sR[2], sC[2]; const int tz = wid * 64 + fresh_lane(); const bool sw = last && has_next;
_Pragma("unroll") for (int i = 0; i < 2; ++i) stage_rc(tz * 16 + i * 8192, sR[i], sC[i]);
              PG8_AOFF1(vt, nxt, ui & 1);
_Pragma("unroll") for (int h = 0; h < 2; ++h) _Pragma("unroll") for (int i = 0; i < 2; ++i) va[h][i] = sw ? vt[h][i] : va[h][i]; }
            PG8_LDA1(Aa, 0, 1, 0); PG8_LDA1(Ab, 0, 1, 1);
            PG8_WAIT_V(2); PG8_WAIT_L(0); PG8_BAR; PG8_STAGE_A8(PG8_SB(0, 0), b2, voffB); PG8_STAGE_A8(PG8_SB(0, 1), b2 + hstepB, voffB); PG8_STAGE_A8(PG8_SA(0, 0), a2, va[0]); PG8_MMA8(1, 0); PG8_BAR; PG8_SCHED;
            PG8_LDA1(Aa, 1, 0, 0); PG8_LDA1(Ab, 1, 0, 1); PG8_LDB(B0, 1, 0); PG8_LDB(B1, 1, 1);
            PG8_WAIT_V(6); PG8_WAIT_L(0); PG8_BAR; PG8_STAGE_A8(PG8_SA(0, 1), a2, va[1]); PG8_MMA8(0, 1); PG8_BAR; PG8_SCHED;
            PG8_LDA1(Aa, 1, 1, 0); PG8_LDA1(Ab, 1, 1, 1);
            PG8_WAIT_V(2); PG8_WAIT_L(0); PG8_BAR; PG8_STAGE_A8(PG8_SB(1, 0), b3, voffB); PG8_STAGE_A8(PG8_SB(1, 1), b3 + hstepB, voffB); PG8_STAGE_A8(PG8_SA(1, 0), a3, va[0]); PG8_MMA8(1, 1); PG8_BAR; PG8_SCHED;
        }
        if (wr == 0) PG8_BAR;
        asm volatile("s_nop 15\n\ts_nop 15" : "+v"(acc[1][1][3][1]), "+v"(acc[1][0][3][1]));
        E(acc, cur, wr, wc, fr, fq);
        if (!has_next) break;
#pragma unroll
        for (int a = 0; a < 2; ++a)
#pragma unroll
            for (int b = 0; b < 2; ++b)
#pragma unroll
                for (int m = 0; m < 4; ++m)
#pragma unroll
                    for (int n = 0; n < 2; ++n) acc[a][b][m][n] = (f32x4){0.f, 0.f, 0.f, 0.f};
        cur = nxt; cB = nB; ++ui;
        if (wr == 1) PG8_BAR;
    }
    PG8_WAIT_V(0);
    PG8_BAR;
#undef PG8_STAGE_A8
#undef PG8_MMA8
#undef PG8_MM1
#undef PG8_LDA1
}
#undef PG8_SA
#undef PG8_SB
#undef PG8_STAGE
#undef PG8_STAGEX
#undef PG8_STAGE_A
#undef PG8_LDA
#undef PG8_LDB
#undef PG8_MMA
#undef PG8_MMAF
#undef PG8_WAIT_V
#undef PG8_WAIT_L
#undef PG8_BAR
#undef PG8_SCHED
#undef PG8_AOFF0
#undef PG8_AOFF1

struct DenseOrder {
    int nM, nN, nwg, G, c; const bf16_t* Bt; int K; const float* Wf;
    int mode;
    __device__ __forceinline__ void init(int M, int N, int G_, int c_, const bf16_t* Bt_, int K_, const float* Wf_ = nullptr, int mode_ = 0) { nM = M / BM; nN = N / BM; nwg = nM * nN; G = G_; c = c_; Bt = Bt_; K = K_; Wf = Wf_; mode = mode_; }
    __device__ __forceinline__ bool next(int i, Unit& u) const {
        const int full = (nwg / G) * G, rem = nwg - full; const bool use_half = rem > 0 && 2 * rem <= G;
        long L = (long)i * G + c; int hn = 0;
        if (mode == 2) { if (!use_half || L >= 2 * rem) return false; hn = (int)(L & 1); L = full + (L >> 1); }
        else if (L >= ((mode == 1 && use_half) ? full : nwg)) return false;
        const int wgid = xcd_remap((int)L, nwg);
        const int nig = 8 * nN, gid = wgid / nig, fm = gid * 8, gsz = (nM - fm) < 8 ? (nM - fm) : 8;
        u.pm = fm + ((wgid % nig) % gsz); u.pn = (wgid % nig) / gsz; u.e = 0; u.lm = u.pm; u.aux = 0; u.hn = hn; return true;
    }
    __device__ __forceinline__ int arow0(const Unit& u, int r) const { return u.pm * BM + r; }
    __device__ __forceinline__ int arow1(const Unit& u, int r, int, PG8_LAS unsigned char*) const { return u.pm * BM + r; }
    __device__ __forceinline__ void prefetch(const Unit&, int, PG8_LAS unsigned char*, int, int) const {}
    __device__ __forceinline__ void round_sync(int, int, int) const {}
    __device__ __forceinline__ const char* bbase(const Unit& u) const { if (Wf) return (const char*)Wf + ((size_t)u.pn * BM + (size_t)u.hn * HALF) * 4; return (const char*)Bt + ((size_t)u.pn * BM + (size_t)u.hn * HALF) * K * 2; }
    __device__ __forceinline__ const char* wbbase(const Unit& u) const { return (const char*)Bt + (size_t)u.pn * BM * K * 2; }
};

struct EpiBf16 {
    static constexpr bool PERM = true;
    bf16_t* O; int ldc; int ocol0; const float* cscale;
    __device__ __forceinline__ void operator()(const f32x4 (&acc)[2][2][4][2], const Unit& u, int wr, int wc, int fr, int fq) const { apply<2>(acc, u, wr, wc, fr, fq, 0); }
    __device__ __forceinline__ void half(const f32x4 (&acc)[2][2][4][2], const Unit& u, int wr, int wc, int fr, int fq) const { apply<1>(acc, u, wr, wc, fr, fq, u.hn * HALF); }
    template <int NBJ> __device__ __forceinline__ void apply(const f32x4 (&acc)[2][2][4][2], const Unit& u, int wr, int wc, int fr, int fq, int cofs) const {
        const int row0 = u.pm * BM + wr * 64 + fr; const int col0 = u.pn * BM + cofs + wc * 32 + 8 * fq;
        f32x4 sv[2][2];
#pragma unroll
        for (int bj = 0; bj < NBJ; ++bj)
#pragma unroll
            for (int n = 0; n < 2; ++n) sv[bj][n] = cscale ? *(const f32x4*)(cscale + col0 + bj * HALF + 4 * n) : (f32x4){1.f, 1.f, 1.f, 1.f};
#pragma unroll
        for (int ai = 0; ai < 2; ++ai)
#pragma unroll
            for (int m = 0; m < 4; ++m) { bf16_t* rowp = O + (size_t)(row0 + ai * HALF + m * 16) * ldc + ocol0 + col0;
#pragma unroll
                for (int bj = 0; bj < NBJ; ++bj) { const f32x4 v0 = acc[ai][bj][m][0] * sv[bj][0], v1 = acc[ai][bj][m][1] * sv[bj][1];
                    u32x4 w; w.x = cvt_pk_bf16(v0[0], v0[1]); w.y = cvt_pk_bf16(v0[2], v0[3]); w.z = cvt_pk_bf16(v1[0], v1[1]); w.w = cvt_pk_bf16(v1[2], v1[3]);
                    *(u32x4*)(rowp + bj * HALF) = w; } }
    }
};
struct EpiF32 {
    static constexpr bool PERM = false;
    float* C; int ldc;
    __device__ __forceinline__ void operator()(const f32x4 (&acc)[2][2][4][2], const Unit& u, int wr, int wc, int fr, int fq) const {
        const int row0 = u.pm * BM + wr * 64 + fr, col0 = u.pn * BM + wc * 32 + 4 * fq;
#pragma unroll
        for (int ai = 0; ai < 2; ++ai)
#pragma unroll
            for (int m = 0; m < 4; ++m) { float* rowp = C + (size_t)(row0 + ai * HALF + m * 16) * ldc + col0;
#pragma unroll
                for (int bj = 0; bj < 2; ++bj)
#pragma unroll
                    for (int n = 0; n < 2; ++n) *(f32x4*)(rowp + bj * HALF + n * 16) = acc[ai][bj][m][n]; }
    }
};
__device__ __forceinline__ float swiglu1(float g, float l) {
    const float gl = fminf(g, 7.0f), li = fminf(fmaxf(l, -7.0f), 7.0f);
    const float sg = __builtin_amdgcn_rcpf(1.0f + __builtin_amdgcn_exp2f(-1.702f * 1.4426950408889634f * gl));
    return gl * sg * (li + 1.0f);
}
template <int KNOB> struct EpiSwigluT {
    static constexpr bool PERM = true;
    bf16_t* O; const float* bias;
    __device__ __forceinline__ void operator()(const f32x4 (&acc)[2][2][4][2], const Unit& u, int wr, int wc, int fr, int fq) const { apply<2>(acc, u, wr, wc, fr, fq, 0); }
    __device__ __forceinline__ void half(const f32x4 (&acc)[2][2][4][2], const Unit& u, int wr, int wc, int fr, int fq) const { apply<1>(acc, u, wr, wc, fr, fq, u.hn * HALF); }
    template <int NBJ> __device__ __forceinline__ void apply(const f32x4 (&acc)[2][2][4][2], const Unit& u, int wr, int wc, int fr, int fq, int cofs) const {
        const int row0 = u.pm * BM + wr * 64 + fr; const int col0 = u.pn * BM + cofs + wc * 32 + 8 * fq;
        const float* bp = bias + (size_t)u.e * 4096 + col0;
        f32x4 bv[2][2];
#pragma unroll
        for (int bj = 0; bj < NBJ; ++bj)
#pragma unroll
            for (int n = 0; n < 2; ++n) bv[bj][n] = *(const f32x4*)(bp + bj * HALF + 4 * n);
#pragma unroll
        for (int ai = 0; ai < 2; ++ai)
#pragma unroll
            for (int m = 0; m < 4; ++m) { bf16_t* rowp = O + (size_t)(row0 + ai * HALF + m * 16) * 2048 + (col0 >> 1);
#pragma unroll
                for (int bj = 0; bj < NBJ; ++bj) { const f32x4 v0 = acc[ai][bj][m][0] + bv[bj][0], v1 = acc[ai][bj][m][1] + bv[bj][1];
#if 0
                    u32x2 w; w.x = cvt_pk_bf16(v0[0] + v0[1], v0[2] + v0[3]); w.y = cvt_pk_bf16(v1[0] + v1[1], v1[2] + v1[3]);
#else
                    u32x2 w; w.x = cvt_pk_bf16(swiglu1(v0[0], v0[1]), swiglu1(v0[2], v0[3])); w.y = cvt_pk_bf16(swiglu1(v1[0], v1[1]), swiglu1(v1[2], v1[3]));
#endif
                    if (KNOB == 2) { w.x = cvt_pk_bf16(v0[0] + v0[1], v0[2] + v0[3]); w.y = cvt_pk_bf16(v1[0] + v1[1], v1[2] + v1[3]); }
                    if (KNOB != 1 || u.aux < 0) *(u32x2*)(rowp + bj * (HALF / 2)) = w; } }
    }
};
typedef EpiSwigluT<0> EpiSwiglu;
struct EpiDown {
    static constexpr bool PERM = true;
    bf16_t* O; const float* bias; const float* gate;
    __device__ __forceinline__ void operator()(const f32x4 (&acc)[2][2][4][2], const Unit& u, int wr, int wc, int fr, int fq) const { apply<2>(acc, u, wr, wc, fr, fq, 0); }
    __device__ __forceinline__ void half(const f32x4 (&acc)[2][2][4][2], const Unit& u, int wr, int wc, int fr, int fq) const { apply<1>(acc, u, wr, wc, fr, fq, u.hn * HALF); }
    template <int NBJ> __device__ __forceinline__ void apply(const f32x4 (&acc)[2][2][4][2], const Unit& u, int wr, int wc, int fr, int fq, int cofs) const {
        const int lrow0 = u.lm * BM + wr * 64 + fr;
        const int row0 = u.pm * BM + wr * 64 + fr; const int col0 = u.pn * BM + cofs + wc * 32 + 8 * fq;
        const float* bp = bias + (size_t)u.e * 2048 + col0; const float* gp = gate + (size_t)u.e * 8192 + lrow0;
        f32x4 bv[2][2];
#pragma unroll
        for (int bj = 0; bj < NBJ; ++bj)
#pragma unroll
            for (int n = 0; n < 2; ++n) bv[bj][n] = *(const f32x4*)(bp + bj * HALF + 4 * n);
#pragma unroll
        for (int ai = 0; ai < 2; ++ai)
#pragma unroll
            for (int m = 0; m < 4; ++m) { bf16_t* rowp = O + (size_t)(row0 + ai * HALF + m * 16) * 2048 + col0; const float gt = gp[ai * HALF + m * 16];
#pragma unroll
                for (int bj = 0; bj < NBJ; ++bj) { const f32x4 v0 = (acc[ai][bj][m][0] + bv[bj][0]) * gt, v1 = (acc[ai][bj][m][1] + bv[bj][1]) * gt;
                    u32x4 w; w.x = cvt_pk_bf16(v0[0], v0[1]); w.y = cvt_pk_bf16(v0[2], v0[3]); w.z = cvt_pk_bf16(v1[0], v1[1]); w.w = cvt_pk_bf16(v1[2], v1[3]);
                    *(u32x4*)(rowp + bj * HALF) = w; } }
    }
};
struct EpiSwiglu8 {
    static constexpr bool PERM = true;
    unsigned char* O; const float* bias; float sc; PG8_LAS unsigned char* lds;
    __device__ __forceinline__ void prefetch(const Unit& u, int par, PG8_LAS unsigned char* l, int wid, int) const {
        const int lane = fresh_lane();
        if (wid < 4) __builtin_amdgcn_global_load_lds((const unsigned*)(bias + (size_t)u.e * 4096 + u.pn * BM + wid * 64 + lane), (PG8_LAS unsigned*)(l + 131072 + par * 1024 + wid * 256), 4, 0, 0);
    }
    __device__ __forceinline__ void operator()(const f32x4 (&acc)[2][2][4][2], const Unit& u, int wr, int wc, int fr, int fq) const { apply<2>(acc, u, wr, wc, fr, fq, 0); }
    __device__ __forceinline__ void half(const f32x4 (&acc)[2][2][4][2], const Unit& u, int wr, int wc, int fr, int fq) const { apply<1>(acc, u, wr, wc, fr, fq, u.hn * HALF); }
    template <int NBJ> __device__ __forceinline__ void apply(const f32x4 (&acc)[2][2][4][2], const Unit& u, int wr, int wc, int fr, int fq, int cofs) const {
        const int row0 = u.pm * BM + wr * 64 + fr; const int col0 = u.pn * BM + cofs + wc * 32 + 8 * fq;
        const PG8_LAS float* bp = (const PG8_LAS float*)(lds + 131072 + u.par * 1024) + cofs + wc * 32 + 8 * fq;
        f32x4 bv[2][2];
#pragma unroll
        for (int bj = 0; bj < NBJ; ++bj)
#pragma unroll
            for (int n = 0; n < 2; ++n) bv[bj][n] = *(const PG8_LAS f32x4*)(bp + bj * HALF + 4 * n);
#pragma unroll
        for (int ai = 0; ai < 2; ++ai)
#pragma unroll
            for (int m = 0; m < 4; ++m) { unsigned char* rowp = O + (size_t)(row0 + ai * HALF + m * 16) * 2048 + (col0 >> 1);
#pragma unroll
                for (int bj = 0; bj < NBJ; ++bj) { const f32x4 v0 = acc[ai][bj][m][0] * sc + bv[bj][0], v1 = acc[ai][bj][m][1] * sc + bv[bj][1];
                    int w = __builtin_amdgcn_cvt_pk_fp8_f32(swiglu1(v0[0], v0[1]), swiglu1(v0[2], v0[3]), 0, false);
                    w = __builtin_amdgcn_cvt_pk_fp8_f32(swiglu1(v1[0], v1[1]), swiglu1(v1[2], v1[3]), w, true);
                    *(int*)(rowp + bj * (HALF / 2)) = w; } }
    }
};
struct EpiDown8 {
    static constexpr bool PERM = true;
    bf16_t* O; const float* bias; const float* gate; float sc; PG8_LAS unsigned char* lds;
    __device__ __forceinline__ void prefetch(const Unit& u, int par, PG8_LAS unsigned char* l, int wid, int) const {
        const int lane = fresh_lane();
        if (wid < 4) __builtin_amdgcn_global_load_lds((const unsigned*)(bias + (size_t)u.e * 2048 + u.pn * BM + wid * 64 + lane), (PG8_LAS unsigned*)(l + 131072 + par * 1024 + wid * 256), 4, 0, 0);
        else __builtin_amdgcn_global_load_lds((const unsigned*)(gate + (size_t)u.e * 8192 + u.lm * BM + (wid - 4) * 64 + lane), (PG8_LAS unsigned*)(l + 133120 + par * 1024 + (wid - 4) * 256), 4, 0, 0);
    }
    __device__ __forceinline__ void operator()(const f32x4 (&acc)[2][2][4][2], const Unit& u, int wr, int wc, int fr, int fq) const { apply<2>(acc, u, wr, wc, fr, fq, 0); }
    __device__ __forceinline__ void half(const f32x4 (&acc)[2][2][4][2], const Unit& u, int wr, int wc, int fr, int fq) const { apply<1>(acc, u, wr, wc, fr, fq, u.hn * HALF); }
    template <int NBJ> __device__ __forceinline__ void apply(const f32x4 (&acc)[2][2][4][2], const Unit& u, int wr, int wc, int fr, int fq, int cofs) const {
        const int lrow0 = u.lm * BM + wr * 64 + fr;
        const int row0 = u.pm * BM + wr * 64 + fr; const int col0 = u.pn * BM + cofs + wc * 32 + 8 * fq;
        const PG8_LAS float* bp = (const PG8_LAS float*)(lds + 131072 + u.par * 1024) + cofs + wc * 32 + 8 * fq; const PG8_LAS float* gp = (const PG8_LAS float*)(lds + 133120 + u.par * 1024) + wr * 64 + fr;
        f32x4 bv[2][2];
#pragma unroll
        for (int bj = 0; bj < NBJ; ++bj)
#pragma unroll
            for (int n = 0; n < 2; ++n) bv[bj][n] = *(const PG8_LAS f32x4*)(bp + bj * HALF + 4 * n);
#pragma unroll
        for (int ai = 0; ai < 2; ++ai)
#pragma unroll
            for (int m = 0; m < 4; ++m) { bf16_t* rowp = O + (size_t)(row0 + ai * HALF + m * 16) * 2048 + col0; const float gt = gp[ai * HALF + m * 16];
#pragma unroll
                for (int bj = 0; bj < NBJ; ++bj) { const f32x4 v0 = (acc[ai][bj][m][0] * sc + bv[bj][0]) * gt, v1 = (acc[ai][bj][m][1] * sc + bv[bj][1]) * gt;
                    u32x4 w; w.x = cvt_pk_bf16(v0[0], v0[1]); w.y = cvt_pk_bf16(v0[2], v0[3]); w.z = cvt_pk_bf16(v1[0], v1[1]); w.w = cvt_pk_bf16(v1[2], v1[3]);
                    *(u32x4*)(rowp + bj * HALF) = w; } }
    }
};
}
namespace fk {
constexpr int NWAVES = 8, NTHR = 512;
constexpr int S_ = 2048, D_ = 2048, T_ = 8192, INW = 5120, RW = 1024, NH = 8, DH = 128, NE = 32, FF = 2048, NCH = 16;
constexpr float ALPHA = 1.189207115002721f;
constexpr float LOG2E = 1.4426950408889634f;

constexpr size_t MiB = 1ull << 20;
constexpr size_t WS_CTL = 0, CTL_ZERO_BYTES = 1 * MiB;
constexpr size_t WS_WIN_T = 2 * MiB, WS_WOUT_T = 22 * MiB, WS_POOLW_T = 30 * MiB, WS_ROPE = 31 * MiB, WS_XB = 32 * MiB, WS_PROJB = 64 * MiB,
                 WS_KVT = 144 * MiB, WS_PB = 176 * MiB, WS_MIXEDB = 192 * MiB, WS_MIX = 224 * MiB, WS_H = 288 * MiB, WS_HB = 352 * MiB,
                 WS_STOK = 384 * MiB, WS_SGATE = 385 * MiB, WS_TOKE = 386 * MiB, WS_TOKR = 387 * MiB, WS_ACTB = 392 * MiB, WS_OUTS = 552 * MiB,
                 WS_WGU_T = 768 * MiB, WS_WD_T = 1280 * MiB, WS_END = 1536 * MiB;
constexpr size_t WS_HB8 = 768 * MiB, WS_ACT8 = 800 * MiB, WS_WGU8 = 1024 * MiB, WS_WD8 = 1280 * MiB;
constexpr int PAD_ROWS = 40960;
constexpr int CW_TMO = 0, CW_CODE = 1, CW_BAR = 4096, CW_CNT = 8192, CW_XSYNC = 12288;

constexpr int RING_BYTES = 131072;
constexpr int RT_LD = 136, RT_BYTES = 128 * RT_LD * 2;
constexpr int REG0 = 0, REG1 = RT_BYTES, REG2 = 2 * RT_BYTES, REG3 = 3 * RT_BYTES;
constexpr int LDSCTL_OFF = 4 * RT_BYTES;
constexpr int MISC_OFF = LDSCTL_OFF, TS_OFF = LDSCTL_OFF + 256, TOKBUF_OFF = LDSCTL_OFF + 1024, EX_OFF = LDSCTL_OFF + 3072;
constexpr int LDS_BYTES = 147456;
static_assert(LDSCTL_OFF >= RING_BYTES && EX_OFF + 2048 <= LDS_BYTES, "LDS map");

#define GAS __attribute__((address_space(1)))
#define LAS __attribute__((address_space(3)))
typedef unsigned short bf16;
typedef unsigned v4u __attribute__((ext_vector_type(4)));
typedef unsigned v2u __attribute__((ext_vector_type(2)));
typedef float f32x4 __attribute__((ext_vector_type(4)));
typedef float f32x2 __attribute__((ext_vector_type(2)));
typedef short bf16x8 __attribute__((ext_vector_type(8)));
typedef GAS unsigned gu32;
#define RLX_AGENT __ATOMIC_RELAXED, __HIP_MEMORY_SCOPE_AGENT
#define LDS_WAIT() asm volatile("s_waitcnt lgkmcnt(0)" ::: "memory")
#define VM_WAIT() asm volatile("s_waitcnt vmcnt(0)" ::: "memory")
__device__ __forceinline__ unsigned f2bf(float f) { unsigned u = __builtin_bit_cast(unsigned, f); return (u + 0x7fffu + ((u >> 16) & 1u)) >> 16; }
__device__ __forceinline__ unsigned pk2(float lo, float hi) { unsigned r; asm("v_cvt_pk_bf16_f32 %0, %1, %2" : "=v"(r) : "v"(lo), "v"(hi)); return r; }
__device__ __forceinline__ float bflo(unsigned w) { return __builtin_bit_cast(float, w << 16); }
__device__ __forceinline__ float bfhi(unsigned w) { return __builtin_bit_cast(float, w & 0xffff0000u); }

#define XB_TMO      128
#define XB_XCNT(j)  (256  + 64 * (j))
#define XB_XSUB(j)  (1280 + 64 * (j))
#define XB_XGEN(j)  (2304 + 64 * (j))
#define XB_TOP      3328
#define XB_TOPGEN   3392
#define XCD_BAR_WORDS 3456
#define XB_SPIN_CAP (1u << 18)
__device__ __forceinline__ unsigned xb_ld(unsigned* p)              { return __hip_atomic_load(p, __ATOMIC_RELAXED, __HIP_MEMORY_SCOPE_AGENT); }
__device__ __forceinline__ unsigned xb_add(unsigned* p, unsigned v) { return __hip_atomic_fetch_add(p, v, __ATOMIC_RELAXED, __HIP_MEMORY_SCOPE_AGENT); }
__device__ __forceinline__ unsigned xb_xcc_id() { return (unsigned)__builtin_amdgcn_s_getreg((3 << 11) | 20) & 0xFu; }
#define XB_SPIN(cond, bar) do { unsigned _sp = 0; while (cond) { __builtin_amdgcn_s_sleep(1); \
    if ((++_sp & 255u) == 0u) { if (xb_ld(&(bar)[XB_TMO])) break; if (_sp > XB_SPIN_CAP) { atomicAdd(&(bar)[XB_TMO], 1u); break; } } } } while (0)
struct XcdBarrier { unsigned* bar; unsigned x; volatile LAS unsigned* st; int wave; };
__device__ __forceinline__ XcdBarrier xcd_barrier_post(unsigned* bar, volatile LAS unsigned* st) {
    XcdBarrier b; b.bar = bar; b.x = xb_xcc_id(); b.st = st; b.wave = __builtin_amdgcn_readfirstlane(threadIdx.x >> 6);
    if (threadIdx.x == 0) st[2] = xb_add(&bar[XB_XCNT(b.x)], 1u);
    return b;
}
__device__ __forceinline__ void xcd_barrier_complete(unsigned* bar, unsigned x, unsigned& nloc, unsigned& nx) {
    const unsigned G = gridDim.x * gridDim.y * gridDim.z;
    unsigned sum, cnt, mine, sp = 0u;
    for (;;) {
        sum = 0u; cnt = 0u; mine = 0u;
#pragma unroll
        for (unsigned j = 0; j < 16; ++j) { const unsigned c = xb_ld(&bar[XB_XCNT(j)]); sum += c; cnt += (c > 0u) ? 1u : 0u; mine = (j == x) ? c : mine; }
        if (sum == G) break;
        __builtin_amdgcn_s_sleep(1);
        if ((++sp & 255u) == 0u) { if (xb_ld(&bar[XB_TMO])) break; if (sp > XB_SPIN_CAP) { atomicAdd(&bar[XB_TMO], 1u); break; } }
    }
    nloc = mine > 0u ? mine : 1u; nx = cnt > 0u ? cnt : 1u;
}
__device__ __forceinline__ void xcd_barrier(const XcdBarrier& b) {
    asm volatile("s_waitcnt vmcnt(0)" ::: "memory");
    __syncthreads();
    if (b.wave == 0 && pg8::fresh_lane() == 0) {
        unsigned* bar = b.bar;
        __builtin_amdgcn_s_waitcnt(0);
        unsigned nloc = b.st[0], nx = b.st[1];
        if (nloc == 0u) { xcd_barrier_complete(bar, b.x, nloc, nx); b.st[0] = nloc; b.st[1] = nx; }
        const unsigned old = xb_add(&bar[XB_XSUB(b.x)], 1u);
        const unsigned gen = old / nloc;
        if (old + 1u == (gen + 1u) * nloc) {
            __builtin_amdgcn_fence(__ATOMIC_RELEASE, "agent");
            asm volatile("s_waitcnt vmcnt(0)" ::: "memory");
            const unsigned og = xb_add(&bar[XB_TOP], 1u);
            const unsigned tg = og / nx;
            if (og + 1u == (tg + 1u) * nx) xb_add(&bar[XB_TOPGEN], 1u);
            else XB_SPIN(xb_ld(&bar[XB_TOPGEN]) == tg, bar);
            __builtin_amdgcn_fence(__ATOMIC_ACQUIRE, "agent");
            xb_add(&bar[XB_XGEN(b.x)], 1u);
            asm volatile("s_waitcnt vmcnt(0)" ::: "memory");
        } else {
            XB_SPIN(xb_ld(&bar[XB_XGEN(b.x)]) == gen, bar);
            __builtin_amdgcn_fence(__ATOMIC_ACQUIRE, "agent");
            asm volatile("s_waitcnt vmcnt(0)" ::: "memory");
        }
    }
    __syncthreads();
}

struct Frame {
    LAS unsigned char* lds;
    unsigned* ctl;
    int wave, G, bx, cntoff;
    const float *x, *w_in, *gn_gain, *pool_w, *pool_scale, *w_out, *ln1g, *ln1b, *rw, *rb, *wgu, *bgu, *wd, *bd, *ln2g, *ln2b;
    float* out;
    bf16 *WinT, *WoutT, *PoolT, *XB, *PROJB, *PB, *MIXEDB, *HB, *ACTB, *OUTS, *WguT, *WdT;
    float *ROPE, *KVT, *MIX, *H, *SGATE;
    int *STOK, *TOKE, *TOKR;
    unsigned char *HB8, *ACT8, *Wgu8, *Wd8;
};
__device__ __forceinline__ float wave_sum(float v) {
#pragma unroll
    for (int o = 1; o < 64; o <<= 1) v += __shfl_xor(v, o);
    return v;
}

__device__ __forceinline__ void p0_transpose_item(const float* W, int K, int N, bf16* WT, int item, int wave, int lane) {
    const int nblk = N / 256, kb = item / nblk, nb = item % nblk, k0 = 64 * kb, n0 = 256 * nb;
    const int n4 = (lane & 15) + 16 * (wave & 3), kq = (lane >> 4) + 4 * (wave >> 2);
    const float* src = W + (size_t)(k0 + kq * 8) * N + n0 + 4 * n4;
    f32x4 r[8];
#pragma unroll
    for (int q = 0; q < 8; ++q) r[q] = *(const GAS f32x4*)(src + (size_t)q * N);
    bf16* dst = WT + (size_t)(n0 + 4 * n4) * K + k0 + kq * 8;
#pragma unroll
    for (int c = 0; c < 4; ++c) { v4u o; o.x = pk2(r[0][c], r[1][c]); o.y = pk2(r[2][c], r[3][c]); o.z = pk2(r[4][c], r[5][c]); o.w = pk2(r[6][c], r[7][c]);
        *(GAS v4u*)(dst + (size_t)c * K) = o; }
}
__device__ __forceinline__ void p0_cvt8_load(const float* W, int N, int item, int wave, int lane, f32x4 (&r)[8]) {
    const int nblk = N / 128, kb = item / nblk, nb = item % nblk;
    const int n4 = (lane & 15) + 16 * (wave & 1), kq = (lane >> 4) + 4 * (wave >> 1);
    const float* src = W + (size_t)(128 * kb + kq * 8) * N + 128 * nb + 4 * n4;
#pragma unroll
    for (int q = 0; q < 8; ++q) r[q] = __builtin_nontemporal_load((const GAS f32x4*)(src + (size_t)q * N));
}
__device__ __forceinline__ void p0_cvt8_store(unsigned char* WT, int K, int N, int item, int wave, int lane, const f32x4 (&r)[8], float scale) {
    const int nblk = N / 128, kb = item / nblk, nb = item % nblk;
    const int n4 = (lane & 15) + 16 * (wave & 1), kq = (lane >> 4) + 4 * (wave >> 1);
    unsigned char* dst = WT + (size_t)(128 * nb + 4 * n4) * K + 128 * kb + kq * 8;
#pragma unroll
    for (int c = 0; c < 4; ++c) {
        int lo = __builtin_amdgcn_cvt_pk_fp8_f32(r[0][c] * scale, r[1][c] * scale, 0, false); lo = __builtin_amdgcn_cvt_pk_fp8_f32(r[2][c] * scale, r[3][c] * scale, lo, true);
        int hi = __builtin_amdgcn_cvt_pk_fp8_f32(r[4][c] * scale, r[5][c] * scale, 0, false); hi = __builtin_amdgcn_cvt_pk_fp8_f32(r[6][c] * scale, r[7][c] * scale, hi, true);
        *(GAS v2u*)(dst + (size_t)c * K) = (v2u){(unsigned)lo, (unsigned)hi}; }
}
__device__ __forceinline__ void p0_cvt8_experts(const float* W, unsigned char* WT, int N, int bx, int G, int wave, int lane) {
    const int per = (D_ / 128) * (N / 128), total = 32 * per;
    for (int it = bx; it < total; it += 2 * G) {
        const int it2 = it + G; const bool two = it2 < total;
        const int e0 = it / per, i0 = it % per, e1 = two ? it2 / per : e0, i1 = two ? it2 % per : i0;
        f32x4 r0[8], r1[8];
        p0_cvt8_load(W + (size_t)e0 * D_ * N, N, i0, wave, lane, r0);
        p0_cvt8_load(W + (size_t)e1 * D_ * N, N, i1, wave, lane, r1);
        p0_cvt8_store(WT + (size_t)e0 * D_ * N, D_, N, i0, wave, lane, r0, 64.0f);
        if (two) p0_cvt8_store(WT + (size_t)e1 * D_ * N, D_, N, i1, wave, lane, r1, 64.0f);
    }
}
__device__ __forceinline__ void p0_prologue(Frame& F) {
    const int lane = pg8::fresh_lane(), tid = F.wave * 64 + lane;
    constexpr int I_IN = (D_ / 64) * (INW / 256);
    for (int it = F.bx; it < I_IN; it += F.G) p0_transpose_item(F.w_in, D_, INW, F.WinT, it, F.wave, lane);
    const int gt = F.bx * NTHR + tid, NGT = F.G * NTHR;
    for (int i = gt; i < T_ * D_ / 8; i += NGT) {
        const f32x4 a = *(const GAS f32x4*)(F.x + (size_t)i * 8), b = *(const GAS f32x4*)(F.x + (size_t)i * 8 + 4);
        v4u o; o.x = pk2(a.x, a.y); o.y = pk2(a.z, a.w); o.z = pk2(b.x, b.y); o.w = pk2(b.z, b.w);
        *(GAS v4u*)(F.XB + (size_t)i * 8) = o;
    }
}
__device__ __forceinline__ void p0_late(Frame& F, int r, int nw) {
    const int lane = pg8::fresh_lane(), tid = F.wave * 64 + lane;
    constexpr int I_OUT = (D_ / 64) * (D_ / 256), I_POOL = 4 * (256 / 64);
    for (int it = r; it < I_OUT + I_POOL; it += nw) {
        if (it < I_OUT) { p0_transpose_item(F.w_out, D_, D_, F.WoutT, it, F.wave, lane); continue; }
        const int q = it - I_OUT, g = q >> 2; p0_transpose_item(F.pool_w + (size_t)g * 65536, 256, 256, F.PoolT + (size_t)g * 65536, q & 3, F.wave, lane);
    }
    for (int i = r * NTHR + tid; i < S_ * 64; i += nw * NTHR) {
        const int pos = i >> 6, fi = i & 63;
        const float inv = powf(10000.0f, -(float)fi / 64.0f);
        float sn, cs; sincosf((float)pos * inv, &sn, &cs);
        *(GAS f32x2*)(F.ROPE + (size_t)i * 2) = (f32x2){cs, sn};
    }
}

__device__ __forceinline__ void rt_mma128(f32x4 (&acc)[2][4], const LAS unsigned char* Mop, const LAS unsigned char* Nop, int m0, int n0, int fr, int fq) {
#pragma unroll
    for (int ks = 0; ks < 4; ++ks) {
        bf16x8 a[2], b[4];
#pragma unroll
        for (int mi = 0; mi < 2; ++mi) a[mi] = *(const LAS bf16x8*)(Mop + ((m0 + mi * 16 + fr) * RT_LD + ks * 32 + fq * 8) * 2);
#pragma unroll
        for (int ni = 0; ni < 4; ++ni) b[ni] = *(const LAS bf16x8*)(Nop + ((n0 + ni * 16 + fr) * RT_LD + ks * 32 + fq * 8) * 2);
#pragma unroll
        for (int mi = 0; mi < 2; ++mi)
#pragma unroll
            for (int ni = 0; ni < 4; ++ni) acc[mi][ni] = __builtin_amdgcn_mfma_f32_16x16x32_bf16(b[ni], a[mi], acc[mi][ni], 0, 0, 0);
    }
}
__device__ __forceinline__ void rt_stage_vt(Frame& F, int tid, LAS unsigned char* dst, int tok0, int h) {
    const int rp = tid & 63;
#pragma unroll
    for (int it = 0; it < 2; ++it) {
        const int cg = (tid >> 6) + 8 * it;
        const bf16* p = F.PROJB + (size_t)(tok0 + 2 * rp) * INW + 2 * RW + h * DH + cg * 8;
        const v4u a = *(const GAS v4u*)p, b = *(const GAS v4u*)(p + INW);
        const unsigned aw[4] = {a.x, a.y, a.z, a.w}, bw[4] = {b.x, b.y, b.z, b.w};
#pragma unroll
        for (int j = 0; j < 4; ++j) {
            *(LAS unsigned*)(dst + ((cg * 8 + 2 * j) * RT_LD + 2 * rp) * 2) = (aw[j] & 0xffffu) | (bw[j] << 16);
            *(LAS unsigned*)(dst + ((cg * 8 + 2 * j + 1) * RT_LD + 2 * rp) * 2) = (aw[j] >> 16) | (bw[j] & 0xffff0000u);
        }
    }
}
__device__ __forceinline__ void unpack8(const v4u v, float (&o)[8]) {
    o[0] = bflo(v.x); o[1] = bfhi(v.x); o[2] = bflo(v.y); o[3] = bfhi(v.y); o[4] = bflo(v.z); o[5] = bfhi(v.z); o[6] = bflo(v.w); o[7] = bfhi(v.w);
}
__device__ __forceinline__ void rot8(const float (&t1)[8], const float (&t2)[8], const float* rp, float sc, float (&o1)[8], float (&o2)[8]) {
#pragma unroll
    for (int q = 0; q < 4; ++q) { const f32x4 cs = *(const GAS f32x4*)(rp + 4 * q);
        o1[2 * q] = (t1[2 * q] * cs.x - t2[2 * q] * cs.y) * sc; o2[2 * q] = (t1[2 * q] * cs.y + t2[2 * q] * cs.x) * sc;
        o1[2 * q + 1] = (t1[2 * q + 1] * cs.z - t2[2 * q + 1] * cs.w) * sc; o2[2 * q + 1] = (t1[2 * q + 1] * cs.w + t2[2 * q + 1] * cs.z) * sc; }
}

__device__ __forceinline__ void r1_unit(Frame& F, int unit) {
    const int lane = pg8::fresh_lane(), tid = F.wave * 64 + lane;
    const int h = (unit >> 4) & 7, n = unit & 15, b = unit >> 7, tok0 = b * S_ + n * 128;
    const float log2g = log2f(1.0f - exp2f(-5.0f - (float)h));
    LAS unsigned char* ZKt = F.lds + REG1; LAS unsigned char* Vt = F.lds + REG2;
    {
        const int rp = tid & 63, ig = tid >> 6;
        float k1[2][8], k2[2][8];
#pragma unroll
        for (int rr = 0; rr < 2; ++rr) {
            const int r = 2 * rp + rr;
            const bf16* p = F.PROJB + (size_t)(tok0 + r) * INW + RW + h * DH + ig * 8;
            float t1[8], t2[8]; unpack8(*(const GAS v4u*)p, t1); unpack8(*(const GAS v4u*)(p + 64), t2);
            const float sc = 0.08838834764831845f * exp2f(log2g * (float)(127 - r));
            rot8(t1, t2, F.ROPE + (size_t)(n * 128 + r) * 128 + ig * 16, sc, k1[rr], k2[rr]);
        }
#pragma unroll
        for (int j = 0; j < 8; ++j) {
            *(LAS unsigned*)(ZKt + ((ig * 8 + j) * RT_LD + 2 * rp) * 2) = pk2(k1[0][j], k1[1][j]);
            *(LAS unsigned*)(ZKt + ((64 + ig * 8 + j) * RT_LD + 2 * rp) * 2) = pk2(k2[0][j], k2[1][j]);
        }
    }
    rt_stage_vt(F, tid, Vt, tok0, h);
    __syncthreads();
    const int fr = lane & 15, fq = lane >> 4, m0 = (F.wave >> 1) * 32, n0 = (F.wave & 1) * 64;
    f32x4 acc[2][4];
#pragma unroll
    for (int mi = 0; mi < 2; ++mi)
#pragma unroll
        for (int ni = 0; ni < 4; ++ni) acc[mi][ni] = (f32x4){0.f, 0.f, 0.f, 0.f};
    rt_mma128(acc, Vt, ZKt, m0, n0, fr, fq);
    bf16* dst = (bf16*)F.KVT + (size_t)unit * 16384;
    asm volatile("s_nop 15\n\ts_nop 15" : "+v"(acc[0][0]), "+v"(acc[0][1]), "+v"(acc[0][2]), "+v"(acc[0][3]), "+v"(acc[1][0]), "+v"(acc[1][1]), "+v"(acc[1][2]), "+v"(acc[1][3]));
#pragma unroll
    for (int mi = 0; mi < 2; ++mi)
#pragma unroll
        for (int ni = 0; ni < 4; ++ni) { v2u w; w.x = pk2(acc[mi][ni].x, acc[mi][ni].y); w.y = pk2(acc[mi][ni].z, acc[mi][ni].w);
            *(GAS v2u*)(dst + (m0 + mi * 16 + fr) * 128 + n0 + ni * 16 + fq * 4) = w; }
    __syncthreads();
}
template <int W> __device__ __forceinline__ void pool_item(Frame& F, int tok, int g, int cgl) {
    const int t = tok & (S_ - 1), c0 = g * 256 + cgl * 8;
    const bf16* up = F.PROJB + (size_t)tok * INW + 4 * RW + c0;
    v4u raw[W];
#pragma unroll
    for (int q = 0; q < W; ++q) { const int qq = q <= t ? q : 0; raw[q] = *(const GAS v4u*)(up - (size_t)qq * INW); }
    float s[8], u0[8];
    unpack8(raw[0], u0);
#pragma unroll
    for (int j = 0; j < 8; ++j) s[j] = u0[j];
#pragma unroll
    for (int q = 1; q < W; ++q) { float v[8]; unpack8(raw[q], v); const float wq = q <= t ? 1.0f : 0.0f;
#pragma unroll
        for (int j = 0; j < 8; ++j) s[j] = fmaf(wq, v[j], s[j]); }
    const float rn = 1.0f / (float)((t + 1 < W) ? t + 1 : W);
    v4u o; o.x = pk2(s[0] * rn - u0[0], s[1] * rn - u0[1]); o.y = pk2(s[2] * rn - u0[2], s[3] * rn - u0[3]);
    o.z = pk2(s[4] * rn - u0[4], s[5] * rn - u0[5]); o.w = pk2(s[6] * rn - u0[6], s[7] * rn - u0[7]);
    *(GAS v4u*)(F.PB + ((size_t)g * T_ + tok) * 256 + cgl * 8) = o;
}
__device__ __forceinline__ void pool_means(Frame& F) {
    const int gt = F.bx * NTHR + F.wave * 64 + pg8::fresh_lane(), NGT = F.G * NTHR;
    for (int it = gt; it < T_ * 128; it += NGT) {
        const int cgl = it & 31, tok = ((it >> 8) << 1) | ((it >> 5) & 1), g = __builtin_amdgcn_readfirstlane((it >> 6) & 3);
        if (g == 0) pool_item<2>(F, tok, 0, cgl); else if (g == 1) pool_item<4>(F, tok, 1, cgl); else if (g == 2) pool_item<8>(F, tok, 2, cgl); else pool_item<16>(F, tok, 3, cgl);
    }
}

__device__ __forceinline__ void r3_unit(Frame& F, int unit) {
    const int lane = pg8::fresh_lane(), tid = F.wave * 64 + lane;
    const int h = (unit >> 4) & 7, n = unit & 15, b = unit >> 7, tok0 = b * S_ + n * 128;
    const float log2g = log2f(1.0f - exp2f(-5.0f - (float)h));
    LAS unsigned char* Qs = F.lds + REG0; LAS unsigned char* Ks = F.lds + REG1; LAS unsigned char* Vt = F.lds + REG2; LAS unsigned char* Rt = F.lds + REG3;
    LAS float* EX = (LAS float*)(F.lds + EX_OFF);
#pragma unroll
    for (int it = 0; it < 2; ++it) {
        const int item = tid + 512 * it, r = item >> 3, ig = item & 7;
        const bf16* pq = F.PROJB + (size_t)(tok0 + r) * INW + h * DH + ig * 8;
        const float* rp = F.ROPE + (size_t)(n * 128 + r) * 128 + ig * 16;
        float t1[8], t2[8], o1[8], o2[8];
        unpack8(*(const GAS v4u*)pq, t1); unpack8(*(const GAS v4u*)(pq + 64), t2);
        rot8(t1, t2, rp, 1.0f, o1, o2);
        v4u w1, w2; w1.x = pk2(o1[0], o1[1]); w1.y = pk2(o1[2], o1[3]); w1.z = pk2(o1[4], o1[5]); w1.w = pk2(o1[6], o1[7]);
        w2.x = pk2(o2[0], o2[1]); w2.y = pk2(o2[2], o2[3]); w2.z = pk2(o2[4], o2[5]); w2.w = pk2(o2[6], o2[7]);
        *(LAS v4u*)(Qs + (r * RT_LD + ig * 8) * 2) = w1; *(LAS v4u*)(Qs + (r * RT_LD + 64 + ig * 8) * 2) = w2;
        unpack8(*(const GAS v4u*)(pq + RW), t1); unpack8(*(const GAS v4u*)(pq + RW + 64), t2);
        rot8(t1, t2, rp, 0.08838834764831845f, o1, o2);
        w1.x = pk2(o1[0], o1[1]); w1.y = pk2(o1[2], o1[3]); w1.z = pk2(o1[4], o1[5]); w1.w = pk2(o1[6], o1[7]);
        w2.x = pk2(o2[0], o2[1]); w2.y = pk2(o2[2], o2[3]); w2.z = pk2(o2[4], o2[5]); w2.w = pk2(o2[6], o2[7]);
        *(LAS v4u*)(Ks + (r * RT_LD + ig * 8) * 2) = w1; *(LAS v4u*)(Ks + (r * RT_LD + 64 + ig * 8) * 2) = w2;
    }
    rt_stage_vt(F, tid, Vt, tok0, h);
    {
        const float gch = exp2f(log2g * 128.0f);
        f32x4 R[8];
#pragma unroll
        for (int i = 0; i < 8; ++i) R[i] = (f32x4){0.f, 0.f, 0.f, 0.f};
        const bf16* src = (const bf16*)F.KVT + (size_t)(unit - n) * 16384 + tid * 4;
        int m = 0;
        for (; m + 1 < n; m += 2) {
            v2u w0[8], w1[8];
#pragma unroll
            for (int i = 0; i < 8; ++i) { w0[i] = *(const GAS v2u*)(src + (size_t)m * 16384 + i * 2048); w1[i] = *(const GAS v2u*)(src + (size_t)(m + 1) * 16384 + i * 2048); }
#pragma unroll
            for (int i = 0; i < 8; ++i) { const f32x4 v0 = (f32x4){bflo(w0[i].x), bfhi(w0[i].x), bflo(w0[i].y), bfhi(w0[i].y)}, v1 = (f32x4){bflo(w1[i].x), bfhi(w1[i].x), bflo(w1[i].y), bfhi(w1[i].y)};
                R[i] = (R[i] * gch + v0) * gch + v1; }
        }
        if (m < n) {
#pragma unroll
            for (int i = 0; i < 8; ++i) { const v2u w = *(const GAS v2u*)(src + (size_t)m * 16384 + i * 2048);
                const f32x4 v = (f32x4){bflo(w.x), bfhi(w.x), bflo(w.y), bfhi(w.y)}; R[i] = R[i] * gch + v; }
        }
#pragma unroll
        for (int i = 0; i < 8; ++i) { const int f = i * 512 + tid, e = f >> 5, d4 = (f & 31) * 4;
            v2u w; w.x = pk2(R[i].x, R[i].y); w.y = pk2(R[i].z, R[i].w);
            *(LAS v2u*)(Rt + (e * RT_LD + d4) * 2) = w; }
    }
    __syncthreads();
    const int fr = lane & 15, fq = lane >> 4, m0 = (F.wave >> 1) * 32, n0 = (F.wave & 1) * 64;
    f32x4 acc[2][4];
#pragma unroll
    for (int mi = 0; mi < 2; ++mi)
#pragma unroll
        for (int ni = 0; ni < 4; ++ni) acc[mi][ni] = (f32x4){0.f, 0.f, 0.f, 0.f};
    rt_mma128(acc, Qs, Ks, m0, n0, fr, fq);
    __syncthreads();
#pragma unroll
    for (int mi = 0; mi < 2; ++mi)
#pragma unroll
        for (int ni = 0; ni < 4; ++ni) {
            const int c = m0 + mi * 16 + fr, mm = n0 + ni * 16 + fq * 4;
            float v[4];
#pragma unroll
            for (int j = 0; j < 4; ++j) v[j] = (mm + j <= c) ? acc[mi][ni][j] * exp2f(-log2g * (float)(mm + j + 1)) : 0.f;
            v2u w; w.x = pk2(v[0], v[1]); w.y = pk2(v[2], v[3]);
            *(LAS v2u*)(Ks + (c * RT_LD + mm) * 2) = w;
            acc[mi][ni] = (f32x4){0.f, 0.f, 0.f, 0.f};
        }
    __syncthreads();
    rt_mma128(acc, Ks, Vt, m0, n0, fr, fq);
    rt_mma128(acc, Qs, Rt, m0, n0, fr, fq);
    float mean[2], rstd[2];
#pragma unroll
    for (int mi = 0; mi < 2; ++mi) {
        const int c = m0 + mi * 16 + fr; const float xi = exp2f(log2g * (float)(c + 1)); float s = 0.f;
#pragma unroll
        for (int ni = 0; ni < 4; ++ni) { acc[mi][ni] = acc[mi][ni] * xi; s += (acc[mi][ni].x + acc[mi][ni].y) + (acc[mi][ni].z + acc[mi][ni].w); }
        s += __shfl_xor(s, 16); s += __shfl_xor(s, 32);
        if (fq == 0) EX[c * 2 + (F.wave & 1)] = s;
    }
    __syncthreads();
#pragma unroll
    for (int mi = 0; mi < 2; ++mi) {
        const int c = m0 + mi * 16 + fr; mean[mi] = (EX[c * 2] + EX[c * 2 + 1]) * (1.0f / 128.0f); float q = 0.f;
#pragma unroll
        for (int ni = 0; ni < 4; ++ni) { const f32x4 d = acc[mi][ni] - mean[mi]; q += (d.x * d.x + d.y * d.y) + (d.z * d.z + d.w * d.w); }
        q += __shfl_xor(q, 16); q += __shfl_xor(q, 32);
        if (fq == 0) EX[256 + c * 2 + (F.wave & 1)] = q;
    }
    __syncthreads();
#pragma unroll
    for (int mi = 0; mi < 2; ++mi) {
        const int c = m0 + mi * 16 + fr; rstd[mi] = 1.0f / sqrtf((EX[256 + c * 2] + EX[256 + c * 2 + 1]) * (1.0f / 128.0f) + 1e-6f);
#pragma unroll
        for (int ni = 0; ni < 4; ++ni) {
            const int e = n0 + ni * 16 + fq * 4;
            const v2u gw = *(const GAS v2u*)(F.PROJB + (size_t)(tok0 + c) * INW + 3 * RW + h * DH + e);
            const f32x4 gain = *(const GAS f32x4*)(F.gn_gain + h * DH + e);
            const float g[4] = {bflo(gw.x), bfhi(gw.x), bflo(gw.y), bfhi(gw.y)};
            float o[4];
#pragma unroll
            for (int j = 0; j < 4; ++j) { const float sg = g[j] / (1.0f + __expf(-g[j])); o[j] = sg * ((acc[mi][ni][j] - mean[mi]) * rstd[mi] * gain[j]); }
            v2u w; w.x = pk2(o[0], o[1]); w.y = pk2(o[2], o[3]);
            *(GAS v2u*)(F.MIXEDB + (size_t)(tok0 + c) * D_ + h * DH + e) = w;
        }
    }
    __syncthreads();
}
struct PoolOrder {
    int G, c; const bf16* Bt;
    __device__ __forceinline__ bool next(int i, pg8::Unit& u) const { const int L = i * G + c; if (L >= 128) return false; u.pm = L >> 2; u.e = L & 3; u.pn = 0; u.lm = u.pm; u.aux = 0; u.hn = 0; return true; }
    __device__ __forceinline__ int arow0(const pg8::Unit& u, int r) const { return u.e * T_ + u.pm * 256 + r; }
    __device__ __forceinline__ int arow1(const pg8::Unit& u, int r, int, LAS unsigned char*) const { return u.e * T_ + u.pm * 256 + r; }
    __device__ __forceinline__ void prefetch(const pg8::Unit&, int, LAS unsigned char*, int, int) const {}
    __device__ __forceinline__ void round_sync(int, int, int) const {}
    __device__ __forceinline__ const char* bbase(const pg8::Unit& u) const { return (const char*)Bt + (size_t)u.e * 65536 * 2; }
};
struct EpiPool {
    static constexpr bool PERM = true;
    bf16* O; const float* cscale;
    __device__ __forceinline__ void operator()(const f32x4 (&acc)[2][2][4][2], const pg8::Unit& u, int wr, int wc, int fr, int fq) const {
        const int row0 = u.pm * 256 + wr * 64 + fr; const int col0 = u.e * 256 + wc * 32 + 8 * fq;
        f32x4 sv[2][2];
#pragma unroll
        for (int bj = 0; bj < 2; ++bj)
#pragma unroll
            for (int n = 0; n < 2; ++n) sv[bj][n] = *(const f32x4*)(cscale + col0 + bj * 128 + 4 * n);
#pragma unroll
        for (int ai = 0; ai < 2; ++ai)
#pragma unroll
            for (int m = 0; m < 4; ++m) { bf16* rowp = O + (size_t)(row0 + ai * 128 + m * 16) * D_ + RW + col0;
#pragma unroll
                for (int bj = 0; bj < 2; ++bj) { const f32x4 v0 = acc[ai][bj][m][0] * sv[bj][0], v1 = acc[ai][bj][m][1] * sv[bj][1];
                    v4u w; w.x = pg8::cvt_pk_bf16(v0[0], v0[1]); w.y = pg8::cvt_pk_bf16(v0[2], v0[3]); w.z = pg8::cvt_pk_bf16(v1[0], v1[1]); w.w = pg8::cvt_pk_bf16(v1[2], v1[3]);
                    *(v4u*)(rowp + bj * 128) = w; } }
    }
};

__device__ __forceinline__ void ln1_router(Frame& F) {
    const int lane_outer = pg8::fresh_lane();
    LAS float* HT = (LAS float*)F.lds;
    LAS float* PART = (LAS float*)(F.lds + 65536);
    LAS int* PK_E = (LAS int*)(F.lds + 65536 + 8192);
    LAS float* PK_G = (LAS float*)(F.lds + 65536 + 8192 + 512);
    LAS unsigned* HIST = (LAS unsigned*)(F.lds + 65536 + 8192 + 1024);
    if (F.wave == 0) HIST[lane_outer] = 0u;
    const int lane0 = lane_outer;
    int it = 0, ntok = 0;
    f32x2 rwr[3][16];
    { const int e0 = lane0 & 31, hf0 = lane0 >> 5; const float* rwp0 = F.rw + (size_t)(F.wave * 256 + hf0 * 128) * 32 + e0;
#pragma unroll
      for (int c = 0; c < 3; ++c)
#pragma unroll
          for (int i = 0; i < 16; ++i) { rwr[c][i].x = rwp0[(c * 32 + 2 * i) * 32]; rwr[c][i].y = rwp0[(c * 32 + 2 * i + 1) * 32]; } }
    f32x4 xa[8]; v2u mb[8];
    {
        const int tok0 = F.bx * 8 + F.wave;
#pragma unroll
        for (int j = 0; j < 8; ++j) { xa[j] = *(const GAS f32x4*)(F.x + (size_t)tok0 * D_ + j * 256 + lane0 * 4); mb[j] = *(const GAS v2u*)((const bf16*)F.MIX + (size_t)tok0 * D_ + j * 256 + lane0 * 4); }
    }
    for (int task = F.bx; task < T_ / 8; task += F.G, ++it, ntok += 8) {
        int lane = lane0; asm volatile("" : "+v"(lane));
        const int tok = task * 8 + F.wave;
        {
            float v[32]; float s = 0.f;
#pragma unroll
            for (int j = 0; j < 8; ++j) { const f32x4 a = xa[j]; const v2u bw = mb[j];
                const f32x4 b = (f32x4){bflo(bw.x), bfhi(bw.x), bflo(bw.y), bfhi(bw.y)};
                v[4 * j] = ALPHA * a.x + b.x; v[4 * j + 1] = ALPHA * a.y + b.y; v[4 * j + 2] = ALPHA * a.z + b.z; v[4 * j + 3] = ALPHA * a.w + b.w;
                s += (v[4 * j] + v[4 * j + 1]) + (v[4 * j + 2] + v[4 * j + 3]); }
            if (task + F.G < T_ / 8) {
                const int tokn = (task + F.G) * 8 + F.wave;
#pragma unroll
                for (int j = 0; j < 8; ++j) { xa[j] = *(const GAS f32x4*)(F.x + (size_t)tokn * D_ + j * 256 + lane * 4); mb[j] = *(const GAS v2u*)((const bf16*)F.MIX + (size_t)tokn * D_ + j * 256 + lane * 4); }
            }
            const float mu = wave_sum(s) * (1.0f / D_); float q = 0.f;
#pragma unroll
            for (int j = 0; j < 32; ++j) { v[j] -= mu; q += v[j] * v[j]; }
            const float rstd = 1.0f / sqrtf(wave_sum(q) * (1.0f / D_) + 1e-5f);
#pragma unroll
            for (int j = 0; j < 8; ++j) { const int c = j * 256 + lane * 4;
                const f32x4 g = *(const GAS f32x4*)(F.ln1g + c), be = *(const GAS f32x4*)(F.ln1b + c);
                const f32x4 hv = (f32x4){v[4 * j] * rstd * g.x + be.x, v[4 * j + 1] * rstd * g.y + be.y, v[4 * j + 2] * rstd * g.z + be.z, v[4 * j + 3] * rstd * g.w + be.w};
                v2u w; w.x = pk2(hv.x, hv.y); w.y = pk2(hv.z, hv.w);
                *(GAS v2u*)(F.HB + (size_t)tok * D_ + c) = w;
                { int w8 = __builtin_amdgcn_cvt_pk_fp8_f32(hv.x, hv.y, 0, false); w8 = __builtin_amdgcn_cvt_pk_fp8_f32(hv.z, hv.w, w8, true); *(GAS int*)(F.HB8 + (size_t)tok * D_ + c) = w8; }
                *(LAS f32x4*)(HT + F.wave * 2048 + c) = hv; }
        }
        __syncthreads();
        const int e = lane & 31, hf = lane >> 5, k0 = F.wave * 256 + hf * 128;
        f32x2 acc2[8];
#pragma unroll
        for (int t = 0; t < 8; ++t) acc2[t] = (f32x2){0.f, 0.f};
        const float* rwp = F.rw + (size_t)k0 * 32 + e;
        f32x2 rc[16];
#define RT_LOAD(dst, c) _Pragma("unroll") for (int i = 0; i < 16; ++i) { dst[i].x = rwp[((c) * 32 + 2 * i) * 32]; dst[i].y = rwp[((c) * 32 + 2 * i + 1) * 32]; }
#define RT_COMP(src, c) _Pragma("unroll") for (int i4 = 0; i4 < 8; ++i4) { _Pragma("unroll") for (int t = 0; t < 8; ++t) { const f32x4 hv = *(const LAS f32x4*)(HT + t * 2048 + k0 + (c) * 32 + i4 * 4); \
            acc2[t] = __builtin_elementwise_fma((f32x2){hv.x, hv.y}, src[i4 * 2], acc2[t]); acc2[t] = __builtin_elementwise_fma((f32x2){hv.z, hv.w}, src[i4 * 2 + 1], acc2[t]); } \
            asm volatile("" : "+v"(acc2[0]), "+v"(acc2[1]), "+v"(acc2[2]), "+v"(acc2[3]), "+v"(acc2[4]), "+v"(acc2[5]), "+v"(acc2[6]), "+v"(acc2[7]) :: "memory"); }
        RT_LOAD(rc, 3) RT_COMP(rwr[0], 0) RT_COMP(rwr[1], 1) RT_COMP(rwr[2], 2) RT_COMP(rc, 3)
#undef RT_LOAD
#undef RT_COMP
        float acc[8];
#pragma unroll
        for (int t = 0; t < 8; ++t) { acc[t] = acc2[t].x + acc2[t].y; acc[t] += __shfl_xor(acc[t], 32); if (hf == 0) PART[(F.wave * 8 + t) * 32 + e] = acc[t]; }
        __syncthreads();
        float mine = F.rb[e];
#pragma unroll
        for (int sl = 0; sl < 8; ++sl) mine += PART[(sl * 8 + F.wave) * 32 + e];
        float tv[4]; int ti[4]; float cur = mine;
#pragma unroll
        for (int k = 0; k < 4; ++k) {
            float bv = cur; int bi = e;
#pragma unroll
            for (int o = 1; o < 32; o <<= 1) { const float ov = __shfl_xor(bv, o); const int oi = __shfl_xor(bi, o); if (ov > bv || (ov == bv && oi < bi)) { bv = ov; bi = oi; } }
            tv[k] = bv; ti[k] = bi;
            if (e == bi) cur = -INFINITY;
        }
        float ex[4], se = 0.f;
#pragma unroll
        for (int k = 0; k < 4; ++k) { ex[k] = __expf(tv[k] - tv[0]); se += ex[k]; }
        if (lane == 0) {
#pragma unroll
            for (int k = 0; k < 4; ++k) { PK_E[(it * 8 + F.wave) * 4 + k] = ti[k]; PK_G[(it * 8 + F.wave) * 4 + k] = ex[k] / se; }
        }
        __syncthreads();
    }
    const int tid = F.wave * 64 + lane_outer;
    int e_ = 0, lr = 0;
    if (tid < 128 && tid < 4 * ntok) { e_ = PK_E[tid]; lr = (int)__hip_atomic_fetch_add((LAS unsigned*)&HIST[e_], 1u, __ATOMIC_RELAXED, __HIP_MEMORY_SCOPE_WORKGROUP); }
    __syncthreads();
    if (tid < 32) { const unsigned c = HIST[tid]; HIST[32 + tid] = c ? __hip_atomic_fetch_add(F.ctl + F.cntoff + 64 * tid, c, RLX_AGENT) : 0u; }
    __syncthreads();
    if (tid < 128 && tid < 4 * ntok) {
        const int slot = tid >> 2, k = tid & 3, it = slot >> 3, w = slot & 7, tok = (F.bx + it * F.G) * 8 + w;
        const int r = (int)HIST[32 + e_] + lr;
        F.STOK[e_ * T_ + r] = tok; F.SGATE[e_ * T_ + r] = PK_G[tid]; F.TOKE[tok * 4 + k] = e_; F.TOKR[tok * 4 + k] = r;
    }
    __syncthreads();
}

__device__ __forceinline__ void build_ts(Frame& F) {
    LAS int* ts = (LAS int*)(F.lds + TS_OFF);
    const int tid = F.wave * 64 + pg8::fresh_lane();
    if (tid < 64) {
        const int e = tid & 31;
        const int c = (int)__hip_atomic_load(F.ctl + F.cntoff + 64 * e, RLX_AGENT);
        int incl = (c + 255) >> 8;
#pragma unroll
        for (int o = 1; o < 32; o <<= 1) { const int v = __shfl_up(incl, o, 32); if ((tid & 31) >= o) incl += v; }
        const int te = (c + 255) >> 8; int inf = te > 0 ? 1 : 0, inr = te > 0 ? te - 1 : 0;
#pragma unroll
        for (int o = 1; o < 32; o <<= 1) { const int v1 = __shfl_up(inf, o, 32), v2 = __shfl_up(inr, o, 32); if ((tid & 31) >= o) { inf += v1; inr += v2; } }
        if (tid < 32) { ts[e + 1] = incl; ts[40 + e] = c; ts[80 + e + 1] = inf; ts[120 + e + 1] = inr; if (e == 0) { ts[0] = 0; ts[80] = 0; ts[120] = 0; } }
    }
    __syncthreads();
}
template <int NN, bool GATHER> struct MoeOrder {
    const LAS int* ts; LAS unsigned char* tokbuf; const int* stok; const bf16* Bt; int G, c, nrowsB; const float* Wf;
    int tpo, lm0;
    unsigned* xs;
    int mode;
    int brow;
    __device__ __forceinline__ bool next(int i, pg8::Unit& u) const {
        const LAS int* tp = ts + tpo;
        const int TM = tp[32], nwg = TM * NN, full = (nwg / G) * G, rem = nwg - full; const bool use_half = rem > 0 && 2 * rem <= G;
        long L = (long)i * G + c; int hn = 0;
        if (mode == 2) { if (!use_half || L >= 2 * rem) return false; hn = (int)(L & 1); L = full + (L >> 1); }
        else if (L >= ((mode == 1 && use_half) ? full : nwg)) return false;
        int w = pg8::xcd_remap((int)L, nwg);
#if defined(PROBE_SCRAMBLE)
        if (mode == 0) w = (int)(((long)w * 37) % nwg);
#endif
        int e = 0;
        for (int k = 0; k < 31; ++k) { if (w >= tp[k + 1] * NN) e = k + 1; }
#if defined(ORDER_PN_FAST)
        const int te = tp[e + 1] - tp[e], r = w - tp[e] * NN, lm = lm0 + r / NN;
        u.e = __builtin_amdgcn_readfirstlane(e); u.pn = __builtin_amdgcn_readfirstlane(r % NN); u.lm = __builtin_amdgcn_readfirstlane(lm);
#else
        const int te = tp[e + 1] - tp[e], r = w - tp[e] * NN, lm = lm0 + r % te;
        u.e = __builtin_amdgcn_readfirstlane(e); u.pn = __builtin_amdgcn_readfirstlane(r / te); u.lm = __builtin_amdgcn_readfirstlane(lm);
#endif
        u.pm = __builtin_amdgcn_readfirstlane(ts[e] + lm); u.aux = __builtin_amdgcn_readfirstlane(ts[40 + e]); u.hn = __builtin_amdgcn_readfirstlane(hn); return true;
    }
    __device__ __forceinline__ void round_sync(int ui, int wid, int lane) const {
        if (!xs) return;
        const LAS int* tp = ts + tpo; const int nwg = tp[32] * NN, full = nwg / G, rem = nwg - full * G; const bool use_half = rem > 0 && 2 * rem <= G;
        const int nfull = (mode == 1 && !use_half && rem > 0) ? full : ((mode == 0 && rem > 0) ? full : full);
        if (ui >= nfull || (G & 7)) return;
        if (wid == 0 && lane == 0) {
            unsigned* w = xs + 64 * (c & 7); const unsigned want = (unsigned)(G >> 3) * (unsigned)ui;
            __hip_atomic_fetch_add(w, 1u, RLX_AGENT);
            unsigned sp = 0; while (__hip_atomic_load(w, RLX_AGENT) < want) { __builtin_amdgcn_s_sleep(1); if (++sp > (1u << 16)) break; }
        }
        __builtin_amdgcn_s_barrier();
    }
    __device__ __forceinline__ const char* wbbase(const pg8::Unit& u) const { return (const char*)Bt + ((size_t)u.e * nrowsB + (size_t)u.pn * 256) * 2048 * 2; }
    __device__ __forceinline__ int arow0(const pg8::Unit& u, int r) const {
        if (!GATHER) return u.pm * 256 + r;
        int rr = u.lm * 256 + r; rr = rr < u.aux ? rr : u.aux - 1; return stok[u.e * T_ + rr];
    }
    __device__ __forceinline__ void prefetch(const pg8::Unit& nx, int par, LAS unsigned char*, int wid, int lane) const {
        if (!GATHER) return;
        const int idx = (wid & 3) * 64 + pg8::fresh_lane();
        int rr = nx.lm * 256 + idx; rr = rr < nx.aux ? rr : nx.aux - 1;
        __builtin_amdgcn_global_load_lds((const unsigned*)(stok + nx.e * T_ + rr), (LAS unsigned*)(tokbuf + par * 1024 + (wid & 3) * 256), 4, 0, 0);
    }
    __device__ __forceinline__ int arow1(const pg8::Unit& u, int r, int par, LAS unsigned char*) const {
        if (!GATHER) return u.pm * 256 + r;
        return *(const LAS int*)(tokbuf + par * 1024 + r * 4);
    }
    __device__ __forceinline__ const char* bbase(const pg8::Unit& u) const {
        if (Wf) return (const char*)Wf + ((size_t)u.e * 2048 * nrowsB + (size_t)u.pn * 256 + (size_t)u.hn * 128) * 4;
        return (const char*)Bt + ((size_t)u.e * nrowsB + (size_t)u.pn * 256 + (size_t)u.hn * 128) * (size_t)brow; }
};

__device__ __forceinline__ void combine_ln2(Frame& F) {
    const LAS int* ts = (const LAS int*)(F.lds + TS_OFF);
    const int gw = F.bx * NWAVES + F.wave, NGW = F.G * NWAVES, lane = pg8::fresh_lane();
    for (int tok = gw; tok < T_; tok += NGW) {
        const bf16* p[4];
#pragma unroll
        for (int k = 0; k < 4; ++k) { const int e = F.TOKE[tok * 4 + k], r = F.TOKR[tok * 4 + k]; p[k] = F.OUTS + (size_t)(ts[e] * 256 + r) * D_; }
        float v[32]; float s = 0.f;
#pragma unroll
        for (int j = 0; j < 8; ++j) { const int c = j * 256 + lane * 4;
            const v2u hw = *(const GAS v2u*)(F.HB + (size_t)tok * D_ + c);
            const f32x4 hh = (f32x4){bflo(hw.x), bfhi(hw.x), bflo(hw.y), bfhi(hw.y)};
            float y[4] = {0.f, 0.f, 0.f, 0.f};
#pragma unroll
            for (int k = 0; k < 4; ++k) { const v2u w = *(const GAS v2u*)(p[k] + c); y[0] += bflo(w.x); y[1] += bfhi(w.x); y[2] += bflo(w.y); y[3] += bfhi(w.y); }
            v[4 * j] = ALPHA * hh.x + y[0]; v[4 * j + 1] = ALPHA * hh.y + y[1]; v[4 * j + 2] = ALPHA * hh.z + y[2]; v[4 * j + 3] = ALPHA * hh.w + y[3];
            s += (v[4 * j] + v[4 * j + 1]) + (v[4 * j + 2] + v[4 * j + 3]); }
        const float mu = wave_sum(s) * (1.0f / D_); float q = 0.f;
#pragma unroll
        for (int j = 0; j < 32; ++j) { v[j] -= mu; q += v[j] * v[j]; }
        const float rstd = 1.0f / sqrtf(wave_sum(q) * (1.0f / D_) + 1e-5f);
#pragma unroll
        for (int j = 0; j < 8; ++j) { const int c = j * 256 + lane * 4;
            const f32x4 g = *(const GAS f32x4*)(F.ln2g + c), be = *(const GAS f32x4*)(F.ln2b + c);
            *(GAS f32x4*)(F.out + (size_t)tok * D_ + c) = (f32x4){v[4 * j] * rstd * g.x + be.x, v[4 * j + 1] * rstd * g.y + be.y, v[4 * j + 2] * rstd * g.z + be.z, v[4 * j + 3] * rstd * g.w + be.w}; }
    }
}

constexpr int N_PHASES = 9;
struct Args { const float* in[16]; float* out; unsigned char* ws; int ph_lo, ph_hi, bar_region, pad; };
__global__ void __launch_bounds__(NTHR, 2) mega_fwd(Args args) {
    extern __shared__ __attribute__((aligned(16))) unsigned char lds_raw[];
    Frame F;
    F.lds = (LAS unsigned char*)lds_raw;
    F.wave = __builtin_amdgcn_readfirstlane(threadIdx.x >> 6); F.G = gridDim.x; F.bx = blockIdx.x;
    unsigned char* ws = args.ws;
    F.ctl = (unsigned*)(ws + WS_CTL);
    F.x = args.in[0]; F.w_in = args.in[1]; F.gn_gain = args.in[2]; F.pool_w = args.in[3]; F.pool_scale = args.in[4]; F.w_out = args.in[5];
    F.ln1g = args.in[6]; F.ln1b = args.in[7]; F.rw = args.in[8]; F.rb = args.in[9]; F.wgu = args.in[10]; F.bgu = args.in[11];
    F.wd = args.in[12]; F.bd = args.in[13]; F.ln2g = args.in[14]; F.ln2b = args.in[15]; F.out = args.out;
    F.WinT = (bf16*)(ws + WS_WIN_T); F.WoutT = (bf16*)(ws + WS_WOUT_T); F.PoolT = (bf16*)(ws + WS_POOLW_T); F.XB = (bf16*)(ws + WS_XB);
    F.PROJB = (bf16*)(ws + WS_PROJB); F.PB = (bf16*)(ws + WS_PB); F.MIXEDB = (bf16*)(ws + WS_MIXEDB); F.HB = (bf16*)(ws + WS_HB);
    F.ACTB = (bf16*)(ws + WS_ACTB); F.OUTS = (bf16*)(ws + WS_OUTS); F.WguT = (bf16*)(ws + WS_WGU_T); F.WdT = (bf16*)(ws + WS_WD_T);
    F.ROPE = (float*)(ws + WS_ROPE); F.KVT = (float*)(ws + WS_KVT); F.MIX = (float*)(ws + WS_MIX); F.H = (float*)(ws + WS_H); F.SGATE = (float*)(ws + WS_SGATE);
    F.HB8 = ws + WS_HB8; F.ACT8 = ws + WS_ACT8; F.Wgu8 = ws + WS_WGU8; F.Wd8 = ws + WS_WD8;
    F.STOK = (int*)(ws + WS_STOK); F.TOKE = (int*)(ws + WS_TOKE); F.TOKR = (int*)(ws + WS_TOKR);
    for (int u = F.wave * 64 + pg8::fresh_lane(); u < (LDS_BYTES - LDSCTL_OFF) / 4; u += NTHR) ((LAS unsigned*)(F.lds + LDSCTL_OFF))[u] = 0u;
    __syncthreads();
    const int lo = args.ph_lo, hi = args.ph_hi;
    XcdBarrier bar; bar.bar = F.ctl + CW_BAR + args.bar_region * XCD_BAR_WORDS; bar.x = 0; bar.st = nullptr; bar.wave = F.wave;
    if (hi - lo > 1) bar = xcd_barrier_post(F.ctl + CW_BAR + args.bar_region * XCD_BAR_WORDS, (volatile LAS unsigned*)(F.lds + MISC_OFF) + 8);
#define IN(k) (lo <= (k) && (k) < hi)
#define SEAM(k) do { if (IN(k) && IN((k) + 1)) xcd_barrier(bar); } while (0)
    LAS unsigned char* ring = F.lds;
#if defined(XCD_ROUND_SYNC)
    unsigned* const XS6 = F.ctl + CW_XSYNC; unsigned* const XS7 = F.ctl + CW_XSYNC + 8 * 64;
#else
    unsigned* const XS6 = nullptr; unsigned* const XS7 = nullptr;
#endif
#define REMAP_BX() do { if (hi - lo > 1) { volatile LAS unsigned* ms = (volatile LAS unsigned*)(F.lds + MISC_OFF) + 8; \
        if (threadIdx.x == 0) { bool ok = (F.G % 8) == 0; for (unsigned j = 0; j < 8; ++j) ok = ok && (xb_ld(&bar.bar[XB_XCNT(j)]) == (unsigned)F.G / 8u); ms[3] = ok ? ms[2] * 8u + bar.x : (unsigned)blockIdx.x; } \
        __syncthreads(); F.bx = __builtin_amdgcn_readfirstlane((int)ms[3]); } } while (0)

#ifndef PROBE_REP
#define PROBE_REP -1
#endif
#define REP(k) if ((k) == PROBE_REP)
    if (IN(0)) { p0_prologue(F);
#if defined(MOE_F8DMA)
        { const int lane0 = pg8::fresh_lane(); p0_cvt8_experts(F.wgu, F.Wgu8, 2 * FF, F.bx, F.G, F.wave, lane0); p0_cvt8_experts(F.wd, F.Wd8, D_, F.bx, F.G, F.wave, lane0); }
#endif
    }
    if (IN(0)) REP(0) { p0_prologue(F); } SEAM(0);
    if (IN(0) && IN(1)) REMAP_BX();
    if (IN(1)) {
#if defined(P1_F32B)
        pg8::DenseOrder S; S.init(T_, INW, F.G, F.bx, F.WinT, D_, F.w_in); pg8::EpiBf16 E{F.PROJB, INW, 0, nullptr};
        pg8::gemm_phase_f32b<pg8::EpiBf16, pg8::DenseOrder, false>(ring, F.wave, F.XB, D_, D_, INW, S, E);
#else
        pg8::DenseOrder S; S.init(T_, INW, F.G, F.bx, F.WinT, D_, nullptr, 1); pg8::EpiBf16 E{F.PROJB, INW, 0, nullptr};
        pg8::gemm_phase<pg8::EpiBf16, pg8::DenseOrder>(ring, F.wave, F.XB, D_, 0, D_, S, E);
        pg8::DenseOrder S2; S2.init(T_, INW, F.G, F.bx, F.WinT, D_, nullptr, 2);
        pg8::gemm_phase_half<pg8::EpiBf16, pg8::DenseOrder>(ring, F.wave, F.XB, D_, 0, D_, S2, E);
#endif
        { const int nunits = (T_ / 256) * (INW / 256), rem = nunits % F.G;
          if (rem == 0 || 2 * rem <= F.G) { const int busy = 2 * rem; if (busy >= F.G) p0_late(F, F.bx, F.G); else if (F.bx >= busy) p0_late(F, F.bx - busy, F.G - busy); }
          else if (F.bx >= rem) p0_late(F, F.bx - rem, F.G - rem); }
    }
    if (IN(1)) REP(1) {
#if defined(P1_F32B)
        pg8::DenseOrder S; S.init(T_, INW, F.G, F.bx, F.WinT, D_, F.w_in); pg8::EpiBf16 E{F.PROJB, INW, 0, nullptr};
        pg8::gemm_phase_f32b<pg8::EpiBf16, pg8::DenseOrder, false>(ring, F.wave, F.XB, D_, D_, INW, S, E);
#else
        pg8::DenseOrder S; S.init(T_, INW, F.G, F.bx, F.WinT, D_, nullptr, 1); pg8::EpiBf16 E{F.PROJB, INW, 0, nullptr};
        pg8::gemm_phase<pg8::EpiBf16, pg8::DenseOrder>(ring, F.wave, F.XB, D_, 0, D_, S, E);
        pg8::DenseOrder S2; S2.init(T_, INW, F.G, F.bx, F.WinT, D_, nullptr, 2);
        pg8::gemm_phase_half<pg8::EpiBf16, pg8::DenseOrder>(ring, F.wave, F.XB, D_, 0, D_, S2, E);
#endif
        { const int nunits = (T_ / 256) * (INW / 256), rem = nunits % F.G;
          if (rem == 0 || 2 * rem <= F.G) { const int busy = 2 * rem; if (busy >= F.G) p0_late(F, F.bx, F.G); else if (F.bx >= busy) p0_late(F, F.bx - busy, F.G - busy); }
          else if (F.bx >= rem) p0_late(F, F.bx - rem, F.G - rem); }
    } SEAM(1);
    if (IN(2)) { for (int u = F.bx; u < 512; u += F.G) r1_unit(F, u); pool_means(F); }
    if (IN(2)) REP(2) { for (int u = F.bx; u < 512; u += F.G) r1_unit(F, u); pool_means(F); } SEAM(2);
    if (IN(3)) {
        for (int u = F.bx, jj = 0; u < 512; u += F.G, ++jj) r3_unit(F, (jj & 1) ? ((u & ~15) | (15 - (u & 15))) : u);
        PoolOrder S{F.G, F.bx, F.PoolT}; EpiPool E{F.MIXEDB, F.pool_scale};
        pg8::gemm_phase<EpiPool, PoolOrder>(ring, F.wave, F.PB, 256, 0, 256, S, E);
    }
    if (IN(3)) REP(3) {
        for (int u = F.bx, jj = 0; u < 512; u += F.G, ++jj) r3_unit(F, (jj & 1) ? ((u & ~15) | (15 - (u & 15))) : u);
        PoolOrder S{F.G, F.bx, F.PoolT}; EpiPool E{F.MIXEDB, F.pool_scale};
        pg8::gemm_phase<EpiPool, PoolOrder>(ring, F.wave, F.PB, 256, 0, 256, S, E);
    } SEAM(3);
    if (IN(4)) {
        pg8::DenseOrder S; S.init(T_, D_, F.G, F.bx, F.WoutT, D_); pg8::EpiBf16 E{(bf16*)F.MIX, D_, 0, nullptr};
        pg8::gemm_phase<pg8::EpiBf16, pg8::DenseOrder>(ring, F.wave, F.MIXEDB, D_, 0, D_, S, E);
    }
    if (IN(4)) REP(4) {
        pg8::DenseOrder S; S.init(T_, D_, F.G, F.bx, F.WoutT, D_); pg8::EpiBf16 E{(bf16*)F.MIX, D_, 0, nullptr};
        pg8::gemm_phase<pg8::EpiBf16, pg8::DenseOrder>(ring, F.wave, F.MIXEDB, D_, 0, D_, S, E);
    } SEAM(4);
    F.cntoff = CW_CNT;
    if (IN(5)) REP(5) { ln1_router(F); xcd_barrier(bar); F.cntoff = CW_CNT + 32; }
    if (IN(5)) { ln1_router(F); } SEAM(5);
    if (IN(6)) {
        build_ts(F);
#if defined(MOE_F8DMA)
#if defined(F8D_PIPE)
        MoeOrder<16, true> S{(const LAS int*)(F.lds + TS_OFF), F.lds + TOKBUF_OFF, F.STOK, (const bf16*)F.Wgu8, F.G, F.bx, 2 * FF, nullptr, 0, 0, nullptr, 0, D_};
        pg8::EpiSwiglu8 E{F.ACT8, F.bgu, 1.0f / 64.0f, F.lds};
        pg8::gemm_phase_f8d<pg8::EpiSwiglu8, MoeOrder<16, true>>(ring, F.wave, F.HB8, D_, S, E);
#else
        MoeOrder<16, true> S{(const LAS int*)(F.lds + TS_OFF), F.lds + TOKBUF_OFF, F.STOK, (const bf16*)F.Wgu8, F.G, F.bx, 2 * FF, nullptr, 0, 0, nullptr, 1, D_};
        pg8::EpiSwiglu8 E{F.ACT8, F.bgu, 1.0f / 64.0f, F.lds};
        pg8::gemm_phase<pg8::EpiSwiglu8, MoeOrder<16, true>, true, true>(ring, F.wave, (const bf16*)F.HB8, D_ / 2, 0, D_ / 2, S, E);
        MoeOrder<16, true> S2{(const LAS int*)(F.lds + TS_OFF), F.lds + TOKBUF_OFF, F.STOK, (const bf16*)F.Wgu8, F.G, F.bx, 2 * FF, nullptr, 0, 0, nullptr, 2, D_};
        pg8::gemm_phase_half<pg8::EpiSwiglu8, MoeOrder<16, true>, true>(ring, F.wave, (const bf16*)F.HB8, D_ / 2, 0, D_ / 2, S2, E);
#endif
#elif defined(MOE_FP8)
        MoeOrder<16, true> S{(const LAS int*)(F.lds + TS_OFF), F.lds + TOKBUF_OFF, F.STOK, F.WguT, F.G, F.bx, 2 * FF, F.wgu, 0, 0, nullptr, 1};
        pg8::EpiSwiglu8 E{F.ACT8, F.bgu, 1.0f / 64.0f, F.lds};
        pg8::gemm_phase_f8<pg8::EpiSwiglu8, MoeOrder<16, true>>(ring, F.wave, F.HB8, D_, 2 * FF, 64.0f, S, E);
        MoeOrder<16, true> S2{(const LAS int*)(F.lds + TS_OFF), F.lds + TOKBUF_OFF, F.STOK, F.WguT, F.G, F.bx, 2 * FF, F.wgu, 0, 0, nullptr, 2};
        pg8::gemm_phase_f8_half<pg8::EpiSwiglu8, MoeOrder<16, true>>(ring, F.wave, F.HB8, D_, 2 * FF, 64.0f, S2, E);
#else
        MoeOrder<16, true> S{(const LAS int*)(F.lds + TS_OFF), F.lds + TOKBUF_OFF, F.STOK, F.WguT, F.G, F.bx, 2 * FF, F.wgu, 0, 0, XS6, 1};
        pg8::EpiSwiglu E{F.ACTB, F.bgu};
        pg8::gemm_phase_f32b<pg8::EpiSwiglu, MoeOrder<16, true>, false>(ring, F.wave, F.HB, D_, D_, 2 * FF, S, E);
        MoeOrder<16, true> S2{(const LAS int*)(F.lds + TS_OFF), F.lds + TOKBUF_OFF, F.STOK, F.WguT, F.G, F.bx, 2 * FF, F.wgu, 0, 0, nullptr, 2};
        pg8::gemm_phase_f32b_half<pg8::EpiSwiglu, MoeOrder<16, true>>(ring, F.wave, F.HB, D_, D_, 2 * FF, S2, E);
#endif
    }
#ifndef PROBE_ABL
#define PROBE_ABL 0
#endif
    if (IN(6)) REP(6) {
        build_ts(F);
        MoeOrder<16, true> S{(const LAS int*)(F.lds + TS_OFF), F.lds + TOKBUF_OFF, F.STOK, F.WguT, F.G, F.bx, 2 * FF, F.wgu, 0, 0, nullptr, 0};
#ifndef PROBE_EPI
#define PROBE_EPI 0
#endif
        pg8::EpiSwigluT<PROBE_EPI> E{F.OUTS, F.bgu};
        pg8::gemm_phase_f32b<pg8::EpiSwigluT<PROBE_EPI>, MoeOrder<16, true>, false, PROBE_ABL>(ring, F.wave, F.HB, D_, D_, 2 * FF, S, E);
    } SEAM(6);
    if (IN(7)) {
        build_ts(F);
#if defined(MOE_F8DMA)
#if defined(F8D_PIPE)
        MoeOrder<8, false> S{(const LAS int*)(F.lds + TS_OFF), F.lds + TOKBUF_OFF, F.STOK, (const bf16*)F.Wd8, F.G, F.bx, D_, nullptr, 0, 0, nullptr, 0, FF};
        pg8::EpiDown8 E{F.OUTS, F.bd, F.SGATE, 1.0f / 64.0f, F.lds};
        pg8::gemm_phase_f8d<pg8::EpiDown8, MoeOrder<8, false>>(ring, F.wave, F.ACT8, FF, S, E);
#else
        MoeOrder<8, false> S{(const LAS int*)(F.lds + TS_OFF), F.lds + TOKBUF_OFF, F.STOK, (const bf16*)F.Wd8, F.G, F.bx, D_, nullptr, 0, 0, nullptr, 1, FF};
        pg8::EpiDown8 E{F.OUTS, F.bd, F.SGATE, 1.0f / 64.0f, F.lds};
        pg8::gemm_phase<pg8::EpiDown8, MoeOrder<8, false>, true, true>(ring, F.wave, (const bf16*)F.ACT8, FF / 2, 0, FF / 2, S, E);
        MoeOrder<8, false> S2{(const LAS int*)(F.lds + TS_OFF), F.lds + TOKBUF_OFF, F.STOK, (const bf16*)F.Wd8, F.G, F.bx, D_, nullptr, 0, 0, nullptr, 2, FF};
        pg8::gemm_phase_half<pg8::EpiDown8, MoeOrder<8, false>, true>(ring, F.wave, (const bf16*)F.ACT8, FF / 2, 0, FF / 2, S2, E);
#endif
#elif defined(MOE_FP8)
        MoeOrder<8, false> S{(const LAS int*)(F.lds + TS_OFF), F.lds + TOKBUF_OFF, F.STOK, F.WdT, F.G, F.bx, D_, F.wd, 0, 0, nullptr, 1};
        pg8::EpiDown8 E{F.OUTS, F.bd, F.SGATE, 1.0f / 64.0f, F.lds};
        pg8::gemm_phase_f8<pg8::EpiDown8, MoeOrder<8, false>>(ring, F.wave, F.ACT8, FF, D_, 64.0f, S, E);
        MoeOrder<8, false> S2{(const LAS int*)(F.lds + TS_OFF), F.lds + TOKBUF_OFF, F.STOK, F.WdT, F.G, F.bx, D_, F.wd, 0, 0, nullptr, 2};
        pg8::gemm_phase_f8_half<pg8::EpiDown8, MoeOrder<8, false>>(ring, F.wave, F.ACT8, FF, D_, 64.0f, S2, E);
#else
        MoeOrder<8, false> S{(const LAS int*)(F.lds + TS_OFF), F.lds + TOKBUF_OFF, F.STOK, F.WdT, F.G, F.bx, D_, F.wd, 0, 0, XS7, 1};
        pg8::EpiDown E{F.OUTS, F.bd, F.SGATE};
        pg8::gemm_phase_f32b<pg8::EpiDown, MoeOrder<8, false>, false>(ring, F.wave, F.ACTB, FF, FF, D_, S, E);
        MoeOrder<8, false> S2{(const LAS int*)(F.lds + TS_OFF), F.lds + TOKBUF_OFF, F.STOK, F.WdT, F.G, F.bx, D_, F.wd, 0, 0, nullptr, 2};
        pg8::gemm_phase_f32b_half<pg8::EpiDown, MoeOrder<8, false>>(ring, F.wave, F.ACTB, FF, FF, D_, S2, E);
#endif
    }
    if (IN(7)) REP(7) {
        build_ts(F);
        MoeOrder<8, false> S{(const LAS int*)(F.lds + TS_OFF), F.lds + TOKBUF_OFF, F.STOK, F.WdT, F.G, F.bx, D_, F.wd, 0, 0, nullptr, 0};
        pg8::EpiDown E{F.OUTS, F.bd, F.SGATE};
        pg8::gemm_phase_f32b<pg8::EpiDown, MoeOrder<8, false>, false>(ring, F.wave, F.ACTB, FF, FF, D_, S, E);
    } SEAM(7);
    if (IN(8)) { build_ts(F); combine_ln2(F); }
    if (IN(8)) REP(8) { build_ts(F); combine_ln2(F); }
#undef IN
#undef SEAM
}

static int g_grid = 0;
static bool setup() {
    if (g_grid) return g_grid > 0;
    int dev = 0, cus = 0, per_cu = 0;
    if (hipGetDevice(&dev) != hipSuccess || hipDeviceGetAttribute(&cus, hipDeviceAttributeMultiprocessorCount, dev) != hipSuccess) { g_grid = -1; return false; }
    if (hipFuncSetAttribute((const void*)mega_fwd, hipFuncAttributeMaxDynamicSharedMemorySize, LDS_BYTES) != hipSuccess) { fprintf(stderr, "hipFuncSetAttribute failed\n"); g_grid = -1; return false; }
    if (hipOccupancyMaxActiveBlocksPerMultiprocessor(&per_cu, (const void*)mega_fwd, NTHR, LDS_BYTES) != hipSuccess || per_cu < 1) fprintf(stderr, "occupancy query: %d per CU\n", per_cu);
    (void)hipGetLastError();
    g_grid = cus;
    return true;
}
static void launch(void* const* d_in, float* out, unsigned char* ws, hipStream_t st, int lo, int hi, int region) {
    Args a{};
    for (int i = 0; i < 16; ++i) a.in[i] = (const float*)d_in[i];
    a.out = out; a.ws = ws; a.ph_lo = lo; a.ph_hi = hi; a.bar_region = region; a.pad = 0;
    hipLaunchKernelGGL(mega_fwd, dim3(g_grid), dim3(NTHR), LDS_BYTES, st, a);
}
}
extern "C" void kernel_launch(void* const* d_in, const int* in_sizes, int n_in, void* d_out, int out_size, void* d_ws, size_t ws_size, hipStream_t stream) {
    (void)in_sizes; (void)n_in; (void)out_size; (void)ws_size;
    unsigned char* ws = (unsigned char*)d_ws;
    if (!fk::setup()) return;
    (void)hipMemsetAsync(ws + fk::WS_CTL, 0, fk::CTL_ZERO_BYTES, stream);
    fk::launch(d_in, (float*)d_out, ws, stream, 0, fk::N_PHASES, 0);
}
```

```cpp
#include <hip/hip_runtime.h>
#include <cstdio>
#include <cstdint>
#include <cmath>
#define MOE_FP8 1
#define F8_SCALED 1
namespace pg8 {
#define PG8_LAS __attribute__((address_space(3)))
typedef unsigned short bf16_t;
typedef short bf16x8 __attribute__((ext_vector_type(8)));
typedef float f32x4 __attribute__((ext_vector_type(4)));
typedef float f32x2 __attribute__((ext_vector_type(2)));
typedef unsigned u32x4 __attribute__((ext_vector_type(4)));
typedef unsigned u32x2 __attribute__((ext_vector_type(2)));
constexpr int BM = 256, BK = 64, HALF = 128, HTB = HALF * BK * 2, STAGE_BYTES = 8 * HTB, NXCD = 8;
typedef int v8i32 __attribute__((ext_vector_type(8)));
typedef short v2i16 __attribute__((ext_vector_type(2)));
typedef int v4i32 __attribute__((ext_vector_type(4)));
typedef long v2i64 __attribute__((ext_vector_type(2)));
__device__ __forceinline__ v8i32 cat8(const bf16x8 a, const bf16x8 b) { return __builtin_shufflevector(__builtin_bit_cast(v4i32, a), __builtin_bit_cast(v4i32, b), 0, 1, 2, 3, 4, 5, 6, 7); }

__host__ __device__ __forceinline__ int lds_byte(int r, int c) { const int st = (r >> 4) * 2 + (c >> 5), rr = r & 15, cc = c & 31, ob = rr * 64 + cc * 2; return st * 1024 + (ob ^ (((ob >> 9) & 1) << 5)); }
__host__ __device__ __forceinline__ void stage_rc(int b, int& R, int& C) { const int st = b / 1024, sb = b % 1024, swz = sb ^ (((sb >> 9) & 1) << 5); R = (st >> 1) * 16 + swz / 64; C = (st & 1) * 32 + (swz % 64) / 2; }
__host__ __device__ __forceinline__ int perm32(int rho) { const int n = rho >> 4, i = rho & 15; return 8 * (i >> 2) + 4 * n + (i & 3); }

struct Unit { int pm, pn, e, lm, aux, hn, par; };

__device__ __forceinline__ int fresh_lane() { int l; asm volatile("v_mbcnt_lo_u32_b32 %0, -1, 0\n\tv_mbcnt_hi_u32_b32 %0, -1, %0" : "=v"(l)); return l; }
__device__ __forceinline__ unsigned cvt_pk_bf16(float lo, float hi) { unsigned r; asm volatile("v_cvt_pk_bf16_f32 %0, %1, %2" : "=v"(r) : "v"(lo), "v"(hi)); return r; }

__device__ __forceinline__ int xcd_remap(int L, int nwg) { const int q = nwg / NXCD, r = nwg % NXCD, xcd = L % NXCD, off = L / NXCD; return (xcd < r ? xcd * (q + 1) : r * (q + 1) + (xcd - r) * q) + off; }

template <class Epi, class Sched, bool ALIGN_EPI = true, bool F8 = false>
__device__ __forceinline__ void gemm_phase(PG8_LAS unsigned char* lds, int wid, const bf16_t* Abase, int lda, int acol0, int K, const Sched& S, const Epi& E) {
    const int lane = fresh_lane(), tid = wid * 64 + lane, wr = wid >> 2, wc = wid & 3, fr = lane & 15, fq = lane >> 4;
    const int nt = K / BK;
    int sR[2], sC[2]; unsigned voffB[2];
#pragma unroll
    for (int i = 0; i < 2; ++i) { stage_rc(tid * 16 + i * 8192, sR[i], sC[i]); const int Rb = Epi::PERM ? ((sR[i] & ~31) + perm32(sR[i] & 31)) : sR[i];
        voffB[i] = (unsigned)(Rb * K + sC[i]) * 2u; }
    const size_t kstep = (size_t)(BK * 2);
    const size_t hstepB = (size_t)HALF * K * 2;
    const unsigned ldsw = (unsigned)wid * 1024u;
    const int aoff = lds_byte(wr * 64 + fr, fq * 8), boff = lds_byte(wc * 32 + fr, fq * 8);
#define PG8_SA(b, h) (((b) * 2 + (h)) * HTB)
#define PG8_SB(b, h) ((4 + (b) * 2 + (h)) * HTB)
#define PG8_STAGE(bufoff, gbase, voff) do { _Pragma("unroll") for (int _i = 0; _i < 2; ++_i) \
        __builtin_amdgcn_global_load_lds((const unsigned*)((const char*)(gbase) + (voff)[_i]), (PG8_LAS unsigned*)(lds + (bufoff) + ldsw + _i * 8192), 16, 0, 0); } while (0)
#ifndef PG8_A_AUX
#define PG8_A_AUX 0
#endif
#define PG8_STAGE_A(bufoff, gbase, voff) do { _Pragma("unroll") for (int _i = 0; _i < 2; ++_i) \
        __builtin_amdgcn_global_load_lds((const unsigned*)((const char*)(gbase) + (voff)[_i]), (PG8_LAS unsigned*)(lds + (bufoff) + ldsw + _i * 8192), 16, 0, PG8_A_AUX); } while (0)
#define PG8_STAGEX(bufoff, gbase, voff) do { if constexpr (F8) { _Pragma("unroll") for (int _i = 0; _i < 2; ++_i) { unsigned _m0s; \
        asm volatile("s_mov_b32 %0, m0\n\ts_mov_b32 m0, %3\n\ts_nop 0\n\tglobal_load_lds_dwordx4 %1, %2\n\ts_mov_b32 m0, %0" : "=&s"(_m0s) : "v"((voff)[_i]), "s"(gbase), "s"((unsigned)(size_t)lds + ldsw + (unsigned)((bufoff) + _i * 8192)) : "memory"); } } \
        else PG8_STAGE(bufoff, gbase, voff); } while (0)
#define PG8_MMA_X(ai, bj, At, Bt) do { if constexpr (!(ABL & 1)) PG8_MMA(ai, bj, At, Bt); } while (0)
#define PG8_LDA_X(dst, b, h) do { if constexpr (!(ABL & 8)) PG8_LDA(dst, b, h); } while (0)
#define PG8_LDB_X(dst, b, h) do { if constexpr (!(ABL & 8)) PG8_LDB(dst, b, h); } while (0)
#define PG8_STAGE_AX(bufoff, gbase, voff) do { if constexpr (!(ABL & 4)) PG8_STAGE_A(bufoff, gbase, voff); } while (0)
#define PG8_LDA(dst, b, h) do { _Pragma("unroll") for (int m = 0; m < 4; ++m) _Pragma("unroll") for (int k = 0; k < 2; ++k) dst[m][k] = *(const PG8_LAS bf16x8*)(lds + PG8_SA(b, h) + aoff + m * 2048 + k * 1024); } while (0)
#define PG8_LDB(dst, b, h) do { _Pragma("unroll") for (int n = 0; n < 2; ++n) _Pragma("unroll") for (int k = 0; k < 2; ++k) dst[n][k] = *(const PG8_LAS bf16x8*)(lds + PG8_SB(b, h) + boff + n * 2048 + k * 1024); } while (0)
#define PG8_MMA(ai, bj, At, Bt) do { __builtin_amdgcn_s_setprio(1); _Pragma("unroll") for (int m = 0; m < 4; ++m) _Pragma("unroll") for (int n = 0; n < 2; ++n) _Pragma("unroll") for (int k = 0; k < 2; ++k) \
        acc[ai][bj][m][n] = __builtin_amdgcn_mfma_f32_16x16x32_bf16(Bt[n][k], At[m][k], acc[ai][bj][m][n], 0, 0, 0); __builtin_amdgcn_s_setprio(0); } while (0)
#define PG8_MMAF(ai, bj, At, Bt) do { if constexpr (F8) { __builtin_amdgcn_s_setprio(1); _Pragma("unroll") for (int m = 0; m < 4; ++m) _Pragma("unroll") for (int n = 0; n < 2; ++n) \
        acc[ai][bj][m][n] = __builtin_amdgcn_mfma_scale_f32_16x16x128_f8f6f4(cat8(Bt[n][0], Bt[n][1]), cat8(At[m][0], At[m][1]), acc[ai][bj][m][n], 0, 0, 0, 0x7f7f7f7f, 0, 0x7f7f7f7f); \
        __builtin_amdgcn_s_setprio(0); } else PG8_MMA(ai, bj, At, Bt); } while (0)
#define PG8_WAIT_V(n) asm volatile("s_waitcnt vmcnt(" #n ")" ::: "memory")
#define PG8_WAIT_L(n) asm volatile("s_waitcnt lgkmcnt(" #n ")" ::: "memory")
#define PG8_BAR __builtin_amdgcn_s_barrier()
#define PG8_SCHED __builtin_amdgcn_sched_barrier(0)
#define PG8_AOFF0(dst, u) do { _Pragma("unroll") for (int _h = 0; _h < 2; ++_h) _Pragma("unroll") for (int _i = 0; _i < 2; ++_i) \
        dst[_h][_i] = (unsigned)(S.arow0(u, _h * HALF + sR[_i]) * lda + acol0 + sC[_i]) * 2u; } while (0)
#define PG8_AOFF1(dst, u, par) do { _Pragma("unroll") for (int _h = 0; _h < 2; ++_h) _Pragma("unroll") for (int _i = 0; _i < 2; ++_i) \
        dst[_h][_i] = (unsigned)(S.arow1(u, _h * HALF + sR[_i], par, lds) * lda + acol0 + sC[_i]) * 2u; } while (0)
    Unit cur, nxt; int ui = 0;
    if (!S.next(0, cur)) return;
    f32x4 acc[2][2][4][2];
#pragma unroll
    for (int a = 0; a < 2; ++a)
#pragma unroll
        for (int b = 0; b < 2; ++b)
#pragma unroll
            for (int m = 0; m < 4; ++m)
#pragma unroll
                for (int n = 0; n < 2; ++n) acc[a][b][m][n] = (f32x4){0.f, 0.f, 0.f, 0.f};
    bf16x8 At[4][2], B0[2][2], B1[2][2];
    unsigned va[2][2], vn[2][2];
    PG8_AOFF0(va, cur);
    const char* const cA = (const char*)Abase;
    const char* cB = S.bbase(cur);
    PG8_STAGEX(PG8_SB(0, 0), cB, voffB); PG8_STAGEX(PG8_SB(0, 1), cB + hstepB, voffB); PG8_STAGEX(PG8_SA(0, 0), cA, va[0]); PG8_STAGEX(PG8_SA(0, 1), cA, va[1]);
    if (wr == 1) PG8_BAR;
    PG8_WAIT_V(2); PG8_BAR;
    PG8_STAGEX(PG8_SB(1, 0), cB + kstep, voffB); PG8_STAGEX(PG8_SA(1, 0), cA + kstep, va[0]); PG8_STAGEX(PG8_SB(1, 1), cB + hstepB + kstep, voffB);
    PG8_WAIT_V(6); PG8_BAR;
    for (;;) {
        const bool has_next = S.next(ui + 1, nxt);
        const char* nB = cB;
        if (has_next) { nB = S.bbase(nxt); S.prefetch(nxt, ui & 1, lds, wid, lane); }
#pragma unroll
        for (int h = 0; h < 2; ++h)
#pragma unroll
            for (int i = 0; i < 2; ++i) vn[h][i] = va[h][i];
#pragma unroll 1
        for (int t = 0; t < nt; t += 2) {
            const bool last = (t == nt - 2);
            const char* a1 = cA + (size_t)(t + 1) * kstep;
            const char* a2 = last ? cA : cA + (size_t)(t + 2) * kstep; const char* b2 = last ? nB : cB + (size_t)(t + 2) * kstep;
            const char* a3 = a2 + kstep; const char* b3 = b2 + kstep;
            if (last && has_next) PG8_AOFF1(vn, nxt, ui & 1);
            unsigned w0[2], w1[2];
            w0[0] = last ? vn[0][0] : va[0][0]; w0[1] = last ? vn[0][1] : va[0][1]; w1[0] = last ? vn[1][0] : va[1][0]; w1[1] = last ? vn[1][1] : va[1][1];
            PG8_LDB(B0, 0, 0); PG8_LDB(B1, 0, 1); PG8_SCHED; PG8_LDA(At, 0, 0); PG8_STAGEX(PG8_SA(1, 1), a1, va[1]);
            PG8_WAIT_V(8); PG8_WAIT_L(0); PG8_BAR; PG8_MMAF(0, 0, At, B0); PG8_MMAF(0, 1, At, B1); PG8_BAR; PG8_SCHED;
            PG8_LDA(At, 0, 1); PG8_STAGEX(PG8_SB(0, 0), b2, voffB); PG8_STAGEX(PG8_SB(0, 1), b2 + hstepB, voffB); PG8_STAGEX(PG8_SA(0, 0), a2, w0);
            PG8_WAIT_V(8); PG8_WAIT_L(0); PG8_BAR; PG8_MMAF(1, 0, At, B0); PG8_MMAF(1, 1, At, B1); PG8_BAR; PG8_SCHED;
            PG8_LDB(B0, 1, 0); PG8_LDB(B1, 1, 1); PG8_SCHED; PG8_LDA(At, 1, 0); PG8_STAGEX(PG8_SA(0, 1), a2, w1);
            PG8_WAIT_V(8); PG8_WAIT_L(0); PG8_BAR; PG8_MMAF(0, 0, At, B0); PG8_MMAF(0, 1, At, B1); PG8_BAR; PG8_SCHED;
            PG8_LDA(At, 1, 1); PG8_STAGEX(PG8_SB(1, 0), b3, voffB); PG8_STAGEX(PG8_SB(1, 1), b3 + hstepB, voffB); PG8_STAGEX(PG8_SA(1, 0), a3, w0);
            PG8_WAIT_V(8); PG8_WAIT_L(0); PG8_BAR; PG8_MMAF(1, 0, At, B0); PG8_MMAF(1, 1, At, B1); PG8_BAR; PG8_SCHED;
        }
        if constexpr (ALIGN_EPI) { if (wr == 0) PG8_BAR; }
        asm volatile("s_nop 15\n\ts_nop 15" : "+v"(acc[1][1][3][1]), "+v"(acc[1][0][3][1]));
        E(acc, cur, wr, wc, fr, fq);
        if (!has_next) break;
#pragma unroll
        for (int a = 0; a < 2; ++a)
#pragma unroll
            for (int b = 0; b < 2; ++b)
#pragma unroll
                for (int m = 0; m < 4; ++m)
#pragma unroll
                    for (int n = 0; n < 2; ++n) acc[a][b][m][n] = (f32x4){0.f, 0.f, 0.f, 0.f};
        cur = nxt; cB = nB; ++ui;
#pragma unroll
        for (int h = 0; h < 2; ++h)
#pragma unroll
            for (int i = 0; i < 2; ++i) va[h][i] = vn[h][i];
        if constexpr (ALIGN_EPI) { if (wr == 1) PG8_BAR; }
    }
    PG8_WAIT_V(0);
    if constexpr (!ALIGN_EPI) { if (wr == 0) PG8_BAR; }
    PG8_BAR;

}
__device__ __forceinline__ __amdgpu_buffer_rsrc_t make_rsrc_uniform(const char* p, int bytes) {
    const unsigned long long a = (unsigned long long)p;
    const unsigned lo = __builtin_amdgcn_readfirstlane((unsigned)a), hi = __builtin_amdgcn_readfirstlane((unsigned)(a >> 32));
    return __builtin_amdgcn_make_buffer_rsrc((void*)(((unsigned long long)hi << 32) | lo), 0, bytes, 0x00020000);
}
__device__ __forceinline__ unsigned cvt_pk_bf16_nv(float lo, float hi) { unsigned r; asm("v_cvt_pk_bf16_f32 %0, %1, %2" : "=v"(r) : "v"(lo), "v"(hi)); return r; }
template <class Epi, class Sched, bool WB = false, int ABL = 0>
__device__ __forceinline__ void gemm_phase_f32b(PG8_LAS unsigned char* lds, int wid, const bf16_t* Abase, int lda, int K, int N, const Sched& S, const Epi& E) {
    static_assert(Epi::PERM, "f32-B body: PERM epilogues only");
    const int lane = fresh_lane(), tid = wid * 64 + lane, wr = wid >> 2, wc = wid & 3, fr = lane & 15, fq = lane >> 4;
    const int nt = K / BK;
    const int acol0 = 0;
    const size_t kstep = (size_t)(BK * 2);
    const unsigned ldsw = (unsigned)wid * 1024u;
    const int aoff = lds_byte(wr * 64 + fr, fq * 8), boff = lds_byte(wc * 32 + fr, fq * 8);
    const int n4 = (lane & 15) + 16 * (wid & 3), kq = (lane >> 4) + 4 * (wid >> 2);
    const unsigned vb = (unsigned)(kq * 8 * N + 4 * n4) * 4u;
    const int browb = N * 4, bkstep = BK * browb;
    const int tline = wid * 16 + (lane & 15);
    const unsigned vtouch = (unsigned)((tid >> 3) * browb + (tid & 7) * 128);
    const int bn = 4 * n4, brow0 = ((bn & 127) & ~31) + (((n4 & 1) << 4) | (((n4 & 7) >> 1) << 2));
    const int wb0 = (bn >> 7) * HTB + lds_byte(brow0, kq * 8);
    const unsigned wbaddr = (unsigned)(size_t)lds + (unsigned)wb0;
    const unsigned vwb = (unsigned)((4 * n4) * K + kq * 8) * 2u;
    Unit cur, nxt; int ui = 0;
    if (!S.next(0, cur)) return;
    f32x4 acc[2][2][4][2];
#pragma unroll
    for (int a = 0; a < 2; ++a)
#pragma unroll
        for (int b = 0; b < 2; ++b)
#pragma unroll
            for (int m = 0; m < 4; ++m)
#pragma unroll
                for (int n = 0; n < 2; ++n) acc[a][b][m][n] = (f32x4){0.f, 0.f, 0.f, 0.f};
    bf16x8 At[4][2], B0[2][2], B1[2][2];
    f32x4 RB[8];
    unsigned va[2][2];
    { int sR[2], sC[2];
_Pragma("unroll") for (int i = 0; i < 2; ++i) stage_rc(tid * 16 + i * 8192, sR[i], sC[i]);
      PG8_AOFF0(va, cur); }
    const char* const cA = (const char*)Abase;
    const char* cB = S.bbase(cur);
    __amdgpu_buffer_rsrc_t rC = make_rsrc_uniform(cB, K * browb), rN = rC;
    __amdgpu_buffer_rsrc_t wC = rC, wN = rC;
    if constexpr (WB) { wC = make_rsrc_uniform(S.wbbase(cur), 256 * K * 2); wN = wC; }
#define PG8_LOADB(rs, so) do { if constexpr (ABL & 2) break; _Pragma("unroll") for (int _j = 0; _j < 8; ++_j) { \
        if constexpr (ABL & 128) asm volatile("buffer_load_dword %0, %1, %2, %3 offen" : "=v"(RB[_j][0]) : "v"(vb), "s"(rs), "s"((so) + _j * browb) : "memory"); \
        else if constexpr (ABL & 256) asm volatile("buffer_load_dwordx4 %0, %1, %2, %3 offen" : "=v"(RB[_j]) : "v"(0u), "s"(rs), "s"((so) + _j * browb) : "memory"); \
        else asm volatile("buffer_load_dwordx4 %0, %1, %2, %3 offen" : "=v"(RB[_j]) : "v"(vb), "s"(rs), "s"((so) + _j * browb) : "memory"); } } while (0)
#define PG8_TOUCH(rs, so, q) do { if (lane < 16) { const unsigned _vt = (unsigned)((((q) * 128 + tline) >> 3) * browb + (((q) * 128 + tline) & 7) * 128); \
        asm volatile("buffer_load_dword %0, %1, %2, %3 offen" : "+v"(touchreg) : "v"(_vt), "s"(rs), "s"(so) : "memory"); } } while (0)
#define PG8_WAITB(n) asm volatile("s_waitcnt vmcnt(" #n ")" : "+v"(RB[0]), "+v"(RB[1]), "+v"(RB[2]), "+v"(RB[3]), "+v"(RB[4]), "+v"(RB[5]), "+v"(RB[6]), "+v"(RB[7]) :: "memory")
#define PG8_WRITEB(b, wrs, wso) do { if constexpr (ABL & 16) break; _Pragma("unroll") for (int _i = 0; _i < 4; ++_i) { u32x4 _w; _w.x = cvt_pk_bf16_nv(RB[0][_i], RB[1][_i]); _w.y = cvt_pk_bf16_nv(RB[2][_i], RB[3][_i]); \
        _w.z = cvt_pk_bf16_nv(RB[4][_i], RB[5][_i]); _w.w = cvt_pk_bf16_nv(RB[6][_i], RB[7][_i]); \
        asm volatile("ds_write_b128 %0, %1 offset:%2" :: "v"(wbaddr + PG8_SB(b, 0)), "v"(_w), "n"(64 * _i) : "memory"); \
        if constexpr (WB) asm volatile("buffer_store_dwordx4 %0, %1, %2, %3 offen" :: "v"(_w), "v"(vwb), "s"(wrs), "s"(wso + _i * K * 2) : "memory"); } } while (0)
    PG8_LOADB(rC, 0); PG8_STAGE_AX(PG8_SA(0, 0), cA, va[0]); PG8_STAGE_AX(PG8_SA(0, 1), cA, va[1]);
    PG8_WAITB(4); PG8_WRITEB(0, wC, 0);
    PG8_STAGE_AX(PG8_SA(1, 0), cA + kstep, va[0]); PG8_LOADB(rC, bkstep);
    if (wr == 1) PG8_BAR;
    if constexpr (WB) PG8_WAIT_V(14); else PG8_WAIT_V(10); PG8_WAIT_L(0); PG8_BAR;
    PG8_BAR;
    for (;;) {
        const bool has_next = S.next(ui + 1, nxt);
        rN = rC; wN = wC;
        if (has_next) { rN = make_rsrc_uniform(S.bbase(nxt), K * browb); if constexpr (WB) wN = make_rsrc_uniform(S.wbbase(nxt), 256 * K * 2); S.prefetch(nxt, ui & 1, lds, wid, lane); }
#pragma unroll 1
        for (int t = 0; t < nt; t += 2) {
            const bool last = (t == nt - 2);
            const char* a1 = cA + (size_t)(t + 1) * kstep;
            const char* a2 = last ? cA : cA + (size_t)(t + 2) * kstep; const char* a3 = a2 + kstep;
            const __amdgpu_buffer_rsrc_t r2 = last ? rN : rC; const int so2 = last ? 0 : (t + 2) * bkstep;
            const __amdgpu_buffer_rsrc_t w2 = last ? wN : wC; const int wso2 = last ? 0 : (t + 2) * (BK * 2);
            PG8_LDB_X(B0, 0, 0); PG8_LDB_X(B1, 0, 1); PG8_SCHED; PG8_LDA_X(At, 0, 0); if constexpr (!(ABL & 64)) PG8_STAGE_AX(PG8_SA(1, 1), a1, va[1]);
            if (last && has_next) { int sR[2], sC[2]; const int tz = wid * 64 + fresh_lane(); _Pragma("unroll") for (int i = 0; i < 2; ++i) stage_rc(tz * 16 + i * 8192, sR[i], sC[i]); PG8_AOFF1(va, nxt, ui & 1); }
            if constexpr (WB) PG8_WAIT_V(16); else PG8_WAIT_V(12);
            PG8_WAIT_L(0); PG8_BAR; PG8_MMA_X(0, 0, At, B0); PG8_MMA_X(0, 1, At, B1); PG8_BAR; PG8_SCHED;
            PG8_LDA_X(At, 0, 1); PG8_WAITB(2); PG8_WRITEB(1, wC, (t + 1) * (BK * 2)); PG8_STAGE_AX(PG8_SA(0, 0), a2, va[0]); PG8_LOADB(r2, so2);
            PG8_WAIT_L(0); PG8_BAR; PG8_MMA_X(1, 0, At, B0); PG8_MMA_X(1, 1, At, B1); PG8_BAR; PG8_SCHED;
            PG8_LDB_X(B0, 1, 0); PG8_LDB_X(B1, 1, 1); PG8_SCHED; PG8_LDA_X(At, 1, 0); if constexpr (!(ABL & 64)) PG8_STAGE_AX(PG8_SA(0, 1), a2, va[1]);
            if constexpr (WB) PG8_WAIT_V(16); else PG8_WAIT_V(12);
            PG8_WAIT_L(0); PG8_BAR; PG8_MMA_X(0, 0, At, B0); PG8_MMA_X(0, 1, At, B1); PG8_BAR; PG8_SCHED;
            PG8_LDA_X(At, 1, 1); PG8_WAITB(2); PG8_WRITEB(0, w2, wso2); PG8_STAGE_AX(PG8_SA(1, 0), a3, va[0]); PG8_LOADB(r2, so2 + bkstep);
            PG8_WAIT_L(0); PG8_BAR; PG8_MMA_X(1, 0, At, B0); PG8_MMA_X(1, 1, At, B1); PG8_BAR; PG8_SCHED;
        }
        if (wr == 0) PG8_BAR;
        asm volatile("s_nop 15\n\ts_nop 15" : "+v"(acc[1][1][3][1]), "+v"(acc[1][0][3][1]));
        if constexpr (!(ABL & 32)) E(acc, cur, wr, wc, fr, fq);
        if (!has_next) break;
#pragma unroll
        for (int a = 0; a < 2; ++a)
#pragma unroll
            for (int b = 0; b < 2; ++b)
#pragma unroll
                for (int m = 0; m < 4; ++m)
#pragma unroll
                    for (int n = 0; n < 2; ++n) acc[a][b][m][n] = (f32x4){0.f, 0.f, 0.f, 0.f};
        cur = nxt; rC = rN; wC = wN; ++ui;
        S.round_sync(ui, wid, lane);
        if (wr == 1) PG8_BAR;
    }
    PG8_WAIT_V(0);
    asm volatile("" :: "v"(RB[0]), "v"(RB[1]), "v"(RB[2]), "v"(RB[3]), "v"(RB[4]), "v"(RB[5]), "v"(RB[6]), "v"(RB[7]));
    PG8_BAR;
#undef PG8_LOADB
#undef PG8_WAITB
#undef PG8_TOUCH
#undef PG8_TOUCH
#undef PG8_WRITEB
}

template <class Epi, class Sched>
__device__ __forceinline__ void gemm_phase_f32b_half(PG8_LAS unsigned char* lds, int wid, const bf16_t* Abase, int lda, int K, int N, const Sched& S, const Epi& E) {
    static_assert(Epi::PERM, "f32-B body: PERM epilogues only");
    const int lane = fresh_lane(), tid = wid * 64 + lane, wr = wid >> 2, wc = wid & 3, fr = lane & 15, fq = lane >> 4;
    const int nt = K / BK;
    const int acol0 = 0;
    const size_t kstep = (size_t)(BK * 2);
    const unsigned ldsw = (unsigned)wid * 1024u;
    const int aoff = lds_byte(wr * 64 + fr, fq * 8), boff = lds_byte(wc * 32 + fr, fq * 8);
    const int n4 = (lane & 15) + 16 * (wid & 1), kq = (lane >> 4) + 4 * (wid >> 1);
    const unsigned vb = (unsigned)(kq * 4 * N + 4 * n4) * 4u;
    const int browb = N * 4, bkstep = BK * browb;
    const int bn = 4 * n4, brow0 = (bn & ~31) + (((n4 & 1) << 4) | (((n4 & 7) >> 1) << 2));
    const unsigned wbaddr = (unsigned)(size_t)lds + (unsigned)lds_byte(brow0, kq * 4);
    Unit cur, nxt; int ui = 0;
    if (!S.next(0, cur)) return;
    f32x4 acc[2][2][4][2];
#pragma unroll
    for (int a = 0; a < 2; ++a)
#pragma unroll
        for (int b = 0; b < 2; ++b)
#pragma unroll
            for (int m = 0; m < 4; ++m)
#pragma unroll
                for (int n = 0; n < 2; ++n) acc[a][b][m][n] = (f32x4){0.f, 0.f, 0.f, 0.f};
    bf16x8 At[4][2], B0[2][2];
    f32x4 RB[4];
    unsigned va[2][2];
    { int sR[2], sC[2];
_Pragma("unroll") for (int i = 0; i < 2; ++i) stage_rc(tid * 16 + i * 8192, sR[i], sC[i]);
      PG8_AOFF0(va, cur); }
    const char* const cA = (const char*)Abase;
    __amdgpu_buffer_rsrc_t rC = make_rsrc_uniform(S.bbase(cur), K * browb), rN = rC;
#define PG8_HLOADB(rs, so) do { _Pragma("unroll") for (int _j = 0; _j < 4; ++_j) asm volatile("buffer_load_dwordx4 %0, %1, %2, %3 offen" : "=v"(RB[_j]) : "v"(vb), "s"(rs), "s"((so) + _j * browb) : "memory"); } while (0)
#define PG8_HWAITB(n) asm volatile("s_waitcnt vmcnt(" #n ")" : "+v"(RB[0]), "+v"(RB[1]), "+v"(RB[2]), "+v"(RB[3]) :: "memory")
#define PG8_HWRITEB(b) do { _Pragma("unroll") for (int _i = 0; _i < 4; ++_i) { u32x2 _w; _w.x = cvt_pk_bf16_nv(RB[0][_i], RB[1][_i]); _w.y = cvt_pk_bf16_nv(RB[2][_i], RB[3][_i]); \
        asm volatile("ds_write_b64 %0, %1 offset:%2" :: "v"(wbaddr + PG8_SB(b, 0)), "v"(_w), "n"(64 * _i) : "memory"); } } while (0)
    PG8_HLOADB(rC, 0); PG8_STAGE_A(PG8_SA(0, 0), cA, va[0]); PG8_STAGE_A(PG8_SA(0, 1), cA, va[1]);
    PG8_HWAITB(4); PG8_HWRITEB(0);
    PG8_STAGE_A(PG8_SA(1, 0), cA + kstep, va[0]); PG8_HLOADB(rC, bkstep);
    if (wr == 1) PG8_BAR;
    PG8_WAIT_V(6); PG8_WAIT_L(0); PG8_BAR;
    PG8_BAR;
    for (;;) {
        const bool has_next = S.next(ui + 1, nxt);
        rN = rC;
        if (has_next) { rN = make_rsrc_uniform(S.bbase(nxt), K * browb); S.prefetch(nxt, ui & 1, lds, wid, lane); }
#pragma unroll 1
        for (int t = 0; t < nt; t += 2) {
            const bool last = (t == nt - 2);
            const char* a1 = cA + (size_t)(t + 1) * kstep;
            const char* a2 = last ? cA : cA + (size_t)(t + 2) * kstep; const char* a3 = a2 + kstep;
            const __amdgpu_buffer_rsrc_t r2 = last ? rN : rC; const int so2 = last ? 0 : (t + 2) * bkstep;
            PG8_LDB(B0, 0, 0); PG8_SCHED; PG8_LDA(At, 0, 0); PG8_STAGE_A(PG8_SA(1, 1), a1, va[1]);
            if (last && has_next) { int sR[2], sC[2]; const int tz = wid * 64 + fresh_lane(); _Pragma("unroll") for (int i = 0; i < 2; ++i) stage_rc(tz * 16 + i * 8192, sR[i], sC[i]); PG8_AOFF1(va, nxt, ui & 1); }
            PG8_WAIT_V(8); PG8_WAIT_L(0); PG8_BAR; PG8_MMA(0, 0, At, B0); PG8_BAR; PG8_SCHED;
            PG8_LDA(At, 0, 1); PG8_HWAITB(2); PG8_HWRITEB(1); PG8_STAGE_A(PG8_SA(0, 0), a2, va[0]); PG8_HLOADB(r2, so2);
            PG8_WAIT_L(0); PG8_BAR; PG8_MMA(1, 0, At, B0); PG8_BAR; PG8_SCHED;
            PG8_LDB(B0, 1, 0); PG8_SCHED; PG8_LDA(At, 1, 0); PG8_STAGE_A(PG8_SA(0, 1), a2, va[1]);
            PG8_WAIT_V(8); PG8_WAIT_L(0); PG8_BAR; PG8_MMA(0, 0, At, B0); PG8_BAR; PG8_SCHED;
            PG8_LDA(At, 1, 1); PG8_HWAITB(2); PG8_HWRITEB(0); PG8_STAGE_A(PG8_SA(1, 0), a3, va[0]); PG8_HLOADB(r2, so2 + bkstep);
            PG8_WAIT_L(0); PG8_BAR; PG8_MMA(1, 0, At, B0); PG8_BAR; PG8_SCHED;
        }
        if (wr == 0) PG8_BAR;
        asm volatile("s_nop 15\n\ts_nop 15" : "+v"(acc[1][1][3][1]), "+v"(acc[1][0][3][1]));
        E.half(acc, cur, wr, wc, fr, fq);
        if (!has_next) break;
#pragma unroll
        for (int a = 0; a < 2; ++a)
#pragma unroll
            for (int m = 0; m < 4; ++m)
#pragma unroll
                for (int n = 0; n < 2; ++n) acc[a][0][m][n] = (f32x4){0.f, 0.f, 0.f, 0.f};
        cur = nxt; rC = rN; ++ui;
        if (wr == 1) PG8_BAR;
    }
    PG8_WAIT_V(0);
    asm volatile("" :: "v"(RB[0]), "v"(RB[1]), "v"(RB[2]), "v"(RB[3]));
    PG8_BAR;
#undef PG8_HLOADB
#undef PG8_HWAITB
#undef PG8_HWRITEB
}
template <class Epi, class Sched, bool F8 = false>
__device__ __forceinline__ void gemm_phase_half(PG8_LAS unsigned char* lds, int wid, const bf16_t* Abase, int lda, int acol0, int K, const Sched& S, const Epi& E) {
    const int lane = fresh_lane(), tid = wid * 64 + lane, wr = wid >> 2, wc = wid & 3, fr = lane & 15, fq = lane >> 4;
    const int nt = K / BK;
    int sR[2], sC[2]; unsigned voffB[2];
#pragma unroll
    for (int i = 0; i < 2; ++i) { stage_rc(tid * 16 + i * 8192, sR[i], sC[i]); const int Rb = Epi::PERM ? ((sR[i] & ~31) + perm32(sR[i] & 31)) : sR[i];
        voffB[i] = (unsigned)(Rb * K + sC[i]) * 2u; }
    const size_t kstep = (size_t)(BK * 2);
    const unsigned ldsw = (unsigned)wid * 1024u;
    const int aoff = lds_byte(wr * 64 + fr, fq * 8), boff = lds_byte(wc * 32 + fr, fq * 8);
    Unit cur, nxt; int ui = 0;
    if (!S.next(0, cur)) return;
    f32x4 acc[2][2][4][2];
#pragma unroll
    for (int a = 0; a < 2; ++a)
#pragma unroll
        for (int b = 0; b < 2; ++b)
#pragma unroll
            for (int m = 0; m < 4; ++m)
#pragma unroll
                for (int n = 0; n < 2; ++n) acc[a][b][m][n] = (f32x4){0.f, 0.f, 0.f, 0.f};
    bf16x8 At[4][2], B0[2][2];
    unsigned va[2][2], vn[2][2];
    PG8_AOFF0(va, cur);
    const char* const cA = (const char*)Abase;
    const char* cB = S.bbase(cur);
    PG8_STAGEX(PG8_SB(0, 0), cB, voffB); PG8_STAGEX(PG8_SA(0, 0), cA, va[0]); PG8_STAGEX(PG8_SA(0, 1), cA, va[1]);
    if (wr == 1) PG8_BAR;
    PG8_WAIT_V(2); PG8_BAR;
    PG8_STAGEX(PG8_SB(1, 0), cB + kstep, voffB); PG8_STAGEX(PG8_SA(1, 0), cA + kstep, va[0]);
    PG8_WAIT_V(4); PG8_BAR;
    for (;;) {
        const bool has_next = S.next(ui + 1, nxt);
        const char* nB = cB;
        if (has_next) { nB = S.bbase(nxt); S.prefetch(nxt, ui & 1, lds, wid, lane); }
#pragma unroll
        for (int h = 0; h < 2; ++h)
#pragma unroll
            for (int i = 0; i < 2; ++i) vn[h][i] = va[h][i];
#pragma unroll 1
        for (int t = 0; t < nt; t += 2) {
            const bool last = (t == nt - 2);
            const char* a1 = cA + (size_t)(t + 1) * kstep;
            const char* a2 = last ? cA : cA + (size_t)(t + 2) * kstep; const char* b2 = last ? nB : cB + (size_t)(t + 2) * kstep;
            const char* a3 = a2 + kstep; const char* b3 = b2 + kstep;
            if (last && has_next) PG8_AOFF1(vn, nxt, ui & 1);
            unsigned w0[2], w1[2];
            w0[0] = last ? vn[0][0] : va[0][0]; w0[1] = last ? vn[0][1] : va[0][1]; w1[0] = last ? vn[1][0] : va[1][0]; w1[1] = last ? vn[1][1] : va[1][1];
            PG8_LDB(B0, 0, 0); PG8_SCHED; PG8_LDA(At, 0, 0); PG8_STAGEX(PG8_SA(1, 1), a1, va[1]);
            PG8_WAIT_V(6); PG8_WAIT_L(0); PG8_BAR; PG8_MMAF(0, 0, At, B0); PG8_BAR; PG8_SCHED;
            PG8_LDA(At, 0, 1); PG8_STAGEX(PG8_SB(0, 0), b2, voffB); PG8_STAGEX(PG8_SA(0, 0), a2, w0);
            PG8_WAIT_V(6); PG8_WAIT_L(0); PG8_BAR; PG8_MMAF(1, 0, At, B0); PG8_BAR; PG8_SCHED;
            PG8_LDB(B0, 1, 0); PG8_SCHED; PG8_LDA(At, 1, 0); PG8_STAGEX(PG8_SA(0, 1), a2, w1);
            PG8_WAIT_V(6); PG8_WAIT_L(0); PG8_BAR; PG8_MMAF(0, 0, At, B0); PG8_BAR; PG8_SCHED;
            PG8_LDA(At, 1, 1); PG8_STAGEX(PG8_SB(1, 0), b3, voffB); PG8_STAGEX(PG8_SA(1, 0), a3, w0);
            PG8_WAIT_V(6); PG8_WAIT_L(0); PG8_BAR; PG8_MMAF(1, 0, At, B0); PG8_BAR; PG8_SCHED;
        }
        if (wr == 0) PG8_BAR;
        asm volatile("s_nop 15\n\ts_nop 15" : "+v"(acc[1][1][3][1]), "+v"(acc[1][0][3][1]));
        E.half(acc, cur, wr, wc, fr, fq);
        if (!has_next) break;
#pragma unroll
        for (int a = 0; a < 2; ++a)
#pragma unroll
            for (int m = 0; m < 4; ++m)
#pragma unroll
                for (int n = 0; n < 2; ++n) acc[a][0][m][n] = (f32x4){0.f, 0.f, 0.f, 0.f};
        cur = nxt; cB = nB; ++ui;
#pragma unroll
        for (int h = 0; h < 2; ++h)
#pragma unroll
            for (int i = 0; i < 2; ++i) va[h][i] = vn[h][i];
        if (wr == 1) PG8_BAR;
    }
    PG8_WAIT_V(0);
    PG8_BAR;
}
template <class Epi, class Sched>
__device__ __forceinline__ void gemm_phase_f8(PG8_LAS unsigned char* lds, int wid, const unsigned char* Abase, int K, int N, float wscale, const Sched& S, const Epi& E) {
    static_assert(Epi::PERM, "fp8 body: PERM epilogues only");
    const int lane = fresh_lane(), tid = wid * 64 + lane, wr = wid >> 2, wc = wid & 3, fr = lane & 15, fq = lane >> 4;
    const int nt = K / 128;
    const int lda = K / 2, acol0 = 0;
    const size_t kstep = 128;
    const unsigned ldsw = (unsigned)wid * 1024u;
    const int aoff = lds_byte(wr * 64 + fr, fq * 8), boff = lds_byte(wc * 32 + fr, fq * 8);
    const int n4 = lane, kq = wid;
    const unsigned vb = (unsigned)(kq * 8 * N + 4 * n4) * 4u;
    const int browb = N * 4, bhstep = 64 * browb, bkstep = 128 * browb;
    const int bn = 4 * n4, brow0 = ((bn & 127) & ~31) + (((n4 & 1) << 4) | (((n4 & 7) >> 1) << 2));
    const unsigned wbaddr = (unsigned)(size_t)lds + (unsigned)(4 * HTB + (bn >> 7) * HTB + lds_byte(brow0, kq * 4));
    const unsigned ldsm0 = (unsigned)(size_t)lds + ldsw;
    Unit cur, nxt; int ui = 0;
    if (!S.next(0, cur)) return;
    nxt = cur;
    f32x4 acc[2][2][4][2];
#pragma unroll
    for (int a = 0; a < 2; ++a)
#pragma unroll
        for (int b = 0; b < 2; ++b)
#pragma unroll
            for (int m = 0; m < 4; ++m)
#pragma unroll
                for (int n = 0; n < 2; ++n) acc[a][b][m][n] = (f32x4){0.f, 0.f, 0.f, 0.f};
    bf16x8 Aa[2], B0[2][2], B1[2][2];
    f32x4 RB[8];
    unsigned va[2][2];
    { int sR[2], sC[2];
_Pragma("unroll") for (int i = 0; i < 2; ++i) stage_rc(tid * 16 + i * 8192, sR[i], sC[i]);
      PG8_AOFF0(va, cur); }
    const char* const cA = (const char*)Abase;
    __amdgpu_buffer_rsrc_t rC = make_rsrc_uniform(S.bbase(cur), K * browb), rN = rC;
#define PG8_STAGE_A8(bufoff, gbase, voff) do { _Pragma("unroll") for (int _i = 0; _i < 2; ++_i) { unsigned _m0s; \
        asm volatile("s_mov_b32 %0, m0\n\ts_mov_b32 m0, %3\n\ts_nop 0\n\tglobal_load_lds_dwordx4 %1, %2\n\ts_mov_b32 m0, %0" : "=&s"(_m0s) : "v"((voff)[_i]), "s"(gbase), "s"(ldsm0 + (unsigned)((bufoff) + _i * 8192)) : "memory"); } } while (0)
#define PG8_FLOADB(rs, so) do { _Pragma("unroll") for (int _j = 0; _j < 8; ++_j) asm volatile("buffer_load_dwordx4 %0, %1, %2, %3 offen" : "=v"(RB[_j]) : "v"(vb), "s"(rs), "s"((so) + _j * browb) : "memory"); } while (0)
#define PG8_FWAITB(n) asm volatile("s_waitcnt vmcnt(" #n ")" : "+v"(RB[0]), "+v"(RB[1]), "+v"(RB[2]), "+v"(RB[3]), "+v"(RB[4]), "+v"(RB[5]), "+v"(RB[6]), "+v"(RB[7]) :: "memory")
#define PG8_FWRITEB(b, h) do { _Pragma("unroll") for (int _i = 0; _i < 4; ++_i) { u32x2 _w; v2i16 _lo, _hi; \
        _lo = __builtin_amdgcn_cvt_scalef32_pk_fp8_f32(_lo, RB[0][_i], RB[1][_i], 1.0f / wscale, false); _lo = __builtin_amdgcn_cvt_scalef32_pk_fp8_f32(_lo, RB[2][_i], RB[3][_i], 1.0f / wscale, true); \
        _hi = __builtin_amdgcn_cvt_scalef32_pk_fp8_f32(_hi, RB[4][_i], RB[5][_i], 1.0f / wscale, false); _hi = __builtin_amdgcn_cvt_scalef32_pk_fp8_f32(_hi, RB[6][_i], RB[7][_i], 1.0f / wscale, true); \
        _w.x = __builtin_bit_cast(unsigned, _lo); _w.y = __builtin_bit_cast(unsigned, _hi); \
        asm volatile("ds_write_b64 %0, %1 offset:%2" :: "v"(wbaddr), "v"(_w), "n"((b) * 2 * HTB + (h) * 1024 + 64 * _i) : "memory"); } } while (0)
#define PG8_LDA1(dst, b, h, m) do { dst[0] = *(const PG8_LAS bf16x8*)(lds + PG8_SA(b, h) + aoff + (m) * 2048); dst[1] = *(const PG8_LAS bf16x8*)(lds + PG8_SA(b, h) + aoff + (m) * 2048 + 1024); } while (0)
#if defined(F8_SCALED)
#define PG8_MM1(ai, m, A) do { _Pragma("unroll") for (int n = 0; n < 2; ++n) { \
        acc[ai][0][m][n] = __builtin_amdgcn_mfma_scale_f32_16x16x128_f8f6f4(cat8(B0[n][0], B0[n][1]), cat8(A[0], A[1]), acc[ai][0][m][n], 0, 0, 0, 0x7f7f7f7f, 0, 0x7f7f7f7f); \
        acc[ai][1][m][n] = __builtin_amdgcn_mfma_scale_f32_16x16x128_f8f6f4(cat8(B1[n][0], B1[n][1]), cat8(A[0], A[1]), acc[ai][1][m][n], 0, 0, 0, 0x7f7f7f7f, 0, 0x7f7f7f7f); } } while (0)
#else
#define PG8_MM1(ai, m, A) do { _Pragma("unroll") for (int n = 0; n < 2; ++n) _Pragma("unroll") for (int k = 0; k < 2; ++k) { \
        const v2i64 _a = __builtin_bit_cast(v2i64, A[k]), _b0 = __builtin_bit_cast(v2i64, B0[n][k]), _b1 = __builtin_bit_cast(v2i64, B1[n][k]); \
        acc[ai][0][m][n] = __builtin_amdgcn_mfma_f32_16x16x32_fp8_fp8(_b0[0], _a[0], acc[ai][0][m][n], 0, 0, 0); \
        acc[ai][0][m][n] = __builtin_amdgcn_mfma_f32_16x16x32_fp8_fp8(_b0[1], _a[1], acc[ai][0][m][n], 0, 0, 0); \
        acc[ai][1][m][n] = __builtin_amdgcn_mfma_f32_16x16x32_fp8_fp8(_b1[0], _a[0], acc[ai][1][m][n], 0, 0, 0); \
        acc[ai][1][m][n] = __builtin_amdgcn_mfma_f32_16x16x32_fp8_fp8(_b1[1], _a[1], acc[ai][1][m][n], 0, 0, 0); } } while (0)
#endif
#define PG8_MMA8(ai, b) do { __builtin_amdgcn_s_setprio(1); \
        PG8_MM1(ai, 0, Aa); PG8_SCHED; PG8_LDA1(Aa, b, ai, 1); PG8_MM1(ai, 1, Aa); PG8_SCHED; \
        PG8_LDA1(Aa, b, ai, 2); PG8_MM1(ai, 2, Aa); PG8_SCHED; \
        PG8_LDA1(Aa, b, ai, 3); PG8_MM1(ai, 3, Aa); __builtin_amdgcn_s_setprio(0); } while (0)
    PG8_FLOADB(rC, 0); PG8_FWAITB(0); PG8_FWRITEB(0, 0);
    PG8_FLOADB(rC, bhstep); PG8_STAGE_A8(PG8_SA(0, 0), cA, va[0]); PG8_STAGE_A8(PG8_SA(0, 1), cA, va[1]);
    PG8_FWAITB(4); PG8_FWRITEB(0, 1);
    PG8_FLOADB(rC, bkstep); PG8_STAGE_A8(PG8_SA(1, 0), cA + kstep, va[0]);
    if (wr == 1) PG8_BAR;
    PG8_WAIT_V(10); PG8_WAIT_L(0); PG8_BAR;
    PG8_BAR;
    for (;;) {
        const bool has_next = S.next(ui + 1, nxt);
        rN = rC;
        if (has_next) { rN = make_rsrc_uniform(S.bbase(nxt), K * browb); S.prefetch(nxt, ui & 1, lds, wid, lane); }
        E.prefetch(cur, ui & 1, lds, wid, lane);
#pragma unroll 1
        for (int t = 0; t < nt; t += 2) {
            const bool last = (t == nt - 2);
            const char* a1 = cA + (size_t)(t + 1) * kstep;
            const char* a2 = last ? cA : cA + (size_t)(t + 2) * kstep; const char* a3 = a2 + kstep;
            const __amdgpu_buffer_rsrc_t r2 = last ? rN : rC; const int so2 = last ? 0 : (t + 2) * bkstep;
            PG8_LDA1(Aa, 0, 0, 0);
            PG8_FWAITB(2); PG8_FWRITEB(1, 0); PG8_FLOADB(rC, (t + 1) * bkstep + bhstep);
            PG8_SCHED; PG8_LDB(B0, 0, 0); PG8_LDB(B1, 0, 1);
            PG8_WAIT_L(0); PG8_BAR; PG8_STAGE_A8(PG8_SA(1, 1), a1, va[1]); PG8_MMA8(0, 0); PG8_BAR; PG8_SCHED;
            { unsigned vt[2][2]; int sR[2], sC[2]; const int tz = wid * 64 + fresh_lane(); const bool sw = last && has_next;
_Pragma("unroll") for (int i = 0; i < 2; ++i) stage_rc(tz * 16 + i * 8192, sR[i], sC[i]);
              PG8_AOFF1(vt, nxt, ui & 1);
_Pragma("unroll") for (int h = 0; h < 2; ++h) _Pragma("unroll") for (int i = 0; i < 2; ++i) va[h][i] = sw ? vt[h][i] : va[h][i]; }
            PG8_LDA1(Aa, 0, 1, 0);
            PG8_FWAITB(2); PG8_FWRITEB(1, 1); PG8_FLOADB(r2, so2);
            PG8_WAIT_L(0); PG8_BAR; PG8_STAGE_A8(PG8_SA(0, 0), a2, va[0]); PG8_MMA8(1, 0); PG8_BAR; PG8_SCHED;
            PG8_LDA1(Aa, 1, 0, 0);
            PG8_FWAITB(2); PG8_FWRITEB(0, 0); PG8_FLOADB(r2, so2 + bhstep);
            PG8_SCHED; PG8_LDB(B0, 1, 0); PG8_LDB(B1, 1, 1);
            PG8_WAIT_L(0); PG8_BAR; PG8_STAGE_A8(PG8_SA(0, 1), a2, va[1]); PG8_MMA8(0, 1); PG8_BAR; PG8_SCHED;
            PG8_LDA1(Aa, 1, 1, 0);
            PG8_FWAITB(2); PG8_FWRITEB(0, 1); PG8_FLOADB(r2, so2 + bkstep);
            PG8_WAIT_L(0); PG8_BAR; PG8_STAGE_A8(PG8_SA(1, 0), a3, va[0]); PG8_MMA8(1, 1); PG8_BAR; PG8_SCHED;
        }
        if (wr == 0) PG8_BAR;
        asm volatile("s_nop 15\n\ts_nop 15" : "+v"(acc[1][1][3][1]), "+v"(acc[1][0][3][1]));
        cur.par = ui & 1; E(acc, cur, wr, wc, fr, fq);
        if (!has_next) break;
#pragma unroll
        for (int a = 0; a < 2; ++a)
#pragma unroll
            for (int b = 0; b < 2; ++b)
#pragma unroll
                for (int m = 0; m < 4; ++m)
#pragma unroll
                    for (int n = 0; n < 2; ++n) acc[a][b][m][n] = (f32x4){0.f, 0.f, 0.f, 0.f};
        cur = nxt; rC = rN; ++ui;
        if (wr == 1) PG8_BAR;
    }
    PG8_WAIT_V(0);
    asm volatile("" :: "v"(RB[0]), "v"(RB[1]), "v"(RB[2]), "v"(RB[3]), "v"(RB[4]), "v"(RB[5]), "v"(RB[6]), "v"(RB[7]));
    PG8_BAR;
#undef PG8_FLOADB
#undef PG8_STAGE_A8
#undef PG8_FWAITB
#undef PG8_FWRITEB
#undef PG8_MMA8
#undef PG8_MM1
#undef PG8_LDA1
}
template <class Epi, class Sched>
__device__ __forceinline__ void gemm_phase_f8_half(PG8_LAS unsigned char* lds, int wid, const unsigned char* Abase, int K, int N, float wscale, const Sched& S, const Epi& E) {
    static_assert(Epi::PERM, "fp8 body: PERM epilogues only");
    const int lane = fresh_lane(), tid = wid * 64 + lane, wr = wid >> 2, wc = wid & 3, fr = lane & 15, fq = lane >> 4;
    const int nt = K / 128;
    const int lda = K / 2, acol0 = 0;
    const size_t kstep = 128;
    const unsigned ldsw = (unsigned)wid * 1024u;
    const int aoff = lds_byte(wr * 64 + fr, fq * 8), boff = lds_byte(wc * 32 + fr, fq * 8);
    const int n4 = (lane & 15) + 16 * (wid & 1), kq = (lane >> 4) + 4 * (wid >> 1);
    const unsigned vb = (unsigned)(kq * 4 * N + 4 * n4) * 4u;
    const int browb = N * 4, bhstep = 64 * browb, bkstep = 128 * browb;
    const int bn = 4 * n4, brow0 = (bn & ~31) + (((n4 & 1) << 4) | (((n4 & 7) >> 1) << 2));
    const unsigned wbaddr = (unsigned)(size_t)lds + (unsigned)(4 * HTB + lds_byte(brow0, kq * 2));
    const unsigned ldsm0 = (unsigned)(size_t)lds + ldsw;
    Unit cur, nxt; int ui = 0;
    if (!S.next(0, cur)) return;
    f32x4 acc[2][2][4][2];
#pragma unroll
    for (int a = 0; a < 2; ++a)
#pragma unroll
        for (int b = 0; b < 2; ++b)
#pragma unroll
            for (int m = 0; m < 4; ++m)
#pragma unroll
                for (int n = 0; n < 2; ++n) acc[a][b][m][n] = (f32x4){0.f, 0.f, 0.f, 0.f};
    bf16x8 Aa[2], Ab[2], B0[2][2];
    f32x4 RB[4];
    unsigned va[2][2];
    { int sR[2], sC[2];
_Pragma("unroll") for (int i = 0; i < 2; ++i) stage_rc(tid * 16 + i * 8192, sR[i], sC[i]);
      PG8_AOFF0(va, cur); }
    const char* const cA = (const char*)Abase;
    __amdgpu_buffer_rsrc_t rC = make_rsrc_uniform(S.bbase(cur), K * browb), rN = rC;
#define PG8_STAGE_A8(bufoff, gbase, voff) do { _Pragma("unroll") for (int _i = 0; _i < 2; ++_i) { unsigned _m0s; \
        asm volatile("s_mov_b32 %0, m0\n\ts_mov_b32 m0, %3\n\ts_nop 0\n\tglobal_load_lds_dwordx4 %1, %2\n\ts_mov_b32 m0, %0" : "=&s"(_m0s) : "v"((voff)[_i]), "s"(gbase), "s"(ldsm0 + (unsigned)((bufoff) + _i * 8192)) : "memory"); } } while (0)
#define PG8_FLOADB(rs, so) do { _Pragma("unroll") for (int _j = 0; _j < 4; ++_j) asm volatile("buffer_load_dwordx4 %0, %1, %2, %3 offen" : "=v"(RB[_j]) : "v"(vb), "s"(rs), "s"((so) + _j * browb) : "memory"); } while (0)
#define PG8_FWAITB(n) asm volatile("s_waitcnt vmcnt(" #n ")" : "+v"(RB[0]), "+v"(RB[1]), "+v"(RB[2]), "+v"(RB[3]) :: "memory")
#define PG8_FWRITEB(b, h) do { _Pragma("unroll") for (int _i = 0; _i < 4; ++_i) { v2i16 _lo; \
        _lo = __builtin_amdgcn_cvt_scalef32_pk_fp8_f32(_lo, RB[0][_i], RB[1][_i], 1.0f / wscale, false); _lo = __builtin_amdgcn_cvt_scalef32_pk_fp8_f32(_lo, RB[2][_i], RB[3][_i], 1.0f / wscale, true); \
        asm volatile("ds_write_b32 %0, %1 offset:%2" :: "v"(wbaddr), "v"(__builtin_bit_cast(unsigned, _lo)), "n"((b) * 2 * HTB + (h) * 1024 + 64 * _i) : "memory"); } } while (0)
#define PG8_LDA1(dst, b, h, m) do { dst[0] = *(const PG8_LAS bf16x8*)(lds + PG8_SA(b, h) + aoff + (m) * 2048); dst[1] = *(const PG8_LAS bf16x8*)(lds + PG8_SA(b, h) + aoff + (m) * 2048 + 1024); } while (0)
#define PG8_MM1(ai, m, A) do { _Pragma("unroll") for (int n = 0; n < 2; ++n) \
        acc[ai][0][m][n] = __builtin_amdgcn_mfma_scale_f32_16x16x128_f8f6f4(cat8(B0[n][0], B0[n][1]), cat8(A[0], A[1]), acc[ai][0][m][n], 0, 0, 0, 0x7f7f7f7f, 0, 0x7f7f7f7f); } while (0)
#define PG8_MMA8(ai, b) do { __builtin_amdgcn_s_setprio(1); \
        PG8_LDA1(Ab, b, ai, 1); PG8_MM1(ai, 0, Aa); PG8_SCHED; \
        PG8_LDA1(Aa, b, ai, 2); PG8_MM1(ai, 1, Ab); PG8_SCHED; \
        PG8_LDA1(Ab, b, ai, 3); PG8_MM1(ai, 2, Aa); PG8_SCHED; \
        PG8_MM1(ai, 3, Ab); __builtin_amdgcn_s_setprio(0); } while (0)
    PG8_FLOADB(rC, 0); PG8_FWAITB(0); PG8_FWRITEB(0, 0);
    PG8_FLOADB(rC, bhstep); PG8_STAGE_A8(PG8_SA(0, 0), cA, va[0]); PG8_STAGE_A8(PG8_SA(0, 1), cA, va[1]);
    PG8_FWAITB(4); PG8_FWRITEB(0, 1);
    PG8_FLOADB(rC, bkstep); PG8_STAGE_A8(PG8_SA(1, 0), cA + kstep, va[0]);
    if (wr == 1) PG8_BAR;
    PG8_WAIT_V(6); PG8_WAIT_L(0); PG8_BAR;
    PG8_BAR;
    for (;;) {
        const bool has_next = S.next(ui + 1, nxt);
        rN = rC;
        if (has_next) { rN = make_rsrc_uniform(S.bbase(nxt), K * browb); S.prefetch(nxt, ui & 1, lds, wid, lane); }
        E.prefetch(cur, ui & 1, lds, wid, lane);
#pragma unroll 1
        for (int t = 0; t < nt; t += 2) {
            const bool last = (t == nt - 2);
            const char* a1 = cA + (size_t)(t + 1) * kstep;
            const char* a2 = last ? cA : cA + (size_t)(t + 2) * kstep; const char* a3 = a2 + kstep;
            const __amdgpu_buffer_rsrc_t r2 = last ? rN : rC; const int so2 = last ? 0 : (t + 2) * bkstep;
            unsigned vn[2][2];
_Pragma("unroll") for (int h = 0; h < 2; ++h) _Pragma("unroll") for (int i = 0; i < 2; ++i) vn[h][i] = va[h][i];
            if (last && has_next) { int sR[2], sC[2]; const int tz = wid * 64 + fresh_lane(); _Pragma("unroll") for (int i = 0; i < 2; ++i) stage_rc(tz * 16 + i * 8192, sR[i], sC[i]); PG8_AOFF1(vn, nxt, ui & 1); }
            PG8_LDA1(Aa, 0, 0, 0);
            PG8_FWAITB(2); PG8_FWRITEB(1, 0); PG8_FLOADB(rC, (t + 1) * bkstep + bhstep);
            PG8_SCHED; PG8_LDB(B0, 0, 0);
            PG8_WAIT_L(0); PG8_BAR; PG8_STAGE_A8(PG8_SA(1, 1), a1, va[1]); PG8_MMA8(0, 0); PG8_BAR; PG8_SCHED;
_Pragma("unroll") for (int h = 0; h < 2; ++h) _Pragma("unroll") for (int i = 0; i < 2; ++i) va[h][i] = vn[h][i];
            PG8_LDA1(Aa, 0, 1, 0);
            PG8_FWAITB(2); PG8_FWRITEB(1, 1); PG8_FLOADB(r2, so2);
            PG8_WAIT_L(0); PG8_BAR; PG8_STAGE_A8(PG8_SA(0, 0), a2, va[0]); PG8_MMA8(1, 0); PG8_BAR; PG8_SCHED;
            PG8_LDA1(Aa, 1, 0, 0);
            PG8_FWAITB(2); PG8_FWRITEB(0, 0); PG8_FLOADB(r2, so2 + bhstep);
            PG8_SCHED; PG8_LDB(B0, 1, 0);
            PG8_WAIT_L(0); PG8_BAR; PG8_STAGE_A8(PG8_SA(0, 1), a2, va[1]); PG8_MMA8(0, 1); PG8_BAR; PG8_SCHED;
            PG8_LDA1(Aa, 1, 1, 0);
            PG8_FWAITB(2); PG8_FWRITEB(0, 1); PG8_FLOADB(r2, so2 + bkstep);
            PG8_WAIT_L(0); PG8_BAR; PG8_STAGE_A8(PG8_SA(1, 0), a3, va[0]); PG8_MMA8(1, 1); PG8_BAR; PG8_SCHED;
        }
        if (wr == 0) PG8_BAR;
        asm volatile("s_nop 15\n\ts_nop 15" : "+v"(acc[1][0][3][1]), "+v"(acc[0][0][3][1]));
        cur.par = ui & 1; E.half(acc, cur, wr, wc, fr, fq);
        if (!has_next) break;
#pragma unroll
        for (int a = 0; a < 2; ++a)
#pragma unroll
            for (int m = 0; m < 4; ++m)
#pragma unroll
                for (int n = 0; n < 2; ++n) acc[a][0][m][n] = (f32x4){0.f, 0.f, 0.f, 0.f};
        cur = nxt; rC = rN; ++ui;
        if (wr == 1) PG8_BAR;
    }
    PG8_WAIT_V(0);
    asm volatile("" :: "v"(RB[0]), "v"(RB[1]), "v"(RB[2]), "v"(RB[3]));
    PG8_BAR;
#undef PG8_FLOADB
#undef PG8_STAGE_A8
#undef PG8_FWAITB
#undef PG8_FWRITEB
#undef PG8_MMA8
#undef PG8_MM1
#undef PG8_LDA1
}
template <class Epi, class Sched>
__device__ __forceinline__ void gemm_phase_f8d(PG8_LAS unsigned char* lds, int wid, const unsigned char* Abase, int K, const Sched& S, const Epi& E) {
    static_assert(Epi::PERM, "fp8 body: PERM epilogues only");
    const int lane = fresh_lane(), tid = wid * 64 + lane, wr = wid >> 2, wc = wid & 3, fr = lane & 15, fq = lane >> 4;
    const int nt = K / 128;
    const int lda = K / 2, acol0 = 0;
    const size_t kstep = 128;
    const unsigned ldsw = (unsigned)wid * 1024u;
    const int aoff = lds_byte(wr * 64 + fr, fq * 8), boff = lds_byte(wc * 32 + fr, fq * 8);
    unsigned voffB[2];
    { int sR[2], sC[2];
_Pragma("unroll") for (int i = 0; i < 2; ++i) { stage_rc(tid * 16 + i * 8192, sR[i], sC[i]); voffB[i] = (unsigned)(((sR[i] & ~31) + perm32(sR[i] & 31)) * K + sC[i] * 2); } }
    const size_t hstepB = (size_t)HALF * K;
    const unsigned ldsm0 = (unsigned)(size_t)lds + ldsw;
    Unit cur, nxt; int ui = 0;
    if (!S.next(0, cur)) return;
    nxt = cur;
    f32x4 acc[2][2][4][2];
#pragma unroll
    for (int a = 0; a < 2; ++a)
#pragma unroll
        for (int b = 0; b < 2; ++b)
#pragma unroll
            for (int m = 0; m < 4; ++m)
#pragma unroll
                for (int n = 0; n < 2; ++n) acc[a][b][m][n] = (f32x4){0.f, 0.f, 0.f, 0.f};
    bf16x8 Aa[2], Ab[2], Ac[2], B0[2][2], B1[2][2];
    unsigned va[2][2];
    { int sR[2], sC[2];
_Pragma("unroll") for (int i = 0; i < 2; ++i) stage_rc(tid * 16 + i * 8192, sR[i], sC[i]);
      PG8_AOFF0(va, cur); }
    const char* const cA = (const char*)Abase;
    const char* cB = S.bbase(cur);
#define PG8_STAGE_A8(bufoff, gbase, voff) do { _Pragma("unroll") for (int _i = 0; _i < 2; ++_i) { unsigned _m0s; \
        asm volatile("s_mov_b32 %0, m0\n\ts_mov_b32 m0, %3\n\ts_nop 0\n\tglobal_load_lds_dwordx4 %1, %2\n\ts_mov_b32 m0, %0" : "=&s"(_m0s) : "v"((voff)[_i]), "s"(gbase), "s"(ldsm0 + (unsigned)((bufoff) + _i * 8192)) : "memory"); } } while (0)
#define PG8_LDA1(dst, b, h, m) do { dst[0] = *(const PG8_LAS bf16x8*)(lds + PG8_SA(b, h) + aoff + (m) * 2048); dst[1] = *(const PG8_LAS bf16x8*)(lds + PG8_SA(b, h) + aoff + (m) * 2048 + 1024); } while (0)
#if defined(F8_SCALED)
#define PG8_MM1(ai, m, A) do { _Pragma("unroll") for (int n = 0; n < 2; ++n) { \
        acc[ai][0][m][n] = __builtin_amdgcn_mfma_scale_f32_16x16x128_f8f6f4(cat8(B0[n][0], B0[n][1]), cat8(A[0], A[1]), acc[ai][0][m][n], 0, 0, 0, 0x7f7f7f7f, 0, 0x7f7f7f7f); \
        acc[ai][1][m][n] = __builtin_amdgcn_mfma_scale_f32_16x16x128_f8f6f4(cat8(B1[n][0], B1[n][1]), cat8(A[0], A[1]), acc[ai][1][m][n], 0, 0, 0, 0x7f7f7f7f, 0, 0x7f7f7f7f); } } while (0)
#else
#define PG8_MM1(ai, m, A) do { _Pragma("unroll") for (int n = 0; n < 2; ++n) _Pragma("unroll") for (int k = 0; k < 2; ++k) { \
        const v2i64 _a = __builtin_bit_cast(v2i64, A[k]), _b0 = __builtin_bit_cast(v2i64, B0[n][k]), _b1 = __builtin_bit_cast(v2i64, B1[n][k]); \
        acc[ai][0][m][n] = __builtin_amdgcn_mfma_f32_16x16x32_fp8_fp8(_b0[0], _a[0], acc[ai][0][m][n], 0, 0, 0); \
        acc[ai][0][m][n] = __builtin_amdgcn_mfma_f32_16x16x32_fp8_fp8(_b0[1], _a[1], acc[ai][0][m][n], 0, 0, 0); \
        acc[ai][1][m][n] = __builtin_amdgcn_mfma_f32_16x16x32_fp8_fp8(_b1[0], _a[0], acc[ai][1][m][n], 0, 0, 0); \
        acc[ai][1][m][n] = __builtin_amdgcn_mfma_f32_16x16x32_fp8_fp8(_b1[1], _a[1], acc[ai][1][m][n], 0, 0, 0); } } while (0)
#endif
#define PG8_MMA8(ai, b) do { __builtin_amdgcn_s_setprio(1); \
        PG8_LDA1(Ac, b, ai, 2); PG8_MM1(ai, 0, Aa); PG8_SCHED; \
        PG8_LDA1(Aa, b, ai, 3); PG8_MM1(ai, 1, Ab); PG8_SCHED; \
        PG8_MM1(ai, 2, Ac); PG8_SCHED; \
        PG8_MM1(ai, 3, Aa); __builtin_amdgcn_s_setprio(0); } while (0)
    PG8_STAGE_A8(PG8_SB(0, 0), cB, voffB); PG8_STAGE_A8(PG8_SB(0, 1), cB + hstepB, voffB); PG8_STAGE_A8(PG8_SA(0, 0), cA, va[0]); PG8_STAGE_A8(PG8_SA(0, 1), cA, va[1]);
    PG8_STAGE_A8(PG8_SB(1, 0), cB + kstep, voffB); PG8_STAGE_A8(PG8_SB(1, 1), cB + hstepB + kstep, voffB); PG8_STAGE_A8(PG8_SA(1, 0), cA + kstep, va[0]);
    if (wr == 1) PG8_BAR;
    PG8_WAIT_V(6); PG8_BAR;
    PG8_BAR;
    for (;;) {
        const bool has_next = S.next(ui + 1, nxt);
        const char* nB = cB;
        if (has_next) { nB = S.bbase(nxt); S.prefetch(nxt, ui & 1, lds, wid, lane); }
#pragma unroll 1
        for (int t = 0; t < nt; t += 2) {
            const bool last = (t == nt - 2);
            const char* a1 = cA + (size_t)(t + 1) * kstep;
            const char* a2 = last ? cA : cA + (size_t)(t + 2) * kstep; const char* a3 = a2 + kstep;
            const char* b2 = last ? nB : cB + (size_t)(t + 2) * kstep; const char* b3 = b2 + kstep;
            PG8_LDA1(Aa, 0, 0, 0); PG8_LDA1(Ab, 0, 0, 1); PG8_LDB(B0, 0, 0); PG8_LDB(B1, 0, 1);
            PG8_WAIT_V(6); PG8_WAIT_L(0); PG8_BAR; PG8_STAGE_A8(PG8_SA(1, 1), a1, va[1]); PG8_MMA8(0, 0); PG8_BAR; PG8_SCHED;
            { unsigned vt[2][2]; int sR[2], sC[2]; const int tz = wid * 64 + fresh_lane(); const bool sw = last && has_next;
_Pragma("unroll") for (int i = 0; i < 2; ++i) stage_rc(tz * 16 + i * 8192, sR[i], sC[i]);
              PG8_AOFF1(vt, nxt, ui & 1);
_Pragma("unroll") for (int h = 0; h < 2; ++h) _Pragma("unroll") for (int i = 0; i < 2; ++i) va[h][i] = sw ? vt[h][i] : va[h][i]; }
            PG8_LDA1(Aa, 0, 1, 0); PG8_LDA1(Ab, 0, 1, 1);
            PG8_WAIT_V(2); PG8_WAIT_L(0); PG8_BAR; PG8_STAGE_A8(PG8_SB(0, 0), b2, voffB); PG8_STAGE_A8(PG8_SB(0, 1), b2 + hstepB, voffB); PG8_STAGE_A8(PG8_SA(0, 0), a2, va[0]); PG8_MMA8(1, 0); PG8_BAR; PG8_SCHED;
            PG8_LDA1(Aa, 1, 0, 0); PG8_LDA1(Ab, 1, 0, 1); PG8_LDB(B0, 1, 0); PG8_LDB(B1, 1, 1);
            PG8_WAIT_V(6); PG8_WAIT_L(0); PG8_BAR; PG8_STAGE_A8(PG8_SA(0, 1), a2, va[1]); PG8_MMA8(0, 1); PG8_BAR; PG8_SCHED;
            PG8_LDA1(Aa, 1, 1, 0); PG8_LDA1(Ab, 1, 1, 1);
            PG8_WAIT_V(2); PG8_WAIT_L(0); PG8_BAR; PG8_STAGE_A8(PG8_SB(1, 0), b3, voffB); PG8_STAGE_A8(PG8_SB(1, 1), b3 + hstepB, voffB); PG8_STAGE_A8(PG8_SA(1, 0), a3, va[0]); PG8_MMA8(1, 1); PG8_BAR; PG8_SCHED;
        }
        if (wr == 0) PG8_BAR;
        asm volatile("s_nop 15\n\ts_nop 15" : "+v"(acc[1][1][3][1]), "+v"(acc[1][0][3][1]));
        E(acc, cur, wr, wc, fr, fq);
        if (!has_next) break;
#pragma unroll
        for (int a = 0; a < 2; ++a)
#pragma unroll
            for (int b = 0; b < 2; ++b)
#pragma unroll
                for (int m = 0; m < 4; ++m)
#pragma unroll
                    for (int n = 0; n < 2; ++n) acc[a][b][m][n] = (f32x4){0.f, 0.f, 0.f, 0.f};
        cur = nxt; cB = nB; ++ui;
        if (wr == 1) PG8_BAR;
    }
    PG8_WAIT_V(0);
    PG8_BAR;
#undef PG8_STAGE_A8
#undef PG8_MMA8
#undef PG8_MM1
#undef PG8_LDA1
}
#undef PG8_SA
#undef PG8_SB
#undef PG8_STAGE
#undef PG8_STAGEX
#undef PG8_STAGE_A
#undef PG8_LDA
#undef PG8_LDB
#undef PG8_MMA
#undef PG8_MMAF
#undef PG8_WAIT_V
#undef PG8_WAIT_L
#undef PG8_BAR
#undef PG8_SCHED
#undef PG8_AOFF0
#undef PG8_AOFF1

struct DenseOrder {
    int nM, nN, nwg, G, c; const bf16_t* Bt; int K; const float* Wf;
    int mode;
    __device__ __forceinline__ void init(int M, int N, int G_, int c_, const bf16_t* Bt_, int K_, const float* Wf_ = nullptr, int mode_ = 0) { nM = M / BM; nN = N / BM; nwg = nM * nN; G = G_; c = c_; Bt = Bt_; K = K_; Wf = Wf_; mode = mode_; }
    __device__ __forceinline__ bool next(int i, Unit& u) const {
        const int full = (nwg / G) * G, rem = nwg - full; const bool use_half = rem > 0 && 2 * rem <= G;
        long L = (long)i * G + c; int hn = 0;
        if (mode == 2) { if (!use_half || L >= 2 * rem) return false; hn = (int)(L & 1); L = full + (L >> 1); }
        else if (L >= ((mode == 1 && use_half) ? full : nwg)) return false;
        const int wgid = xcd_remap((int)L, nwg);
        const int nig = 8 * nN, gid = wgid / nig, fm = gid * 8, gsz = (nM - fm) < 8 ? (nM - fm) : 8;
        u.pm = fm + ((wgid % nig) % gsz); u.pn = (wgid % nig) / gsz; u.e = 0; u.lm = u.pm; u.aux = 0; u.hn = hn; return true;
    }
    __device__ __forceinline__ int arow0(const Unit& u, int r) const { return u.pm * BM + r; }
    __device__ __forceinline__ int arow1(const Unit& u, int r, int, PG8_LAS unsigned char*) const { return u.pm * BM + r; }
    __device__ __forceinline__ void prefetch(const Unit&, int, PG8_LAS unsigned char*, int, int) const {}
    __device__ __forceinline__ void round_sync(int, int, int) const {}
    __device__ __forceinline__ const char* bbase(const Unit& u) const { if (Wf) return (const char*)Wf + ((size_t)u.pn * BM + (size_t)u.hn * HALF) * 4; return (const char*)Bt + ((size_t)u.pn * BM + (size_t)u.hn * HALF) * K * 2; }
    __device__ __forceinline__ const char* wbbase(const Unit& u) const { return (const char*)Bt + (size_t)u.pn * BM * K * 2; }
};

struct EpiBf16 {
    static constexpr bool PERM = true;
    bf16_t* O; int ldc; int ocol0; const float* cscale;
    __device__ __forceinline__ void operator()(const f32x4 (&acc)[2][2][4][2], const Unit& u, int wr, int wc, int fr, int fq) const { apply<2>(acc, u, wr, wc, fr, fq, 0); }
    __device__ __forceinline__ void half(const f32x4 (&acc)[2][2][4][2], const Unit& u, int wr, int wc, int fr, int fq) const { apply<1>(acc, u, wr, wc, fr, fq, u.hn * HALF); }
    template <int NBJ> __device__ __forceinline__ void apply(const f32x4 (&acc)[2][2][4][2], const Unit& u, int wr, int wc, int fr, int fq, int cofs) const {
        const int row0 = u.pm * BM + wr * 64 + fr; const int col0 = u.pn * BM + cofs + wc * 32 + 8 * fq;
        f32x4 sv[2][2];
#pragma unroll
        for (int bj = 0; bj < NBJ; ++bj)
#pragma unroll
            for (int n = 0; n < 2; ++n) sv[bj][n] = cscale ? *(const f32x4*)(cscale + col0 + bj * HALF + 4 * n) : (f32x4){1.f, 1.f, 1.f, 1.f};
#pragma unroll
        for (int ai = 0; ai < 2; ++ai)
#pragma unroll
            for (int m = 0; m < 4; ++m) { bf16_t* rowp = O + (size_t)(row0 + ai * HALF + m * 16) * ldc + ocol0 + col0;
#pragma unroll
                for (int bj = 0; bj < NBJ; ++bj) { const f32x4 v0 = acc[ai][bj][m][0] * sv[bj][0], v1 = acc[ai][bj][m][1] * sv[bj][1];
                    u32x4 w; w.x = cvt_pk_bf16(v0[0], v0[1]); w.y = cvt_pk_bf16(v0[2], v0[3]); w.z = cvt_pk_bf16(v1[0], v1[1]); w.w = cvt_pk_bf16(v1[2], v1[3]);
                    *(u32x4*)(rowp + bj * HALF) = w; } }
    }
};
struct EpiF32 {
    static constexpr bool PERM = false;
    float* C; int ldc;
    __device__ __forceinline__ void operator()(const f32x4 (&acc)[2][2][4][2], const Unit& u, int wr, int wc, int fr, int fq) const {
        const int row0 = u.pm * BM + wr * 64 + fr, col0 = u.pn * BM + wc * 32 + 4 * fq;
#pragma unroll
        for (int ai = 0; ai < 2; ++ai)
#pragma unroll
            for (int m = 0; m < 4; ++m) { float* rowp = C + (size_t)(row0 + ai * HALF + m * 16) * ldc + col0;
#pragma unroll
                for (int bj = 0; bj < 2; ++bj)
#pragma unroll
                    for (int n = 0; n < 2; ++n) *(f32x4*)(rowp + bj * HALF + n * 16) = acc[ai][bj][m][n]; }
    }
};
__device__ __forceinline__ float swiglu1(float g, float l) {
    const float gl = fminf(g, 7.0f), li = fminf(fmaxf(l, -7.0f), 7.0f);
    const float sg = __builtin_amdgcn_rcpf(1.0f + __builtin_amdgcn_exp2f(-1.702f * 1.4426950408889634f * gl));
    return gl * sg * (li + 1.0f);
}
template <int KNOB> struct EpiSwigluT {
    static constexpr bool PERM = true;
    bf16_t* O; const float* bias;
    __device__ __forceinline__ void operator()(const f32x4 (&acc)[2][2][4][2], const Unit& u, int wr, int wc, int fr, int fq) const { apply<2>(acc, u, wr, wc, fr, fq, 0); }
    __device__ __forceinline__ void half(const f32x4 (&acc)[2][2][4][2], const Unit& u, int wr, int wc, int fr, int fq) const { apply<1>(acc, u, wr, wc, fr, fq, u.hn * HALF); }
    template <int NBJ> __device__ __forceinline__ void apply(const f32x4 (&acc)[2][2][4][2], const Unit& u, int wr, int wc, int fr, int fq, int cofs) const {
        const int row0 = u.pm * BM + wr * 64 + fr; const int col0 = u.pn * BM + cofs + wc * 32 + 8 * fq;
        const float* bp = bias + (size_t)u.e * 4096 + col0;
        f32x4 bv[2][2];
#pragma unroll
        for (int bj = 0; bj < NBJ; ++bj)
#pragma unroll
            for (int n = 0; n < 2; ++n) bv[bj][n] = *(const f32x4*)(bp + bj * HALF + 4 * n);
#pragma unroll
        for (int ai = 0; ai < 2; ++ai)
#pragma unroll
            for (int m = 0; m < 4; ++m) { bf16_t* rowp = O + (size_t)(row0 + ai * HALF + m * 16) * 2048 + (col0 >> 1);
#pragma unroll
                for (int bj = 0; bj < NBJ; ++bj) { const f32x4 v0 = acc[ai][bj][m][0] + bv[bj][0], v1 = acc[ai][bj][m][1] + bv[bj][1];
#if 0
                    u32x2 w; w.x = cvt_pk_bf16(v0[0] + v0[1], v0[2] + v0[3]); w.y = cvt_pk_bf16(v1[0] + v1[1], v1[2] + v1[3]);
#else
                    u32x2 w; w.x = cvt_pk_bf16(swiglu1(v0[0], v0[1]), swiglu1(v0[2], v0[3])); w.y = cvt_pk_bf16(swiglu1(v1[0], v1[1]), swiglu1(v1[2], v1[3]));
#endif
                    if (KNOB == 2) { w.x = cvt_pk_bf16(v0[0] + v0[1], v0[2] + v0[3]); w.y = cvt_pk_bf16(v1[0] + v1[1], v1[2] + v1[3]); }
                    if (KNOB != 1 || u.aux < 0) *(u32x2*)(rowp + bj * (HALF / 2)) = w; } }
    }
};
typedef EpiSwigluT<0> EpiSwiglu;
struct EpiDown {
    static constexpr bool PERM = true;
    bf16_t* O; const float* bias; const float* gate;
    __device__ __forceinline__ void operator()(const f32x4 (&acc)[2][2][4][2], const Unit& u, int wr, int wc, int fr, int fq) const { apply<2>(acc, u, wr, wc, fr, fq, 0); }
    __device__ __forceinline__ void half(const f32x4 (&acc)[2][2][4][2], const Unit& u, int wr, int wc, int fr, int fq) const { apply<1>(acc, u, wr, wc, fr, fq, u.hn * HALF); }
    template <int NBJ> __device__ __forceinline__ void apply(const f32x4 (&acc)[2][2][4][2], const Unit& u, int wr, int wc, int fr, int fq, int cofs) const {
        const int lrow0 = u.lm * BM + wr * 64 + fr;
        const int row0 = u.pm * BM + wr * 64 + fr; const int col0 = u.pn * BM + cofs + wc * 32 + 8 * fq;
        const float* bp = bias + (size_t)u.e * 2048 + col0; const float* gp = gate + (size_t)u.e * 8192 + lrow0;
        f32x4 bv[2][2];
#pragma unroll
        for (int bj = 0; bj < NBJ; ++bj)
#pragma unroll
            for (int n = 0; n < 2; ++n) bv[bj][n] = *(const f32x4*)(bp + bj * HALF + 4 * n);
#pragma unroll
        for (int ai = 0; ai < 2; ++ai)
#pragma unroll
            for (int m = 0; m < 4; ++m) { bf16_t* rowp = O + (size_t)(row0 + ai * HALF + m * 16) * 2048 + col0; const float gt = gp[ai * HALF + m * 16];
#pragma unroll
                for (int bj = 0; bj < NBJ; ++bj) { const f32x4 v0 = (acc[ai][bj][m][0] + bv[bj][0]) * gt, v1 = (acc[ai][bj][m][1] + bv[bj][1]) * gt;
                    u32x4 w; w.x = cvt_pk_bf16(v0[0], v0[1]); w.y = cvt_pk_bf16(v0[2], v0[3]); w.z = cvt_pk_bf16(v1[0], v1[1]); w.w = cvt_pk_bf16(v1[2], v1[3]);
                    *(u32x4*)(rowp + bj * HALF) = w; } }
    }
};
struct EpiSwiglu8 {
    static constexpr bool PERM = true;
    unsigned char* O; const float* bias; float sc; PG8_LAS unsigned char* lds;
    __device__ __forceinline__ void prefetch(const Unit& u, int par, PG8_LAS unsigned char* l, int wid, int) const {
        const int lane = fresh_lane();
        if (wid < 4) __builtin_amdgcn_global_load_lds((const unsigned*)(bias + (size_t)u.e * 4096 + u.pn * BM + wid * 64 + lane), (PG8_LAS unsigned*)(l + 131072 + par * 1024 + wid * 256), 4, 0, 0);
    }
    __device__ __forceinline__ void operator()(const f32x4 (&acc)[2][2][4][2], const Unit& u, int wr, int wc, int fr, int fq) const { apply<2>(acc, u, wr, wc, fr, fq, 0); }
    __device__ __forceinline__ void half(const f32x4 (&acc)[2][2][4][2], const Unit& u, int wr, int wc, int fr, int fq) const { apply<1>(acc, u, wr, wc, fr, fq, u.hn * HALF); }
    template <int NBJ> __device__ __forceinline__ void apply(const f32x4 (&acc)[2][2][4][2], const Unit& u, int wr, int wc, int fr, int fq, int cofs) const {
        const int row0 = u.pm * BM + wr * 64 + fr; const int col0 = u.pn * BM + cofs + wc * 32 + 8 * fq;
        const PG8_LAS float* bp = (const PG8_LAS float*)(lds + 131072 + u.par * 1024) + cofs + wc * 32 + 8 * fq;
        f32x4 bv[2][2];
#pragma unroll
        for (int bj = 0; bj < NBJ; ++bj)
#pragma unroll
            for (int n = 0; n < 2; ++n) bv[bj][n] = *(const PG8_LAS f32x4*)(bp + bj * HALF + 4 * n);
#pragma unroll
        for (int ai = 0; ai < 2; ++ai)
#pragma unroll
            for (int m = 0; m < 4; ++m) { unsigned char* rowp = O + (size_t)(row0 + ai * HALF + m * 16) * 2048 + (col0 >> 1);
#pragma unroll
                for (int bj = 0; bj < NBJ; ++bj) { const f32x4 v0 = acc[ai][bj][m][0] * sc + bv[bj][0], v1 = acc[ai][bj][m][1] * sc + bv[bj][1];
                    int w = __builtin_amdgcn_cvt_pk_fp8_f32(swiglu1(v0[0], v0[1]), swiglu1(v0[2], v0[3]), 0, false);
                    w = __builtin_amdgcn_cvt_pk_fp8_f32(swiglu1(v1[0], v1[1]), swiglu1(v1[2], v1[3]), w, true);
                    *(int*)(rowp + bj * (HALF / 2)) = w; } }
    }
};
struct EpiDown8 {
    static constexpr bool PERM = true;
    bf16_t* O; const float* bias; const float* gate; float sc; PG8_LAS unsigned char* lds;
    __device__ __forceinline__ void prefetch(const Unit& u, int par, PG8_LAS unsigned char* l, int wid, int) const {
        const int lane = fresh_lane();
        if (wid < 4) __builtin_amdgcn_global_load_lds((const unsigned*)(bias + (size_t)u.e * 2048 + u.pn * BM + wid * 64 + lane), (PG8_LAS unsigned*)(l + 131072 + par * 1024 + wid * 256), 4, 0, 0);
        else __builtin_amdgcn_global_load_lds((const unsigned*)(gate + (size_t)u.e * 8192 + u.lm * BM + (wid - 4) * 64 + lane), (PG8_LAS unsigned*)(l + 133120 + par * 1024 + (wid - 4) * 256), 4, 0, 0);
    }
    __device__ __forceinline__ void operator()(const f32x4 (&acc)[2][2][4][2], const Unit& u, int wr, int wc, int fr, int fq) const { apply<2>(acc, u, wr, wc, fr, fq, 0); }
    __device__ __forceinline__ void half(const f32x4 (&acc)[2][2][4][2], const Unit& u, int wr, int wc, int fr, int fq) const { apply<1>(acc, u, wr, wc, fr, fq, u.hn * HALF); }
    template <int NBJ> __device__ __forceinline__ void apply(const f32x4 (&acc)[2][2][4][2], const Unit& u, int wr, int wc, int fr, int fq, int cofs) const {
        const int lrow0 = u.lm * BM + wr * 64 + fr;
        const int row0 = u.pm * BM + wr * 64 + fr; const int col0 = u.pn * BM + cofs + wc * 32 + 8 * fq;
        const PG8_LAS float* bp = (const PG8_LAS float*)(lds + 131072 + u.par * 1024) + cofs + wc * 32 + 8 * fq; const PG8_LAS float* gp = (const PG8_LAS float*)(lds + 133120 + u.par * 1024) + wr * 64 + fr;
        f32x4 bv[2][2];
#pragma unroll
        for (int bj = 0; bj < NBJ; ++bj)
#pragma unroll
            for (int n = 0; n < 2; ++n) bv[bj][n] = *(const PG8_LAS f32x4*)(bp + bj * HALF + 4 * n);
#pragma unroll
        for (int ai = 0; ai < 2; ++ai)
#pragma unroll
            for (int m = 0; m < 4; ++m) { bf16_t* rowp = O + (size_t)(row0 + ai * HALF + m * 16) * 2048 + col0; const float gt = gp[ai * HALF + m * 16];
#pragma unroll
                for (int bj = 0; bj < NBJ; ++bj) { const f32x4 v0 = (acc[ai][bj][m][0] * sc + bv[bj][0]) * gt, v1 = (acc[ai][bj][m][1] * sc + bv[bj][1]) * gt;
                    u32x4 w; w.x = cvt_pk_bf16(v0[0], v0[1]); w.y = cvt_pk_bf16(v0[2], v0[3]); w.z = cvt_pk_bf16(v1[0], v1[1]); w.w = cvt_pk_bf16(v1[2], v1[3]);
                    *(u32x4*)(rowp + bj * HALF) = w; } }
    }
};
}
namespace fk {
constexpr int NWAVES = 8, NTHR = 512;
constexpr int S_ = 2048, D_ = 2048, T_ = 8192, INW = 5120, RW = 1024, NH = 8, DH = 128, NE = 32, FF = 2048, NCH = 16;
constexpr float ALPHA = 1.189207115002721f;
constexpr float LOG2E = 1.4426950408889634f;

constexpr size_t MiB = 1ull << 20;
constexpr size_t WS_CTL = 0, CTL_ZERO_BYTES = 1 * MiB;
constexpr size_t WS_WIN_T = 2 * MiB, WS_WOUT_T = 22 * MiB, WS_POOLW_T = 30 * MiB, WS_ROPE = 31 * MiB, WS_XB = 32 * MiB, WS_PROJB = 64 * MiB,
                 WS_KVT = 144 * MiB, WS_PB = 176 * MiB, WS_MIXEDB = 192 * MiB, WS_MIX = 224 * MiB, WS_H = 288 * MiB, WS_HB = 352 * MiB,
                 WS_STOK = 384 * MiB, WS_SGATE = 385 * MiB, WS_TOKE = 386 * MiB, WS_TOKR = 387 * MiB, WS_ACTB = 392 * MiB, WS_OUTS = 552 * MiB,
                 WS_WGU_T = 768 * MiB, WS_WD_T = 1280 * MiB, WS_END = 1536 * MiB;
constexpr size_t WS_HB8 = 768 * MiB, WS_ACT8 = 800 * MiB, WS_WGU8 = 1024 * MiB, WS_WD8 = 1280 * MiB;
constexpr int PAD_ROWS = 40960;
constexpr int CW_TMO = 0, CW_CODE = 1, CW_BAR = 4096, CW_CNT = 8192, CW_XSYNC = 12288;

constexpr int RING_BYTES = 131072;
constexpr int RT_LD = 136, RT_BYTES = 128 * RT_LD * 2;
constexpr int REG0 = 0, REG1 = RT_BYTES, REG2 = 2 * RT_BYTES, REG3 = 3 * RT_BYTES;
constexpr int LDSCTL_OFF = 4 * RT_BYTES;
constexpr int MISC_OFF = LDSCTL_OFF, TS_OFF = LDSCTL_OFF + 256, TOKBUF_OFF = LDSCTL_OFF + 1024, EX_OFF = LDSCTL_OFF + 3072;
constexpr int LDS_BYTES = 147456;
static_assert(LDSCTL_OFF >= RING_BYTES && EX_OFF + 2048 <= LDS_BYTES, "LDS map");

#define GAS __attribute__((address_space(1)))
#define LAS __attribute__((address_space(3)))
typedef unsigned short bf16;
typedef unsigned v4u __attribute__((ext_vector_type(4)));
typedef unsigned v2u __attribute__((ext_vector_type(2)));
typedef float f32x4 __attribute__((ext_vector_type(4)));
typedef float f32x2 __attribute__((ext_vector_type(2)));
typedef short bf16x8 __attribute__((ext_vector_type(8)));
typedef GAS unsigned gu32;
#define RLX_AGENT __ATOMIC_RELAXED, __HIP_MEMORY_SCOPE_AGENT
#define LDS_WAIT() asm volatile("s_waitcnt lgkmcnt(0)" ::: "memory")
#define VM_WAIT() asm volatile("s_waitcnt vmcnt(0)" ::: "memory")
__device__ __forceinline__ unsigned f2bf(float f) { unsigned u = __builtin_bit_cast(unsigned, f); return (u + 0x7fffu + ((u >> 16) & 1u)) >> 16; }
__device__ __forceinline__ unsigned pk2(float lo, float hi) { unsigned r; asm("v_cvt_pk_bf16_f32 %0, %1, %2" : "=v"(r) : "v"(lo), "v"(hi)); return r; }
__device__ __forceinline__ float bflo(unsigned w) { return __builtin_bit_cast(float, w << 16); }
__device__ __forceinline__ float bfhi(unsigned w) { return __builtin_bit_cast(float, w & 0xffff0000u); }

#define XB_TMO      128
#define XB_XCNT(j)  (256  + 64 * (j))
#define XB_XSUB(j)  (1280 + 64 * (j))
#define XB_XGEN(j)  (2304 + 64 * (j))
#define XB_TOP      3328
#define XB_TOPGEN   3392
#define XCD_BAR_WORDS 3456
#define XB_SPIN_CAP (1u << 18)
__device__ __forceinline__ unsigned xb_ld(unsigned* p)              { return __hip_atomic_load(p, __ATOMIC_RELAXED, __HIP_MEMORY_SCOPE_AGENT); }
__device__ __forceinline__ unsigned xb_add(unsigned* p, unsigned v) { return __hip_atomic_fetch_add(p, v, __ATOMIC_RELAXED, __HIP_MEMORY_SCOPE_AGENT); }
__device__ __forceinline__ unsigned xb_xcc_id() { return (unsigned)__builtin_amdgcn_s_getreg((3 << 11) | 20) & 0xFu; }
#define XB_SPIN(cond, bar) do { unsigned _sp = 0; while (cond) { __builtin_amdgcn_s_sleep(1); \
    if ((++_sp & 255u) == 0u) { if (xb_ld(&(bar)[XB_TMO])) break; if (_sp > XB_SPIN_CAP) { atomicAdd(&(bar)[XB_TMO], 1u); break; } } } } while (0)
struct XcdBarrier { unsigned* bar; unsigned x; volatile LAS unsigned* st; int wave; };
__device__ __forceinline__ XcdBarrier xcd_barrier_post(unsigned* bar, volatile LAS unsigned* st) {
    XcdBarrier b; b.bar = bar; b.x = xb_xcc_id(); b.st = st; b.wave = __builtin_amdgcn_readfirstlane(threadIdx.x >> 6);
    if (threadIdx.x == 0) st[2] = xb_add(&bar[XB_XCNT(b.x)], 1u);
    return b;
}
__device__ __forceinline__ void xcd_barrier_complete(unsigned* bar, unsigned x, unsigned& nloc, unsigned& nx) {
    const unsigned G = gridDim.x * gridDim.y * gridDim.z;
    unsigned sum, cnt, mine, sp = 0u;
    for (;;) {
        sum = 0u; cnt = 0u; mine = 0u;
#pragma unroll
        for (unsigned j = 0; j < 16; ++j) { const unsigned c = xb_ld(&bar[XB_XCNT(j)]); sum += c; cnt += (c > 0u) ? 1u : 0u; mine = (j == x) ? c : mine; }
        if (sum == G) break;
        __builtin_amdgcn_s_sleep(1);
        if ((++sp & 255u) == 0u) { if (xb_ld(&bar[XB_TMO])) break; if (sp > XB_SPIN_CAP) { atomicAdd(&bar[XB_TMO], 1u); break; } }
    }
    nloc = mine > 0u ? mine : 1u; nx = cnt > 0u ? cnt : 1u;
}
__device__ __forceinline__ void xcd_barrier(const XcdBarrier& b) {
    asm volatile("s_waitcnt vmcnt(0)" ::: "memory");
    __syncthreads();
    if (b.wave == 0 && pg8::fresh_lane() == 0) {
        unsigned* bar = b.bar;
        __builtin_amdgcn_s_waitcnt(0);
        unsigned nloc = b.st[0], nx = b.st[1];
        if (nloc == 0u) { xcd_barrier_complete(bar, b.x, nloc, nx); b.st[0] = nloc; b.st[1] = nx; }
        const unsigned old = xb_add(&bar[XB_XSUB(b.x)], 1u);
        const unsigned gen = old / nloc;
        if (old + 1u == (gen + 1u) * nloc) {
            __builtin_amdgcn_fence(__ATOMIC_RELEASE, "agent");
            asm volatile("s_waitcnt vmcnt(0)" ::: "memory");
            const unsigned og = xb_add(&bar[XB_TOP], 1u);
            const unsigned tg = og / nx;
            if (og + 1u == (tg + 1u) * nx) xb_add(&bar[XB_TOPGEN], 1u);
            else XB_SPIN(xb_ld(&bar[XB_TOPGEN]) == tg, bar);
            __builtin_amdgcn_fence(__ATOMIC_ACQUIRE, "agent");
            xb_add(&bar[XB_XGEN(b.x)], 1u);
            asm volatile("s_waitcnt vmcnt(0)" ::: "memory");
        } else {
            XB_SPIN(xb_ld(&bar[XB_XGEN(b.x)]) == gen, bar);
            __builtin_amdgcn_fence(__ATOMIC_ACQUIRE, "agent");
            asm volatile("s_waitcnt vmcnt(0)" ::: "memory");
        }
    }
    __syncthreads();
}

struct Frame {
    LAS unsigned char* lds;
    unsigned* ctl;
    int wave, G, bx, cntoff;
    const float *x, *w_in, *gn_gain, *pool_w, *pool_scale, *w_out, *ln1g, *ln1b, *rw, *rb, *wgu, *bgu, *wd, *bd, *ln2g, *ln2b;
    float* out;
    bf16 *WinT, *WoutT, *PoolT, *XB, *PROJB, *PB, *MIXEDB, *HB, *ACTB, *OUTS, *WguT, *WdT;
    float *ROPE, *KVT, *MIX, *H, *SGATE;
    int *STOK, *TOKE, *TOKR;
    unsigned char *HB8, *ACT8, *Wgu8, *Wd8;
};
__device__ __forceinline__ float wave_sum(float v) {
#pragma unroll
    for (int o = 1; o < 64; o <<= 1) v += __shfl_xor(v, o);
    return v;
}

__device__ __forceinline__ void p0_transpose_item(const float* W, int K, int N, bf16* WT, int item, int wave, int lane) {
    const int nblk = N / 256, kb = item / nblk, nb = item % nblk, k0 = 64 * kb, n0 = 256 * nb;
    const int n4 = (lane & 15) + 16 * (wave & 3), kq = (lane >> 4) + 4 * (wave >> 2);
    const float* src = W + (size_t)(k0 + kq * 8) * N + n0 + 4 * n4;
    f32x4 r[8];
#pragma unroll
    for (int q = 0; q < 8; ++q) r[q] = *(const GAS f32x4*)(src + (size_t)q * N);
    bf16* dst = WT + (size_t)(n0 + 4 * n4) * K + k0 + kq * 8;
#pragma unroll
    for (int c = 0; c < 4; ++c) { v4u o; o.x = pk2(r[0][c], r[1][c]); o.y = pk2(r[2][c], r[3][c]); o.z = pk2(r[4][c], r[5][c]); o.w = pk2(r[6][c], r[7][c]);
        *(GAS v4u*)(dst + (size_t)c * K) = o; }
}
__device__ __forceinline__ void p0_cvt8_load(const float* W, int N, int item, int wave, int lane, f32x4 (&r)[8]) {
    const int nblk = N / 128, kb = item / nblk, nb = item % nblk;
    const int n4 = (lane & 15) + 16 * (wave & 1), kq = (lane >> 4) + 4 * (wave >> 1);
    const float* src = W + (size_t)(128 * kb + kq * 8) * N + 128 * nb + 4 * n4;
#pragma unroll
    for (int q = 0; q < 8; ++q) r[q] = __builtin_nontemporal_load((const GAS f32x4*)(src + (size_t)q * N));
}
__device__ __forceinline__ void p0_cvt8_store(unsigned char* WT, int K, int N, int item, int wave, int lane, const f32x4 (&r)[8], float scale) {
    const int nblk = N / 128, kb = item / nblk, nb = item % nblk;
    const int n4 = (lane & 15) + 16 * (wave & 1), kq = (lane >> 4) + 4 * (wave >> 1);
    unsigned char* dst = WT + (size_t)(128 * nb + 4 * n4) * K + 128 * kb + kq * 8;
#pragma unroll
    for (int c = 0; c < 4; ++c) {
        int lo = __builtin_amdgcn_cvt_pk_fp8_f32(r[0][c] * scale, r[1][c] * scale, 0, false); lo = __builtin_amdgcn_cvt_pk_fp8_f32(r[2][c] * scale, r[3][c] * scale, lo, true);
        int hi = __builtin_amdgcn_cvt_pk_fp8_f32(r[4][c] * scale, r[5][c] * scale, 0, false); hi = __builtin_amdgcn_cvt_pk_fp8_f32(r[6][c] * scale, r[7][c] * scale, hi, true);
        *(GAS v2u*)(dst + (size_t)c * K) = (v2u){(unsigned)lo, (unsigned)hi}; }
}
__device__ __forceinline__ void p0_cvt8_experts(const float* W, unsigned char* WT, int N, int bx, int G, int wave, int lane) {
    const int per = (D_ / 128) * (N / 128), total = 32 * per;
    for (int it = bx; it < total; it += 2 * G) {
        const int it2 = it + G; const bool two = it2 < total;
        const int e0 = it / per, i0 = it % per, e1 = two ? it2 / per : e0, i1 = two ? it2 % per : i0;
        f32x4 r0[8], r1[8];
        p0_cvt8_load(W + (size_t)e0 * D_ * N, N, i0, wave, lane, r0);
        p0_cvt8_load(W + (size_t)e1 * D_ * N, N, i1, wave, lane, r1);
        p0_cvt8_store(WT + (size_t)e0 * D_ * N, D_, N, i0, wave, lane, r0, 64.0f);
        if (two) p0_cvt8_store(WT + (size_t)e1 * D_ * N, D_, N, i1, wave, lane, r1, 64.0f);
    }
}
__device__ __forceinline__ void p0_prologue(Frame& F) {
    const int lane = pg8::fresh_lane(), tid = F.wave * 64 + lane;
    constexpr int I_IN = (D_ / 64) * (INW / 256);
    for (int it = F.bx; it < I_IN; it += F.G) p0_transpose_item(F.w_in, D_, INW, F.WinT, it, F.wave, lane);
    const int gt = F.bx * NTHR + tid, NGT = F.G * NTHR;
    for (int i = gt; i < T_ * D_ / 8; i += NGT) {
        const f32x4 a = *(const GAS f32x4*)(F.x + (size_t)i * 8), b = *(const GAS f32x4*)(F.x + (size_t)i * 8 + 4);
        v4u o; o.x = pk2(a.x, a.y); o.y = pk2(a.z, a.w); o.z = pk2(b.x, b.y); o.w = pk2(b.z, b.w);
        *(GAS v4u*)(F.XB + (size_t)i * 8) = o;
    }
}
__device__ __forceinline__ void p0_late(Frame& F, int r, int nw) {
    const int lane = pg8::fresh_lane(), tid = F.wave * 64 + lane;
    constexpr int I_OUT = (D_ / 64) * (D_ / 256), I_POOL = 4 * (256 / 64);
    for (int it = r; it < I_OUT + I_POOL; it += nw) {
        if (it < I_OUT) { p0_transpose_item(F.w_out, D_, D_, F.WoutT, it, F.wave, lane); continue; }
        const int q = it - I_OUT, g = q >> 2; p0_transpose_item(F.pool_w + (size_t)g * 65536, 256, 256, F.PoolT + (size_t)g * 65536, q & 3, F.wave, lane);
    }
    for (int i = r * NTHR + tid; i < S_ * 64; i += nw * NTHR) {
        const int pos = i >> 6, fi = i & 63;
        const float inv = powf(10000.0f, -(float)fi / 64.0f);
        float sn, cs; sincosf((float)pos * inv, &sn, &cs);
        *(GAS f32x2*)(F.ROPE + (size_t)i * 2) = (f32x2){cs, sn};
    }
}

__device__ __forceinline__ void rt_mma128(f32x4 (&acc)[2][4], const LAS unsigned char* Mop, const LAS unsigned char* Nop, int m0, int n0, int fr, int fq) {
#pragma unroll
    for (int ks = 0; ks < 4; ++ks) {
        bf16x8 a[2], b[4];
#pragma unroll
        for (int mi = 0; mi < 2; ++mi) a[mi] = *(const LAS bf16x8*)(Mop + ((m0 + mi * 16 + fr) * RT_LD + ks * 32 + fq * 8) * 2);
#pragma unroll
        for (int ni = 0; ni < 4; ++ni) b[ni] = *(const LAS bf16x8*)(Nop + ((n0 + ni * 16 + fr) * RT_LD + ks * 32 + fq * 8) * 2);
#pragma unroll
        for (int mi = 0; mi < 2; ++mi)
#pragma unroll
            for (int ni = 0; ni < 4; ++ni) acc[mi][ni] = __builtin_amdgcn_mfma_f32_16x16x32_bf16(b[ni], a[mi], acc[mi][ni], 0, 0, 0);
    }
}
__device__ __forceinline__ void rt_stage_vt(Frame& F, int tid, LAS unsigned char* dst, int tok0, int h) {
    const int rp = tid & 63;
#pragma unroll
    for (int it = 0; it < 2; ++it) {
        const int cg = (tid >> 6) + 8 * it;
        const bf16* p = F.PROJB + (size_t)(tok0 + 2 * rp) * INW + 2 * RW + h * DH + cg * 8;
        const v4u a = *(const GAS v4u*)p, b = *(const GAS v4u*)(p + INW);
        const unsigned aw[4] = {a.x, a.y, a.z, a.w}, bw[4] = {b.x, b.y, b.z, b.w};
#pragma unroll
        for (int j = 0; j < 4; ++j) {
            *(LAS unsigned*)(dst + ((cg * 8 + 2 * j) * RT_LD + 2 * rp) * 2) = (aw[j] & 0xffffu) | (bw[j] << 16);
            *(LAS unsigned*)(dst + ((cg * 8 + 2 * j + 1) * RT_LD + 2 * rp) * 2) = (aw[j] >> 16) | (bw[j] & 0xffff0000u);
        }
    }
}
__device__ __forceinline__ void unpack8(const v4u v, float (&o)[8]) {
    o[0] = bflo(v.x); o[1] = bfhi(v.x); o[2] = bflo(v.y); o[3] = bfhi(v.y); o[4] = bflo(v.z); o[5] = bfhi(v.z); o[6] = bflo(v.w); o[7] = bfhi(v.w);
}
__device__ __forceinline__ void rot8(const float (&t1)[8], const float (&t2)[8], const float* rp, float sc, float (&o1)[8], float (&o2)[8]) {
#pragma unroll
    for (int q = 0; q < 4; ++q) { const f32x4 cs = *(const GAS f32x4*)(rp + 4 * q);
        o1[2 * q] = (t1[2 * q] * cs.x - t2[2 * q] * cs.y) * sc; o2[2 * q] = (t1[2 * q] * cs.y + t2[2 * q] * cs.x) * sc;
        o1[2 * q + 1] = (t1[2 * q + 1] * cs.z - t2[2 * q + 1] * cs.w) * sc; o2[2 * q + 1] = (t1[2 * q + 1] * cs.w + t2[2 * q + 1] * cs.z) * sc; }
}

__device__ __forceinline__ void r1_unit(Frame& F, int unit) {
    const int lane = pg8::fresh_lane(), tid = F.wave * 64 + lane;
    const int h = (unit >> 4) & 7, n = unit & 15, b = unit >> 7, tok0 = b * S_ + n * 128;
    const float log2g = log2f(1.0f - exp2f(-5.0f - (float)h));
    LAS unsigned char* ZKt = F.lds + REG1; LAS unsigned char* Vt = F.lds + REG2;
    {
        const int rp = tid & 63, ig = tid >> 6;
        float k1[2][8], k2[2][8];
#pragma unroll
        for (int rr = 0; rr < 2; ++rr) {
            const int r = 2 * rp + rr;
            const bf16* p = F.PROJB + (size_t)(tok0 + r) * INW + RW + h * DH + ig * 8;
            float t1[8], t2[8]; unpack8(*(const GAS v4u*)p, t1); unpack8(*(const GAS v4u*)(p + 64), t2);
            const float sc = 0.08838834764831845f * exp2f(log2g * (float)(127 - r));
            rot8(t1, t2, F.ROPE + (size_t)(n * 128 + r) * 128 + ig * 16, sc, k1[rr], k2[rr]);
        }
#pragma unroll
        for (int j = 0; j < 8; ++j) {
            *(LAS unsigned*)(ZKt + ((ig * 8 + j) * RT_LD + 2 * rp) * 2) = pk2(k1[0][j], k1[1][j]);
            *(LAS unsigned*)(ZKt + ((64 + ig * 8 + j) * RT_LD + 2 * rp) * 2) = pk2(k2[0][j], k2[1][j]);
        }
    }
    rt_stage_vt(F, tid, Vt, tok0, h);
    __syncthreads();
    const int fr = lane & 15, fq = lane >> 4, m0 = (F.wave >> 1) * 32, n0 = (F.wave & 1) * 64;
    f32x4 acc[2][4];
#pragma unroll
    for (int mi = 0; mi < 2; ++mi)
#pragma unroll
        for (int ni = 0; ni < 4; ++ni) acc[mi][ni] = (f32x4){0.f, 0.f, 0.f, 0.f};
    rt_mma128(acc, Vt, ZKt, m0, n0, fr, fq);
    bf16* dst = (bf16*)F.KVT + (size_t)unit * 16384;
    asm volatile("s_nop 15\n\ts_nop 15" : "+v"(acc[0][0]), "+v"(acc[0][1]), "+v"(acc[0][2]), "+v"(acc[0][3]), "+v"(acc[1][0]), "+v"(acc[1][1]), "+v"(acc[1][2]), "+v"(acc[1][3]));
#pragma unroll
    for (int mi = 0; mi < 2; ++mi)
#pragma unroll
        for (int ni = 0; ni < 4; ++ni) { v2u w; w.x = pk2(acc[mi][ni].x, acc[mi][ni].y); w.y = pk2(acc[mi][ni].z, acc[mi][ni].w);
            *(GAS v2u*)(dst + (m0 + mi * 16 + fr) * 128 + n0 + ni * 16 + fq * 4) = w; }
    __syncthreads();
}
template <int W> __device__ __forceinline__ void pool_item(Frame& F, int tok, int g, int cgl) {
    const int t = tok & (S_ - 1), c0 = g * 256 + cgl * 8;
    const bf16* up = F.PROJB + (size_t)tok * INW + 4 * RW + c0;
    v4u raw[W];
#pragma unroll
    for (int q = 0; q < W; ++q) { const int qq = q <= t ? q : 0; raw[q] = *(const GAS v4u*)(up - (size_t)qq * INW); }
    float s[8], u0[8];
    unpack8(raw[0], u0);
#pragma unroll
    for (int j = 0; j < 8; ++j) s[j] = u0[j];
#pragma unroll
    for (int q = 1; q < W; ++q) { float v[8]; unpack8(raw[q], v); const float wq = q <= t ? 1.0f : 0.0f;
#pragma unroll
        for (int j = 0; j < 8; ++j) s[j] = fmaf(wq, v[j], s[j]); }
    const float rn = 1.0f / (float)((t + 1 < W) ? t + 1 : W);
    v4u o; o.x = pk2(s[0] * rn - u0[0], s[1] * rn - u0[1]); o.y = pk2(s[2] * rn - u0[2], s[3] * rn - u0[3]);
    o.z = pk2(s[4] * rn - u0[4], s[5] * rn - u0[5]); o.w = pk2(s[6] * rn - u0[6], s[7] * rn - u0[7]);
    *(GAS v4u*)(F.PB + ((size_t)g * T_ + tok) * 256 + cgl * 8) = o;
}
__device__ __forceinline__ void pool_means(Frame& F) {
    const int gt = F.bx * NTHR + F.wave * 64 + pg8::fresh_lane(), NGT = F.G * NTHR;
    for (int it = gt; it < T_ * 128; it += NGT) {
        const int cgl = it & 31, tok = ((it >> 8) << 1) | ((it >> 5) & 1), g = __builtin_amdgcn_readfirstlane((it >> 6) & 3);
        if (g == 0) pool_item<2>(F, tok, 0, cgl); else if (g == 1) pool_item<4>(F, tok, 1, cgl); else if (g == 2) pool_item<8>(F, tok, 2, cgl); else pool_item<16>(F, tok, 3, cgl);
    }
}

__device__ __forceinline__ void r3_unit(Frame& F, int unit) {
    const int lane = pg8::fresh_lane(), tid = F.wave * 64 + lane;
    const int h = (unit >> 4) & 7, n = unit & 15, b = unit >> 7, tok0 = b * S_ + n * 128;
    const float log2g = log2f(1.0f - exp2f(-5.0f - (float)h));
    LAS unsigned char* Qs = F.lds + REG0; LAS unsigned char* Ks = F.lds + REG1; LAS unsigned char* Vt = F.lds + REG2; LAS unsigned char* Rt = F.lds + REG3;
    LAS float* EX = (LAS float*)(F.lds + EX_OFF);
#pragma unroll
    for (int it = 0; it < 2; ++it) {
        const int item = tid + 512 * it, r = item >> 3, ig = item & 7;
        const bf16* pq = F.PROJB + (size_t)(tok0 + r) * INW + h * DH + ig * 8;
        const float* rp = F.ROPE + (size_t)(n * 128 + r) * 128 + ig * 16;
        float t1[8], t2[8], o1[8], o2[8];
        unpack8(*(const GAS v4u*)pq, t1); unpack8(*(const GAS v4u*)(pq + 64), t2);
        rot8(t1, t2, rp, 1.0f, o1, o2);
        v4u w1, w2; w1.x = pk2(o1[0], o1[1]); w1.y = pk2(o1[2], o1[3]); w1.z = pk2(o1[4], o1[5]); w1.w = pk2(o1[6], o1[7]);
        w2.x = pk2(o2[0], o2[1]); w2.y = pk2(o2[2], o2[3]); w2.z = pk2(o2[4], o2[5]); w2.w = pk2(o2[6], o2[7]);
        *(LAS v4u*)(Qs + (r * RT_LD + ig * 8) * 2) = w1; *(LAS v4u*)(Qs + (r * RT_LD + 64 + ig * 8) * 2) = w2;
        unpack8(*(const GAS v4u*)(pq + RW), t1); unpack8(*(const GAS v4u*)(pq + RW + 64), t2);
        rot8(t1, t2, rp, 0.08838834764831845f, o1, o2);
        w1.x = pk2(o1[0], o1[1]); w1.y = pk2(o1[2], o1[3]); w1.z = pk2(o1[4], o1[5]); w1.w = pk2(o1[6], o1[7]);
        w2.x = pk2(o2[0], o2[1]); w2.y = pk2(o2[2], o2[3]); w2.z = pk2(o2[4], o2[5]); w2.w = pk2(o2[6], o2[7]);
        *(LAS v4u*)(Ks + (r * RT_LD + ig * 8) * 2) = w1; *(LAS v4u*)(Ks + (r * RT_LD + 64 + ig * 8) * 2) = w2;
    }
    rt_stage_vt(F, tid, Vt, tok0, h);
    {
        const float gch = exp2f(log2g * 128.0f);
        f32x4 R[8];
#pragma unroll
        for (int i = 0; i < 8; ++i) R[i] = (f32x4){0.f, 0.f, 0.f, 0.f};
        const bf16* src = (const bf16*)F.KVT + (size_t)(unit - n) * 16384 + tid * 4;
        int m = 0;
        for (; m + 1 < n; m += 2) {
            v2u w0[8], w1[8];
#pragma unroll
            for (int i = 0; i < 8; ++i) { w0[i] = *(const GAS v2u*)(src + (size_t)m * 16384 + i * 2048); w1[i] = *(const GAS v2u*)(src + (size_t)(m + 1) * 16384 + i * 2048); }
#pragma unroll
            for (int i = 0; i < 8; ++i) { const f32x4 v0 = (f32x4){bflo(w0[i].x), bfhi(w0[i].x), bflo(w0[i].y), bfhi(w0[i].y)}, v1 = (f32x4){bflo(w1[i].x), bfhi(w1[i].x), bflo(w1[i].y), bfhi(w1[i].y)};
                R[i] = (R[i] * gch + v0) * gch + v1; }
        }
        if (m < n) {
#pragma unroll
            for (int i = 0; i < 8; ++i) { const v2u w = *(const GAS v2u*)(src + (size_t)m * 16384 + i * 2048);
                const f32x4 v = (f32x4){bflo(w.x), bfhi(w.x), bflo(w.y), bfhi(w.y)}; R[i] = R[i] * gch + v; }
        }
#pragma unroll
        for (int i = 0; i < 8; ++i) { const int f = i * 512 + tid, e = f >> 5, d4 = (f & 31) * 4;
            v2u w; w.x = pk2(R[i].x, R[i].y); w.y = pk2(R[i].z, R[i].w);
            *(LAS v2u*)(Rt + (e * RT_LD + d4) * 2) = w; }
    }
    __syncthreads();
    const int fr = lane & 15, fq = lane >> 4, m0 = (F.wave >> 1) * 32, n0 = (F.wave & 1) * 64;
    f32x4 acc[2][4];
#pragma unroll
    for (int mi = 0; mi < 2; ++mi)
#pragma unroll
        for (int ni = 0; ni < 4; ++ni) acc[mi][ni] = (f32x4){0.f, 0.f, 0.f, 0.f};
    rt_mma128(acc, Qs, Ks, m0, n0, fr, fq);
    __syncthreads();
#pragma unroll
    for (int mi = 0; mi < 2; ++mi)
#pragma unroll
        for (int ni = 0; ni < 4; ++ni) {
            const int c = m0 + mi * 16 + fr, mm = n0 + ni * 16 + fq * 4;
            float v[4];
#pragma unroll
            for (int j = 0; j < 4; ++j) v[j] = (mm + j <= c) ? acc[mi][ni][j] * exp2f(-log2g * (float)(mm + j + 1)) : 0.f;
            v2u w; w.x = pk2(v[0], v[1]); w.y = pk2(v[2], v[3]);
            *(LAS v2u*)(Ks + (c * RT_LD + mm) * 2) = w;
            acc[mi][ni] = (f32x4){0.f, 0.f, 0.f, 0.f};
        }
    __syncthreads();
    rt_mma128(acc, Ks, Vt, m0, n0, fr, fq);
    rt_mma128(acc, Qs, Rt, m0, n0, fr, fq);
    float mean[2], rstd[2];
#pragma unroll
    for (int mi = 0; mi < 2; ++mi) {
        const int c = m0 + mi * 16 + fr; const float xi = exp2f(log2g * (float)(c + 1)); float s = 0.f;
#pragma unroll
        for (int ni = 0; ni < 4; ++ni) { acc[mi][ni] = acc[mi][ni] * xi; s += (acc[mi][ni].x + acc[mi][ni].y) + (acc[mi][ni].z + acc[mi][ni].w); }
        s += __shfl_xor(s, 16); s += __shfl_xor(s, 32);
        if (fq == 0) EX[c * 2 + (F.wave & 1)] = s;
    }
    __syncthreads();
#pragma unroll
    for (int mi = 0; mi < 2; ++mi) {
        const int c = m0 + mi * 16 + fr; mean[mi] = (EX[c * 2] + EX[c * 2 + 1]) * (1.0f / 128.0f); float q = 0.f;
#pragma unroll
        for (int ni = 0; ni < 4; ++ni) { const f32x4 d = acc[mi][ni] - mean[mi]; q += (d.x * d.x + d.y * d.y) + (d.z * d.z + d.w * d.w); }
        q += __shfl_xor(q, 16); q += __shfl_xor(q, 32);
        if (fq == 0) EX[256 + c * 2 + (F.wave & 1)] = q;
    }
    __syncthreads();
#pragma unroll
    for (int mi = 0; mi < 2; ++mi) {
        const int c = m0 + mi * 16 + fr; rstd[mi] = 1.0f / sqrtf((EX[256 + c * 2] + EX[256 + c * 2 + 1]) * (1.0f / 128.0f) + 1e-6f);
#pragma unroll
        for (int ni = 0; ni < 4; ++ni) {
            const int e = n0 + ni * 16 + fq * 4;
            const v2u gw = *(const GAS v2u*)(F.PROJB + (size_t)(tok0 + c) * INW + 3 * RW + h * DH + e);
            const f32x4 gain = *(const GAS f32x4*)(F.gn_gain + h * DH + e);
            const float g[4] = {bflo(gw.x), bfhi(gw.x), bflo(gw.y), bfhi(gw.y)};
            float o[4];
#pragma unroll
            for (int j = 0; j < 4; ++j) { const float sg = g[j] / (1.0f + __expf(-g[j])); o[j] = sg * ((acc[mi][ni][j] - mean[mi]) * rstd[mi] * gain[j]); }
            v2u w; w.x = pk2(o[0], o[1]); w.y = pk2(o[2], o[3]);
            *(GAS v2u*)(F.MIXEDB + (size_t)(tok0 + c) * D_ + h * DH + e) = w;
        }
    }
    __syncthreads();
}
struct PoolOrder {
    int G, c; const bf16* Bt;
    __device__ __forceinline__ bool next(int i, pg8::Unit& u) const { const int L = i * G + c; if (L >= 128) return false; u.pm = L >> 2; u.e = L & 3; u.pn = 0; u.lm = u.pm; u.aux = 0; u.hn = 0; return true; }
    __device__ __forceinline__ int arow0(const pg8::Unit& u, int r) const { return u.e * T_ + u.pm * 256 + r; }
    __device__ __forceinline__ int arow1(const pg8::Unit& u, int r, int, LAS unsigned char*) const { return u.e * T_ + u.pm * 256 + r; }
    __device__ __forceinline__ void prefetch(const pg8::Unit&, int, LAS unsigned char*, int, int) const {}
    __device__ __forceinline__ void round_sync(int, int, int) const {}
    __device__ __forceinline__ const char* bbase(const pg8::Unit& u) const { return (const char*)Bt + (size_t)u.e * 65536 * 2; }
};
struct EpiPool {
    static constexpr bool PERM = true;
    bf16* O; const float* cscale;
    __device__ __forceinline__ void operator()(const f32x4 (&acc)[2][2][4][2], const pg8::Unit& u, int wr, int wc, int fr, int fq) const {
        const int row0 = u.pm * 256 + wr * 64 + fr; const int col0 = u.e * 256 + wc * 32 + 8 * fq;
        f32x4 sv[2][2];
#pragma unroll
        for (int bj = 0; bj < 2; ++bj)
#pragma unroll
            for (int n = 0; n < 2; ++n) sv[bj][n] = *(const f32x4*)(cscale + col0 + bj * 128 + 4 * n);
#pragma unroll
        for (int ai = 0; ai < 2; ++ai)
#pragma unroll
            for (int m = 0; m < 4; ++m) { bf16* rowp = O + (size_t)(row0 + ai * 128 + m * 16) * D_ + RW + col0;
#pragma unroll
                for (int bj = 0; bj < 2; ++bj) { const f32x4 v0 = acc[ai][bj][m][0] * sv[bj][0], v1 = acc[ai][bj][m][1] * sv[bj][1];
                    v4u w; w.x = pg8::cvt_pk_bf16(v0[0], v0[1]); w.y = pg8::cvt_pk_bf16(v0[2], v0[3]); w.z = pg8::cvt_pk_bf16(v1[0], v1[1]); w.w = pg8::cvt_pk_bf16(v1[2], v1[3]);
                    *(v4u*)(rowp + bj * 128) = w; } }
    }
};

__device__ __forceinline__ void ln1_router(Frame& F) {
    const int lane_outer = pg8::fresh_lane();
    LAS float* HT = (LAS float*)F.lds;
    LAS float* PART = (LAS float*)(F.lds + 65536);
    LAS int* PK_E = (LAS int*)(F.lds + 65536 + 8192);
    LAS float* PK_G = (LAS float*)(F.lds + 65536 + 8192 + 512);
    LAS unsigned* HIST = (LAS unsigned*)(F.lds + 65536 + 8192 + 1024);
    if (F.wave == 0) HIST[lane_outer] = 0u;
    const int lane0 = lane_outer;
    int it = 0, ntok = 0;
    f32x2 rwr[3][16];
    { const int e0 = lane0 & 31, hf0 = lane0 >> 5; const float* rwp0 = F.rw + (size_t)(F.wave * 256 + hf0 * 128) * 32 + e0;
#pragma unroll
      for (int c = 0; c < 3; ++c)
#pragma unroll
          for (int i = 0; i < 16; ++i) { rwr[c][i].x = rwp0[(c * 32 + 2 * i) * 32]; rwr[c][i].y = rwp0[(c * 32 + 2 * i + 1) * 32]; } }
    f32x4 xa[8]; v2u mb[8];
    {
        const int tok0 = F.bx * 8 + F.wave;
#pragma unroll
        for (int j = 0; j < 8; ++j) { xa[j] = *(const GAS f32x4*)(F.x + (size_t)tok0 * D_ + j * 256 + lane0 * 4); mb[j] = *(const GAS v2u*)((const bf16*)F.MIX + (size_t)tok0 * D_ + j * 256 + lane0 * 4); }
    }
    for (int task = F.bx; task < T_ / 8; task += F.G, ++it, ntok += 8) {
        int lane = lane0; asm volatile("" : "+v"(lane));
        const int tok = task * 8 + F.wave;
        {
            float v[32]; float s = 0.f;
#pragma unroll
            for (int j = 0; j < 8; ++j) { const f32x4 a = xa[j]; const v2u bw = mb[j];
                const f32x4 b = (f32x4){bflo(bw.x), bfhi(bw.x), bflo(bw.y), bfhi(bw.y)};
                v[4 * j] = ALPHA * a.x + b.x; v[4 * j + 1] = ALPHA * a.y + b.y; v[4 * j + 2] = ALPHA * a.z + b.z; v[4 * j + 3] = ALPHA * a.w + b.w;
                s += (v[4 * j] + v[4 * j + 1]) + (v[4 * j + 2] + v[4 * j + 3]); }
            if (task + F.G < T_ / 8) {
                const int tokn = (task + F.G) * 8 + F.wave;
#pragma unroll
                for (int j = 0; j < 8; ++j) { xa[j] = *(const GAS f32x4*)(F.x + (size_t)tokn * D_ + j * 256 + lane * 4); mb[j] = *(const GAS v2u*)((const bf16*)F.MIX + (size_t)tokn * D_ + j * 256 + lane * 4); }
            }
            const float mu = wave_sum(s) * (1.0f / D_); float q = 0.f;
#pragma unroll
            for (int j = 0; j < 32; ++j) { v[j] -= mu; q += v[j] * v[j]; }
            const float rstd = 1.0f / sqrtf(wave_sum(q) * (1.0f / D_) + 1e-5f);
#pragma unroll
            for (int j = 0; j < 8; ++j) { const int c = j * 256 + lane * 4;
                const f32x4 g = *(const GAS f32x4*)(F.ln1g + c), be = *(const GAS f32x4*)(F.ln1b + c);
                const f32x4 hv = (f32x4){v[4 * j] * rstd * g.x + be.x, v[4 * j + 1] * rstd * g.y + be.y, v[4 * j + 2] * rstd * g.z + be.z, v[4 * j + 3] * rstd * g.w + be.w};
                v2u w; w.x = pk2(hv.x, hv.y); w.y = pk2(hv.z, hv.w);
                *(GAS v2u*)(F.HB + (size_t)tok * D_ + c) = w;
                { int w8 = __builtin_amdgcn_cvt_pk_fp8_f32(hv.x, hv.y, 0, false); w8 = __builtin_amdgcn_cvt_pk_fp8_f32(hv.z, hv.w, w8, true); *(GAS int*)(F.HB8 + (size_t)tok * D_ + c) = w8; }
                *(LAS f32x4*)(HT + F.wave * 2048 + c) = hv; }
        }
        __syncthreads();
        const int e = lane & 31, hf = lane >> 5, k0 = F.wave * 256 + hf * 128;
        f32x2 acc2[8];
#pragma unroll
        for (int t = 0; t < 8; ++t) acc2[t] = (f32x2){0.f, 0.f};
        const float* rwp = F.rw + (size_t)k0 * 32 + e;
        f32x2 rc[16];
#define RT_LOAD(dst, c) _Pragma("unroll") for (int i = 0; i < 16; ++i) { dst[i].x = rwp[((c) * 32 + 2 * i) * 32]; dst[i].y = rwp[((c) * 32 + 2 * i + 1) * 32]; }
#define RT_COMP(src, c) _Pragma("unroll") for (int i4 = 0; i4 < 8; ++i4) { _Pragma("unroll") for (int t = 0; t < 8; ++t) { const f32x4 hv = *(const LAS f32x4*)(HT + t * 2048 + k0 + (c) * 32 + i4 * 4); \
            acc2[t] = __builtin_elementwise_fma((f32x2){hv.x, hv.y}, src[i4 * 2], acc2[t]); acc2[t] = __builtin_elementwise_fma((f32x2){hv.z, hv.w}, src[i4 * 2 + 1], acc2[t]); } \
            asm volatile("" : "+v"(acc2[0]), "+v"(acc2[1]), "+v"(acc2[2]), "+v"(acc2[3]), "+v"(acc2[4]), "+v"(acc2[5]), "+v"(acc2[6]), "+v"(acc2[7]) :: "memory"); }
        RT_LOAD(rc, 3) RT_COMP(rwr[0], 0) RT_COMP(rwr[1], 1) RT_COMP(rwr[2], 2) RT_COMP(rc, 3)
#undef RT_LOAD
#undef RT_COMP
        float acc[8];
#pragma unroll
        for (int t = 0; t < 8; ++t) { acc[t] = acc2[t].x + acc2[t].y; acc[t] += __shfl_xor(acc[t], 32); if (hf == 0) PART[(F.wave * 8 + t) * 32 + e] = acc[t]; }
        __syncthreads();
        float mine = F.rb[e];
#pragma unroll
        for (int sl = 0; sl < 8; ++sl) mine += PART[(sl * 8 + F.wave) * 32 + e];
        float tv[4]; int ti[4]; float cur = mine;
#pragma unroll
        for (int k = 0; k < 4; ++k) {
            float bv = cur; int bi = e;
#pragma unroll
            for (int o = 1; o < 32; o <<= 1) { const float ov = __shfl_xor(bv, o); const int oi = __shfl_xor(bi, o); if (ov > bv || (ov == bv && oi < bi)) { bv = ov; bi = oi; } }
            tv[k] = bv; ti[k] = bi;
            if (e == bi) cur = -INFINITY;
        }
        float ex[4], se = 0.f;
#pragma unroll
        for (int k = 0; k < 4; ++k) { ex[k] = __expf(tv[k] - tv[0]); se += ex[k]; }
        if (lane == 0) {
#pragma unroll
            for (int k = 0; k < 4; ++k) { PK_E[(it * 8 + F.wave) * 4 + k] = ti[k]; PK_G[(it * 8 + F.wave) * 4 + k] = ex[k] / se; }
        }
        __syncthreads();
    }
    const int tid = F.wave * 64 + lane_outer;
    int e_ = 0, lr = 0;
    if (tid < 128 && tid < 4 * ntok) { e_ = PK_E[tid]; lr = (int)__hip_atomic_fetch_add((LAS unsigned*)&HIST[e_], 1u, __ATOMIC_RELAXED, __HIP_MEMORY_SCOPE_WORKGROUP); }
    __syncthreads();
    if (tid < 32) { const unsigned c = HIST[tid]; HIST[32 + tid] = c ? __hip_atomic_fetch_add(F.ctl + F.cntoff + 64 * tid, c, RLX_AGENT) : 0u; }
    __syncthreads();
    if (tid < 128 && tid < 4 * ntok) {
        const int slot = tid >> 2, k = tid & 3, it = slot >> 3, w = slot & 7, tok = (F.bx + it * F.G) * 8 + w;
        const int r = (int)HIST[32 + e_] + lr;
        F.STOK[e_ * T_ + r] = tok; F.SGATE[e_ * T_ + r] = PK_G[tid]; F.TOKE[tok * 4 + k] = e_; F.TOKR[tok * 4 + k] = r;
    }
    __syncthreads();
}

__device__ __forceinline__ void build_ts(Frame& F) {
    LAS int* ts = (LAS int*)(F.lds + TS_OFF);
    const int tid = F.wave * 64 + pg8::fresh_lane();
    if (tid < 64) {
        const int e = tid & 31;
        const int c = (int)__hip_atomic_load(F.ctl + F.cntoff + 64 * e, RLX_AGENT);
        int incl = (c + 255) >> 8;
#pragma unroll
        for (int o = 1; o < 32; o <<= 1) { const int v = __shfl_up(incl, o, 32); if ((tid & 31) >= o) incl += v; }
        const int te = (c + 255) >> 8; int inf = te > 0 ? 1 : 0, inr = te > 0 ? te - 1 : 0;
#pragma unroll
        for (int o = 1; o < 32; o <<= 1) { const int v1 = __shfl_up(inf, o, 32), v2 = __shfl_up(inr, o, 32); if ((tid & 31) >= o) { inf += v1; inr += v2; } }
        if (tid < 32) { ts[e + 1] = incl; ts[40 + e] = c; ts[80 + e + 1] = inf; ts[120 + e + 1] = inr; if (e == 0) { ts[0] = 0; ts[80] = 0; ts[120] = 0; } }
    }
    __syncthreads();
}
template <int NN, bool GATHER> struct MoeOrder {
    const LAS int* ts; LAS unsigned char* tokbuf; const int* stok; const bf16* Bt; int G, c, nrowsB; const float* Wf;
    int tpo, lm0;
    unsigned* xs;
    int mode;
    int brow;
    __device__ __forceinline__ bool next(int i, pg8::Unit& u) const {
        const LAS int* tp = ts + tpo;
        const int TM = tp[32], nwg = TM * NN, full = (nwg / G) * G, rem = nwg - full; const bool use_half = rem > 0 && 2 * rem <= G;
        long L = (long)i * G + c; int hn = 0;
        if (mode == 2) { if (!use_half || L >= 2 * rem) return false; hn = (int)(L & 1); L = full + (L >> 1); }
        else if (L >= ((mode == 1 && use_half) ? full : nwg)) return false;
        int w = pg8::xcd_remap((int)L, nwg);
#if defined(PROBE_SCRAMBLE)
        if (mode == 0) w = (int)(((long)w * 37) % nwg);
#endif
        int e = 0;
        for (int k = 0; k < 31; ++k) { if (w >= tp[k + 1] * NN) e = k + 1; }
#if defined(ORDER_PN_FAST)
        const int te = tp[e + 1] - tp[e], r = w - tp[e] * NN, lm = lm0 + r / NN;
        u.e = __builtin_amdgcn_readfirstlane(e); u.pn = __builtin_amdgcn_readfirstlane(r % NN); u.lm = __builtin_amdgcn_readfirstlane(lm);
#else
        const int te = tp[e + 1] - tp[e], r = w - tp[e] * NN, lm = lm0 + r % te;
        u.e = __builtin_amdgcn_readfirstlane(e); u.pn = __builtin_amdgcn_readfirstlane(r / te); u.lm = __builtin_amdgcn_readfirstlane(lm);
#endif
        u.pm = __builtin_amdgcn_readfirstlane(ts[e] + lm); u.aux = __builtin_amdgcn_readfirstlane(ts[40 + e]); u.hn = __builtin_amdgcn_readfirstlane(hn); return true;
    }
    __device__ __forceinline__ void round_sync(int ui, int wid, int lane) const {
        if (!xs) return;
        const LAS int* tp = ts + tpo; const int nwg = tp[32] * NN, full = nwg / G, rem = nwg - full * G; const bool use_half = rem > 0 && 2 * rem <= G;
        const int nfull = (mode == 1 && !use_half && rem > 0) ? full : ((mode == 0 && rem > 0) ? full : full);
        if (ui >= nfull || (G & 7)) return;
        if (wid == 0 && lane == 0) {
            unsigned* w = xs + 64 * (c & 7); const unsigned want = (unsigned)(G >> 3) * (unsigned)ui;
            __hip_atomic_fetch_add(w, 1u, RLX_AGENT);
            unsigned sp = 0; while (__hip_atomic_load(w, RLX_AGENT) < want) { __builtin_amdgcn_s_sleep(1); if (++sp > (1u << 16)) break; }
        }
        __builtin_amdgcn_s_barrier();
    }
    __device__ __forceinline__ const char* wbbase(const pg8::Unit& u) const { return (const char*)Bt + ((size_t)u.e * nrowsB + (size_t)u.pn * 256) * 2048 * 2; }
    __device__ __forceinline__ int arow0(const pg8::Unit& u, int r) const {
        if (!GATHER) return u.pm * 256 + r;
        int rr = u.lm * 256 + r; rr = rr < u.aux ? rr : u.aux - 1; return stok[u.e * T_ + rr];
    }
    __device__ __forceinline__ void prefetch(const pg8::Unit& nx, int par, LAS unsigned char*, int wid, int lane) const {
        if (!GATHER) return;
        const int idx = (wid & 3) * 64 + pg8::fresh_lane();
        int rr = nx.lm * 256 + idx; rr = rr < nx.aux ? rr : nx.aux - 1;
        __builtin_amdgcn_global_load_lds((const unsigned*)(stok + nx.e * T_ + rr), (LAS unsigned*)(tokbuf + par * 1024 + (wid & 3) * 256), 4, 0, 0);
    }
    __device__ __forceinline__ int arow1(const pg8::Unit& u, int r, int par, LAS unsigned char*) const {
        if (!GATHER) return u.pm * 256 + r;
        return *(const LAS int*)(tokbuf + par * 1024 + r * 4);
    }
    __device__ __forceinline__ const char* bbase(const pg8::Unit& u) const {
        if (Wf) return (const char*)Wf + ((size_t)u.e * 2048 * nrowsB + (size_t)u.pn * 256 + (size_t)u.hn * 128) * 4;
        return (const char*)Bt + ((size_t)u.e * nrowsB + (size_t)u.pn * 256 + (size_t)u.hn * 128) * (size_t)brow; }
};

__device__ __forceinline__ void combine_ln2(Frame& F) {
    const LAS int* ts = (const LAS int*)(F.lds + TS_OFF);
    const int gw = F.bx * NWAVES + F.wave, NGW = F.G * NWAVES, lane = pg8::fresh_lane();
    for (int tok = gw; tok < T_; tok += NGW) {
        const bf16* p[4];
#pragma unroll
        for (int k = 0; k < 4; ++k) { const int e = F.TOKE[tok * 4 + k], r = F.TOKR[tok * 4 + k]; p[k] = F.OUTS + (size_t)(ts[e] * 256 + r) * D_; }
        float v[32]; float s = 0.f;
#pragma unroll
        for (int j = 0; j < 8; ++j) { const int c = j * 256 + lane * 4;
            const v2u hw = *(const GAS v2u*)(F.HB + (size_t)tok * D_ + c);
            const f32x4 hh = (f32x4){bflo(hw.x), bfhi(hw.x), bflo(hw.y), bfhi(hw.y)};
            float y[4] = {0.f, 0.f, 0.f, 0.f};
#pragma unroll
            for (int k = 0; k < 4; ++k) { const v2u w = *(const GAS v2u*)(p[k] + c); y[0] += bflo(w.x); y[1] += bfhi(w.x); y[2] += bflo(w.y); y[3] += bfhi(w.y); }
            v[4 * j] = ALPHA * hh.x + y[0]; v[4 * j + 1] = ALPHA * hh.y + y[1]; v[4 * j + 2] = ALPHA * hh.z + y[2]; v[4 * j + 3] = ALPHA * hh.w + y[3];
            s += (v[4 * j] + v[4 * j + 1]) + (v[4 * j + 2] + v[4 * j + 3]); }
        const float mu = wave_sum(s) * (1.0f / D_); float q = 0.f;
#pragma unroll
        for (int j = 0; j < 32; ++j) { v[j] -= mu; q += v[j] * v[j]; }
        const float rstd = 1.0f / sqrtf(wave_sum(q) * (1.0f / D_) + 1e-5f);
#pragma unroll
        for (int j = 0; j < 8; ++j) { const int c = j * 256 + lane * 4;
            const f32x4 g = *(const GAS f32x4*)(F.ln2g + c), be = *(const GAS f32x4*)(F.ln2b + c);
            *(GAS f32x4*)(F.out + (size_t)tok * D_ + c) = (f32x4){v[4 * j] * rstd * g.x + be.x, v[4 * j + 1] * rstd * g.y + be.y, v[4 * j + 2] * rstd * g.z + be.z, v[4 * j + 3] * rstd * g.w + be.w}; }
    }
}

constexpr int N_PHASES = 9;
struct Args { const float* in[16]; float* out; unsigned char* ws; int ph_lo, ph_hi, bar_region, pad; };
__global__ void __launch_bounds__(NTHR, 2) mega_fwd(Args args) {
    extern __shared__ __attribute__((aligned(16))) unsigned char lds_raw[];
    Frame F;
    F.lds = (LAS unsigned char*)lds_raw;
    F.wave = __builtin_amdgcn_readfirstlane(threadIdx.x >> 6); F.G = gridDim.x; F.bx = blockIdx.x;
    unsigned char* ws = args.ws;
    F.ctl = (unsigned*)(ws + WS_CTL);
    F.x = args.in[0]; F.w_in = args.in[1]; F.gn_gain = args.in[2]; F.pool_w = args.in[3]; F.pool_scale = args.in[4]; F.w_out = args.in[5];
    F.ln1g = args.in[6]; F.ln1b = args.in[7]; F.rw = args.in[8]; F.rb = args.in[9]; F.wgu = args.in[10]; F.bgu = args.in[11];
    F.wd = args.in[12]; F.bd = args.in[13]; F.ln2g = args.in[14]; F.ln2b = args.in[15]; F.out = args.out;
    F.WinT = (bf16*)(ws + WS_WIN_T); F.WoutT = (bf16*)(ws + WS_WOUT_T); F.PoolT = (bf16*)(ws + WS_POOLW_T); F.XB = (bf16*)(ws + WS_XB);
    F.PROJB = (bf16*)(ws + WS_PROJB); F.PB = (bf16*)(ws + WS_PB); F.MIXEDB = (bf16*)(ws + WS_MIXEDB); F.HB = (bf16*)(ws + WS_HB);
    F.ACTB = (bf16*)(ws + WS_ACTB); F.OUTS = (bf16*)(ws + WS_OUTS); F.WguT = (bf16*)(ws + WS_WGU_T); F.WdT = (bf16*)(ws + WS_WD_T);
    F.ROPE = (float*)(ws + WS_ROPE); F.KVT = (float*)(ws + WS_KVT); F.MIX = (float*)(ws + WS_MIX); F.H = (float*)(ws + WS_H); F.SGATE = (float*)(ws + WS_SGATE);
    F.HB8 = ws + WS_HB8; F.ACT8 = ws + WS_ACT8; F.Wgu8 = ws + WS_WGU8; F.Wd8 = ws + WS_WD8;
    F.STOK = (int*)(ws + WS_STOK); F.TOKE = (int*)(ws + WS_TOKE); F.TOKR = (int*)(ws + WS_TOKR);
    for (int u = F.wave * 64 + pg8::fresh_lane(); u < (LDS_BYTES - LDSCTL_OFF) / 4; u += NTHR) ((LAS unsigned*)(F.lds + LDSCTL_OFF))[u] = 0u;
    __syncthreads();
    const int lo = args.ph_lo, hi = args.ph_hi;
    XcdBarrier bar; bar.bar = F.ctl + CW_BAR + args.bar_region * XCD_BAR_WORDS; bar.x = 0; bar.st = nullptr; bar.wave = F.wave;
    if (hi - lo > 1) bar = xcd_barrier_post(F.ctl + CW_BAR + args.bar_region * XCD_BAR_WORDS, (volatile LAS unsigned*)(F.lds + MISC_OFF) + 8);
#define IN(k) (lo <= (k) && (k) < hi)
#define SEAM(k) do { if (IN(k) && IN((k) + 1)) xcd_barrier(bar); } while (0)
    LAS unsigned char* ring = F.lds;
#if defined(XCD_ROUND_SYNC)
    unsigned* const XS6 = F.ctl + CW_XSYNC; unsigned* const XS7 = F.ctl + CW_XSYNC + 8 * 64;
#else
    unsigned* const XS6 = nullptr; unsigned* const XS7 = nullptr;
#endif
#define REMAP_BX() do { if (hi - lo > 1) { volatile LAS unsigned* ms = (volatile LAS unsigned*)(F.lds + MISC_OFF) + 8; \
        if (threadIdx.x == 0) { bool ok = (F.G % 8) == 0; for (unsigned j = 0; j < 8; ++j) ok = ok && (xb_ld(&bar.bar[XB_XCNT(j)]) == (unsigned)F.G / 8u); ms[3] = ok ? ms[2] * 8u + bar.x : (unsigned)blockIdx.x; } \
        __syncthreads(); F.bx = __builtin_amdgcn_readfirstlane((int)ms[3]); } } while (0)

#ifndef PROBE_REP
#define PROBE_REP -1
#endif
#define REP(k) if ((k) == PROBE_REP)
    if (IN(0)) { p0_prologue(F);
#if defined(MOE_F8DMA)
        { const int lane0 = pg8::fresh_lane(); p0_cvt8_experts(F.wgu, F.Wgu8, 2 * FF, F.bx, F.G, F.wave, lane0); p0_cvt8_experts(F.wd, F.Wd8, D_, F.bx, F.G, F.wave, lane0); }
#endif
    }
    if (IN(0)) REP(0) { p0_prologue(F); } SEAM(0);
    if (IN(0) && IN(1)) REMAP_BX();
    if (IN(1)) {
#if defined(P1_F32B)
        pg8::DenseOrder S; S.init(T_, INW, F.G, F.bx, F.WinT, D_, F.w_in); pg8::EpiBf16 E{F.PROJB, INW, 0, nullptr};
        pg8::gemm_phase_f32b<pg8::EpiBf16, pg8::DenseOrder, false>(ring, F.wave, F.XB, D_, D_, INW, S, E);
#else
        pg8::DenseOrder S; S.init(T_, INW, F.G, F.bx, F.WinT, D_, nullptr, 1); pg8::EpiBf16 E{F.PROJB, INW, 0, nullptr};
        pg8::gemm_phase<pg8::EpiBf16, pg8::DenseOrder>(ring, F.wave, F.XB, D_, 0, D_, S, E);
        pg8::DenseOrder S2; S2.init(T_, INW, F.G, F.bx, F.WinT, D_, nullptr, 2);
        pg8::gemm_phase_half<pg8::EpiBf16, pg8::DenseOrder>(ring, F.wave, F.XB, D_, 0, D_, S2, E);
#endif
        { const int nunits = (T_ / 256) * (INW / 256), rem = nunits % F.G;
          if (rem == 0 || 2 * rem <= F.G) { const int busy = 2 * rem; if (busy >= F.G) p0_late(F, F.bx, F.G); else if (F.bx >= busy) p0_late(F, F.bx - busy, F.G - busy); }
          else if (F.bx >= rem) p0_late(F, F.bx - rem, F.G - rem); }
    }
    if (IN(1)) REP(1) {
#if defined(P1_F32B)
        pg8::DenseOrder S; S.init(T_, INW, F.G, F.bx, F.WinT, D_, F.w_in); pg8::EpiBf16 E{F.PROJB, INW, 0, nullptr};
        pg8::gemm_phase_f32b<pg8::EpiBf16, pg8::DenseOrder, false>(ring, F.wave, F.XB, D_, D_, INW, S, E);
#else
        pg8::DenseOrder S; S.init(T_, INW, F.G, F.bx, F.WinT, D_, nullptr, 1); pg8::EpiBf16 E{F.PROJB, INW, 0, nullptr};
        pg8::gemm_phase<pg8::EpiBf16, pg8::DenseOrder>(ring, F.wave, F.XB, D_, 0, D_, S, E);
        pg8::DenseOrder S2; S2.init(T_, INW, F.G, F.bx, F.WinT, D_, nullptr, 2);
        pg8::gemm_phase_half<pg8::EpiBf16, pg8::DenseOrder>(ring, F.wave, F.XB, D_, 0, D_, S2, E);
#endif
        { const int nunits = (T_ / 256) * (INW / 256), rem = nunits % F.G;
          if (rem == 0 || 2 * rem <= F.G) { const int busy = 2 * rem; if (busy >= F.G) p0_late(F, F.bx, F.G); else if (F.bx >= busy) p0_late(F, F.bx - busy, F.G - busy); }
          else if (F.bx >= rem) p0_late(F, F.bx - rem, F.G - rem); }
    } SEAM(1);
    if (IN(2)) { for (int u = F.bx; u < 512; u += F.G) r1_unit(F, u); pool_means(F); }
    if (IN(2)) REP(2) { for (int u = F.bx; u < 512; u += F.G) r1_unit(F, u); pool_means(F); } SEAM(2);
    if (IN(3)) {
        for (int u = F.bx, jj = 0; u < 512; u += F.G, ++jj) r3_unit(F, (jj & 1) ? ((u & ~15) | (15 - (u & 15))) : u);
        PoolOrder S{F.G, F.bx, F.PoolT}; EpiPool E{F.MIXEDB, F.pool_scale};
        pg8::gemm_phase<EpiPool, PoolOrder>(ring, F.wave, F.PB, 256, 0, 256, S, E);
    }
    if (IN(3)) REP(3) {
        for (int u = F.bx, jj = 0; u < 512; u += F.G, ++jj) r3_unit(F, (jj & 1) ? ((u & ~15) | (15 - (u & 15))) : u);
        PoolOrder S{F.G, F.bx, F.PoolT}; EpiPool E{F.MIXEDB, F.pool_scale};
        pg8::gemm_phase<EpiPool, PoolOrder>(ring, F.wave, F.PB, 256, 0, 256, S, E);
    } SEAM(3);
    if (IN(4)) {
        pg8::DenseOrder S; S.init(T_, D_, F.G, F.bx, F.WoutT, D_); pg8::EpiBf16 E{(bf16*)F.MIX, D_, 0, nullptr};
        pg8::gemm_phase<pg8::EpiBf16, pg8::DenseOrder>(ring, F.wave, F.MIXEDB, D_, 0, D_, S, E);
    }
    if (IN(4)) REP(4) {
        pg8::DenseOrder S; S.init(T_, D_, F.G, F.bx, F.WoutT, D_); pg8::EpiBf16 E{(bf16*)F.MIX, D_, 0, nullptr};
        pg8::gemm_phase<pg8::EpiBf16, pg8::DenseOrder>(ring, F.wave, F.MIXEDB, D_, 0, D_, S, E);
    } SEAM(4);
    F.cntoff = CW_CNT;
    if (IN(5)) REP(5) { ln1_router(F); xcd_barrier(bar); F.cntoff = CW_CNT + 32; }
    if (IN(5)) { ln1_router(F); } SEAM(5);
    if (IN(6)) {
        build_ts(F);
#if defined(MOE_F8DMA)
#if defined(F8D_PIPE)
        MoeOrder<16, true> S{(const LAS int*)(F.lds + TS_OFF), F.lds + TOKBUF_OFF, F.STOK, (const bf16*)F.Wgu8, F.G, F.bx, 2 * FF, nullptr, 0, 0, nullptr, 0, D_};
        pg8::EpiSwiglu8 E{F.ACT8, F.bgu, 1.0f / 64.0f, F.lds};
        pg8::gemm_phase_f8d<pg8::EpiSwiglu8, MoeOrder<16, true>>(ring, F.wave, F.HB8, D_, S, E);
#else
        MoeOrder<16, true> S{(const LAS int*)(F.lds + TS_OFF), F.lds + TOKBUF_OFF, F.STOK, (const bf16*)F.Wgu8, F.G, F.bx, 2 * FF, nullptr, 0, 0, nullptr, 1, D_};
        pg8::EpiSwiglu8 E{F.ACT8, F.bgu, 1.0f / 64.0f, F.lds};
        pg8::gemm_phase<pg8::EpiSwiglu8, MoeOrder<16, true>, true, true>(ring, F.wave, (const bf16*)F.HB8, D_ / 2, 0, D_ / 2, S, E);
        MoeOrder<16, true> S2{(const LAS int*)(F.lds + TS_OFF), F.lds + TOKBUF_OFF, F.STOK, (const bf16*)F.Wgu8, F.G, F.bx, 2 * FF, nullptr, 0, 0, nullptr, 2, D_};
        pg8::gemm_phase_half<pg8::EpiSwiglu8, MoeOrder<16, true>, true>(ring, F.wave, (const bf16*)F.HB8, D_ / 2, 0, D_ / 2, S2, E);
#endif
#elif defined(MOE_FP8)
        MoeOrder<16, true> S{(const LAS int*)(F.lds + TS_OFF), F.lds + TOKBUF_OFF, F.STOK, F.WguT, F.G, F.bx, 2 * FF, F.wgu, 0, 0, nullptr, 1};
        pg8::EpiSwiglu8 E{F.ACT8, F.bgu, 1.0f / 64.0f, F.lds};
        pg8::gemm_phase_f8<pg8::EpiSwiglu8, MoeOrder<16, true>>(ring, F.wave, F.HB8, D_, 2 * FF, 64.0f, S, E);
        MoeOrder<16, true> S2{(const LAS int*)(F.lds + TS_OFF), F.lds + TOKBUF_OFF, F.STOK, F.WguT, F.G, F.bx, 2 * FF, F.wgu, 0, 0, nullptr, 2};
        pg8::gemm_phase_f8_half<pg8::EpiSwiglu8, MoeOrder<16, true>>(ring, F.wave, F.HB8, D_, 2 * FF, 64.0f, S2, E);
#else
        MoeOrder<16, true> S{(const LAS int*)(F.lds + TS_OFF), F.lds + TOKBUF_OFF, F.STOK, F.WguT, F.G, F.bx, 2 * FF, F.wgu, 0, 0, XS6, 1};
        pg8::EpiSwiglu E{F.ACTB, F.bgu};
        pg8::gemm_phase_f32b<pg8::EpiSwiglu, MoeOrder<16, true>, false>(ring, F.wave, F.HB, D_, D_, 2 * FF, S, E);
        MoeOrder<16, true> S2{(const LAS int*)(F.lds + TS_OFF), F.lds + TOKBUF_OFF, F.STOK, F.WguT, F.G, F.bx, 2 * FF, F.wgu, 0, 0, nullptr, 2};
        pg8::gemm_phase_f32b_half<pg8::EpiSwiglu, MoeOrder<16, true>>(ring, F.wave, F.HB, D_, D_, 2 * FF, S2, E);
#endif
    }
#ifndef PROBE_ABL
#define PROBE_ABL 0
#endif
    if (IN(6)) REP(6) {
        build_ts(F);
        MoeOrder<16, true> S{(const LAS int*)(F.lds + TS_OFF), F.lds + TOKBUF_OFF, F.STOK, F.WguT, F.G, F.bx, 2 * FF, F.wgu, 0, 0, nullptr, 0};
#ifndef PROBE_EPI
#define PROBE_EPI 0
#endif
        pg8::EpiSwigluT<PROBE_EPI> E{F.OUTS, F.bgu};
        pg8::gemm_phase_f32b<pg8::EpiSwigluT<PROBE_EPI>, MoeOrder<16, true>, false, PROBE_ABL>(ring, F.wave, F.HB, D_, D_, 2 * FF, S, E);
    } SEAM(6);
    if (IN(7)) {
        build_ts(F);
#if defined(MOE_F8DMA)
#if defined(F8D_PIPE)
        MoeOrder<8, false> S{(const LAS int*)(F.lds + TS_OFF), F.lds + TOKBUF_OFF, F.STOK, (const bf16*)F.Wd8, F.G, F.bx, D_, nullptr, 0, 0, nullptr, 0, FF};
        pg8::EpiDown8 E{F.OUTS, F.bd, F.SGATE, 1.0f / 64.0f, F.lds};
        pg8::gemm_phase_f8d<pg8::EpiDown8, MoeOrder<8, false>>(ring, F.wave, F.ACT8, FF, S, E);
#else
        MoeOrder<8, false> S{(const LAS int*)(F.lds + TS_OFF), F.lds + TOKBUF_OFF, F.STOK, (const bf16*)F.Wd8, F.G, F.bx, D_, nullptr, 0, 0, nullptr, 1, FF};
        pg8::EpiDown8 E{F.OUTS, F.bd, F.SGATE, 1.0f / 64.0f, F.lds};
        pg8::gemm_phase<pg8::EpiDown8, MoeOrder<8, false>, true, true>(ring, F.wave, (const bf16*)F.ACT8, FF / 2, 0, FF / 2, S, E);
        MoeOrder<8, false> S2{(const LAS int*)(F.lds + TS_OFF), F.lds + TOKBUF_OFF, F.STOK, (const bf16*)F.Wd8, F.G, F.bx, D_, nullptr, 0, 0, nullptr, 2, FF};
        pg8::gemm_phase_half<pg8::EpiDown8, MoeOrder<8, false>, true>(ring, F.wave, (const bf16*)F.ACT8, FF / 2, 0, FF / 2, S2, E);
#endif
#elif defined(MOE_FP8)
        MoeOrder<8, false> S{(const LAS int*)(F.lds + TS_OFF), F.lds + TOKBUF_OFF, F.STOK, F.WdT, F.G, F.bx, D_, F.wd, 0, 0, nullptr, 1};
        pg8::EpiDown8 E{F.OUTS, F.bd, F.SGATE, 1.0f / 64.0f, F.lds};
        pg8::gemm_phase_f8<pg8::EpiDown8, MoeOrder<8, false>>(ring, F.wave, F.ACT8, FF, D_, 64.0f, S, E);
        MoeOrder<8, false> S2{(const LAS int*)(F.lds + TS_OFF), F.lds + TOKBUF_OFF, F.STOK, F.WdT, F.G, F.bx, D_, F.wd, 0, 0, nullptr, 2};
        pg8::gemm_phase_f8_half<pg8::EpiDown8, MoeOrder<8, false>>(ring, F.wave, F.ACT8, FF, D_, 64.0f, S2, E);
#else
        MoeOrder<8, false> S{(const LAS int*)(F.lds + TS_OFF), F.lds + TOKBUF_OFF, F.STOK, F.WdT, F.G, F.bx, D_, F.wd, 0, 0, XS7, 1};
        pg8::EpiDown E{F.OUTS, F.bd, F.SGATE};
        pg8::gemm_phase_f32b<pg8::EpiDown, MoeOrder<8, false>, false>(ring, F.wave, F.ACTB, FF, FF, D_, S, E);
        MoeOrder<8, false> S2{(const LAS int*)(F.lds + TS_OFF), F.lds + TOKBUF_OFF, F.STOK, F.WdT, F.G, F.bx, D_, F.wd, 0, 0, nullptr, 2};
        pg8::gemm_phase_f32b_half<pg8::EpiDown, MoeOrder<8, false>>(ring, F.wave, F.ACTB, FF, FF, D_, S2, E);
#endif
    }
    if (IN(7)) REP(7) {
        build_ts(F);
        MoeOrder<8, false> S{(const LAS int*)(F.lds + TS_OFF), F.lds + TOKBUF_OFF, F.STOK, F.WdT, F.G, F.bx, D_, F.wd, 0, 0, nullptr, 0};
        pg8::EpiDown E{F.OUTS, F.bd, F.SGATE};
        pg8::gemm_phase_f32b<pg8::EpiDown, MoeOrder<8, false>, false>(ring, F.wave, F.ACTB, FF, FF, D_, S, E);
    } SEAM(7);
    if (IN(8)) { build_ts(F); combine_ln2(F); }
    if (IN(8)) REP(8) { build_ts(F); combine_ln2(F); }
#undef IN
#undef SEAM
}

static int g_grid = 0;
static bool setup() {
    if (g_grid) return g_grid > 0;
    int dev = 0, cus = 0, per_cu = 0;
    if (hipGetDevice(&dev) != hipSuccess || hipDeviceGetAttribute(&cus, hipDeviceAttributeMultiprocessorCount, dev) != hipSuccess) { g_grid = -1; return false; }
    if (hipFuncSetAttribute((const void*)mega_fwd, hipFuncAttributeMaxDynamicSharedMemorySize, LDS_BYTES) != hipSuccess) { fprintf(stderr, "hipFuncSetAttribute failed\n"); g_grid = -1; return false; }
    if (hipOccupancyMaxActiveBlocksPerMultiprocessor(&per_cu, (const void*)mega_fwd, NTHR, LDS_BYTES) != hipSuccess || per_cu < 1) fprintf(stderr, "occupancy query: %d per CU\n", per_cu);
    (void)hipGetLastError();
    g_grid = cus;
    return true;
}
static void launch(void* const* d_in, float* out, unsigned char* ws, hipStream_t st, int lo, int hi, int region) {
    Args a{};
    for (int i = 0; i < 16; ++i) a.in[i] = (const float*)d_in[i];
    a.out = out; a.ws = ws; a.ph_lo = lo; a.ph_hi = hi; a.bar_region = region; a.pad = 0;
    hipLaunchKernelGGL(mega_fwd, dim3(g_grid), dim3(NTHR), LDS_BYTES, st, a);
}
}
extern "C" void kernel_launch(void* const* d_in, const int* in_sizes, int n_in, void* d_out, int out_size, void* d_ws, size_t ws_size, hipStream_t stream) {
    (void)in_sizes; (void)n_in; (void)out_size; (void)ws_size;
    unsigned char* ws = (unsigned char*)d_ws;
    if (!fk::setup()) return;
    (void)hipMemsetAsync(ws + fk::WS_CTL, 0, fk::CTL_ZERO_BYTES, stream);
    fk::launch(d_in, (float*)d_out, ws, stream, 0, fk::N_PHASES, 0);
}
```

```cpp
#include <hip/hip_runtime.h>
#include <cstdio>
#include <cstdint>
#include <cmath>
#define MOE_FP8 1
#define F8_SCALED 1
namespace pg8 {
#define PG8_LAS __attribute__((address_space(3)))
typedef unsigned short bf16_t;
typedef short bf16x8 __attribute__((ext_vector_type(8)));
typedef float f32x4 __attribute__((ext_vector_type(4)));
typedef float f32x2 __attribute__((ext_vector_type(2)));
typedef unsigned u32x4 __attribute__((ext_vector_type(4)));
typedef unsigned u32x2 __attribute__((ext_vector_type(2)));
constexpr int BM = 256, BK = 64, HALF = 128, HTB = HALF * BK * 2, STAGE_BYTES = 8 * HTB, NXCD = 8;
typedef int v8i32 __attribute__((ext_vector_type(8)));
typedef short v2i16 __attribute__((ext_vector_type(2)));
typedef int v4i32 __attribute__((ext_vector_type(4)));
typedef long v2i64 __attribute__((ext_vector_type(2)));
__device__ __forceinline__ v8i32 cat8(const bf16x8 a, const bf16x8 b) { return __builtin_shufflevector(__builtin_bit_cast(v4i32, a), __builtin_bit_cast(v4i32, b), 0, 1, 2, 3, 4, 5, 6, 7); }

__host__ __device__ __forceinline__ int lds_byte(int r, int c) { const int st = (r >> 4) * 2 + (c >> 5), rr = r & 15, cc = c & 31, ob = rr * 64 + cc * 2; return st * 1024 + (ob ^ (((ob >> 9) & 1) << 5)); }
__host__ __device__ __forceinline__ void stage_rc(int b, int& R, int& C) { const int st = b / 1024, sb = b % 1024, swz = sb ^ (((sb >> 9) & 1) << 5); R = (st >> 1) * 16 + swz / 64; C = (st & 1) * 32 + (swz % 64) / 2; }
__host__ __device__ __forceinline__ int perm32(int rho) { const int n = rho >> 4, i = rho & 15; return 8 * (i >> 2) + 4 * n + (i & 3); }

struct Unit { int pm, pn, e, lm, aux, hn, par; };

__device__ __forceinline__ int fresh_lane() { int l; asm volatile("v_mbcnt_lo_u32_b32 %0, -1, 0\n\tv_mbcnt_hi_u32_b32 %0, -1, %0" : "=v"(l)); return l; }
__device__ __forceinline__ unsigned cvt_pk_bf16(float lo, float hi) { unsigned r; asm volatile("v_cvt_pk_bf16_f32 %0, %1, %2" : "=v"(r) : "v"(lo), "v"(hi)); return r; }

__device__ __forceinline__ int xcd_remap(int L, int nwg) { const int q = nwg / NXCD, r = nwg % NXCD, xcd = L % NXCD, off = L / NXCD; return (xcd < r ? xcd * (q + 1) : r * (q + 1) + (xcd - r) * q) + off; }

template <class Epi, class Sched, bool ALIGN_EPI = true, bool F8 = false>
__device__ __forceinline__ void gemm_phase(PG8_LAS unsigned char* lds, int wid, const bf16_t* Abase, int lda, int acol0, int K, const Sched& S, const Epi& E) {
    const int lane = fresh_lane(), tid = wid * 64 + lane, wr = wid >> 2, wc = wid & 3, fr = lane & 15, fq = lane >> 4;
    const int nt = K / BK;
    int sR[2], sC[2]; unsigned voffB[2];
#pragma unroll
    for (int i = 0; i < 2; ++i) { stage_rc(tid * 16 + i * 8192, sR[i], sC[i]); const int Rb = Epi::PERM ? ((sR[i] & ~31) + perm32(sR[i] & 31)) : sR[i];
        voffB[i] = (unsigned)(Rb * K + sC[i]) * 2u; }
    const size_t kstep = (size_t)(BK * 2);
    const size_t hstepB = (size_t)HALF * K * 2;
    const unsigned ldsw = (unsigned)wid * 1024u;
    const int aoff = lds_byte(wr * 64 + fr, fq * 8), boff = lds_byte(wc * 32 + fr, fq * 8);
#define PG8_SA(b, h) (((b) * 2 + (h)) * HTB)
#define PG8_SB(b, h) ((4 + (b) * 2 + (h)) * HTB)
#define PG8_STAGE(bufoff, gbase, voff) do { _Pragma("unroll") for (int _i = 0; _i < 2; ++_i) \
        __builtin_amdgcn_global_load_lds((const unsigned*)((const char*)(gbase) + (voff)[_i]), (PG8_LAS unsigned*)(lds + (bufoff) + ldsw + _i * 8192), 16, 0, 0); } while (0)
#ifndef PG8_A_AUX
#define PG8_A_AUX 0
#endif
#define PG8_STAGE_A(bufoff, gbase, voff) do { _Pragma("unroll") for (int _i = 0; _i < 2; ++_i) \
        __builtin_amdgcn_global_load_lds((const unsigned*)((const char*)(gbase) + (voff)[_i]), (PG8_LAS unsigned*)(lds + (bufoff) + ldsw + _i * 8192), 16, 0, PG8_A_AUX); } while (0)
#define PG8_STAGEX(bufoff, gbase, voff) do { if constexpr (F8) { _Pragma("unroll") for (int _i = 0; _i < 2; ++_i) { unsigned _m0s; \
        asm volatile("s_mov_b32 %0, m0\n\ts_mov_b32 m0, %3\n\ts_nop 0\n\tglobal_load_lds_dwordx4 %1, %2\n\ts_mov_b32 m0, %0" : "=&s"(_m0s) : "v"((voff)[_i]), "s"(gbase), "s"((unsigned)(size_t)lds + ldsw + (unsigned)((bufoff) + _i * 8192)) : "memory"); } } \
        else PG8_STAGE(bufoff, gbase, voff); } while (0)
#define PG8_MMA_X(ai, bj, At, Bt) do { if constexpr (!(ABL & 1)) PG8_MMA(ai, bj, At, Bt); } while (0)
#define PG8_LDA_X(dst, b, h) do { if constexpr (!(ABL & 8)) PG8_LDA(dst, b, h); } while (0)
#define PG8_LDB_X(dst, b, h) do { if constexpr (!(ABL & 8)) PG8_LDB(dst, b, h); } while (0)
#define PG8_STAGE_AX(bufoff, gbase, voff) do { if constexpr (!(ABL & 4)) PG8_STAGE_A(bufoff, gbase, voff); } while (0)
#define PG8_LDA(dst, b, h) do { _Pragma("unroll") for (int m = 0; m < 4; ++m) _Pragma("unroll") for (int k = 0; k < 2; ++k) dst[m][k] = *(const PG8_LAS bf16x8*)(lds + PG8_SA(b, h) + aoff + m * 2048 + k * 1024); } while (0)
#define PG8_LDB(dst, b, h) do { _Pragma("unroll") for (int n = 0; n < 2; ++n) _Pragma("unroll") for (int k = 0; k < 2; ++k) dst[n][k] = *(const PG8_LAS bf16x8*)(lds + PG8_SB(b, h) + boff + n * 2048 + k * 1024); } while (0)
#define PG8_MMA(ai, bj, At, Bt) do { __builtin_amdgcn_s_setprio(1); _Pragma("unroll") for (int m = 0; m < 4; ++m) _Pragma("unroll") for (int n = 0; n < 2; ++n) _Pragma("unroll") for (int k = 0; k < 2; ++k) \
        acc[ai][bj][m][n] = __builtin_amdgcn_mfma_f32_16x16x32_bf16(Bt[n][k], At[m][k], acc[ai][bj][m][n], 0, 0, 0); __builtin_amdgcn_s_setprio(0); } while (0)
#define PG8_MMAF(ai, bj, At, Bt) do { if constexpr (F8) { __builtin_amdgcn_s_setprio(1); _Pragma("unroll") for (int m = 0; m < 4; ++m) _Pragma("unroll") for (int n = 0; n < 2; ++n) \
        acc[ai][bj][m][n] = __builtin_amdgcn_mfma_scale_f32_16x16x128_f8f6f4(cat8(Bt[n][0], Bt[n][1]), cat8(At[m][0], At[m][1]), acc[ai][bj][m][n], 0, 0, 0, 0x7f7f7f7f, 0, 0x7f7f7f7f); \
        __builtin_amdgcn_s_setprio(0); } else PG8_MMA(ai, bj, At, Bt); } while (0)
#define PG8_WAIT_V(n) asm volatile("s_waitcnt vmcnt(" #n ")" ::: "memory")
#define PG8_WAIT_L(n) asm volatile("s_waitcnt lgkmcnt(" #n ")" ::: "memory")
#define PG8_BAR __builtin_amdgcn_s_barrier()
#define PG8_SCHED __builtin_amdgcn_sched_barrier(0)
#define PG8_AOFF0(dst, u) do { _Pragma("unroll") for (int _h = 0; _h < 2; ++_h) _Pragma("unroll") for (int _i = 0; _i < 2; ++_i) \
        dst[_h][_i] = (unsigned)(S.arow0(u, _h * HALF + sR[_i]) * lda + acol0 + sC[_i]) * 2u; } while (0)
#define PG8_AOFF1(dst, u, par) do { _Pragma("unroll") for (int _h = 0; _h < 2; ++_h) _Pragma("unroll") for (int _i = 0; _i < 2; ++_i) \
        dst[_h][_i] = (unsigned)(S.arow1(u, _h * HALF + sR[_i], par, lds) * lda + acol0 + sC[_i]) * 2u; } while (0)
    Unit cur, nxt; int ui = 0;
    if (!S.next(0, cur)) return;
    f32x4 acc[2][2][4][2];
#pragma unroll
    for (int a = 0; a < 2; ++a)
#pragma unroll
        for (int b = 0; b < 2; ++b)
#pragma unroll
            for (int m = 0; m < 4; ++m)
#pragma unroll
                for (int n = 0; n < 2; ++n) acc[a][b][m][n] = (f32x4){0.f, 0.f, 0.f, 0.f};
    bf16x8 At[4][2], B0[2][2], B1[2][2];
    unsigned va[2][2], vn[2][2];
    PG8_AOFF0(va, cur);
    const char* const cA = (const char*)Abase;
    const char* cB = S.bbase(cur);
    PG8_STAGEX(PG8_SB(0, 0), cB, voffB); PG8_STAGEX(PG8_SB(0, 1), cB + hstepB, voffB); PG8_STAGEX(PG8_SA(0, 0), cA, va[0]); PG8_STAGEX(PG8_SA(0, 1), cA, va[1]);
    if (wr == 1) PG8_BAR;
    PG8_WAIT_V(2); PG8_BAR;
    PG8_STAGEX(PG8_SB(1, 0), cB + kstep, voffB); PG8_STAGEX(PG8_SA(1, 0), cA + kstep, va[0]); PG8_STAGEX(PG8_SB(1, 1), cB + hstepB + kstep, voffB);
    PG8_WAIT_V(6); PG8_BAR;
    for (;;) {
        const bool has_next = S.next(ui + 1, nxt);
        const char* nB = cB;
        if (has_next) { nB = S.bbase(nxt); S.prefetch(nxt, ui & 1, lds, wid, lane); }
#pragma unroll
        for (int h = 0; h < 2; ++h)
#pragma unroll
            for (int i = 0; i < 2; ++i) vn[h][i] = va[h][i];
#pragma unroll 1
        for (int t = 0; t < nt; t += 2) {
            const bool last = (t == nt - 2);
            const char* a1 = cA + (size_t)(t + 1) * kstep;
            const char* a2 = last ? cA : cA + (size_t)(t + 2) * kstep; const char* b2 = last ? nB : cB + (size_t)(t + 2) * kstep;
            const char* a3 = a2 + kstep; const char* b3 = b2 + kstep;
            if (last && has_next) PG8_AOFF1(vn, nxt, ui & 1);
            unsigned w0[2], w1[2];
            w0[0] = last ? vn[0][0] : va[0][0]; w0[1] = last ? vn[0][1] : va[0][1]; w1[0] = last ? vn[1][0] : va[1][0]; w1[1] = last ? vn[1][1] : va[1][1];
            PG8_LDB(B0, 0, 0); PG8_LDB(B1, 0, 1); PG8_SCHED; PG8_LDA(At, 0, 0); PG8_STAGEX(PG8_SA(1, 1), a1, va[1]);
            PG8_WAIT_V(8); PG8_WAIT_L(0); PG8_BAR; PG8_MMAF(0, 0, At, B0); PG8_MMAF(0, 1, At, B1); PG8_BAR; PG8_SCHED;
            PG8_LDA(At, 0, 1); PG8_STAGEX(PG8_SB(0, 0), b2, voffB); PG8_STAGEX(PG8_SB(0, 1), b2 + hstepB, voffB); PG8_STAGEX(PG8_SA(0, 0), a2, w0);
            PG8_WAIT_V(8); PG8_WAIT_L(0); PG8_BAR; PG8_MMAF(1, 0, At, B0); PG8_MMAF(1, 1, At, B1); PG8_BAR; PG8_SCHED;
            PG8_LDB(B0, 1, 0); PG8_LDB(B1, 1, 1); PG8_SCHED; PG8_LDA(At, 1, 0); PG8_STAGEX(PG8_SA(0, 1), a2, w1);
            PG8_WAIT_V(8); PG8_WAIT_L(0); PG8_BAR; PG8_MMAF(0, 0, At, B0); PG8_MMAF(0, 1, At, B1); PG8_BAR; PG8_SCHED;
            PG8_LDA(At, 1, 1); PG8_STAGEX(PG8_SB(1, 0), b3, voffB); PG8_STAGEX(PG8_SB(1, 1), b3 + hstepB, voffB); PG8_STAGEX(PG8_SA(1, 0), a3, w0);
            PG8_WAIT_V(8); PG8_WAIT_L(0); PG8_BAR; PG8_MMAF(1, 0, At, B0); PG8_MMAF(1, 1, At, B1); PG8_BAR; PG8_SCHED;
        }
        if constexpr (ALIGN_EPI) { if (wr == 0) PG8_BAR; }
        asm volatile("s_nop 15\n\ts_nop 15" : "+v"(acc[1][1][3][1]), "+v"(acc[1][0][3][1]));
        E(acc, cur, wr, wc, fr, fq);
        if (!has_next) break;
#pragma unroll
        for (int a = 0; a < 2; ++a)
#pragma unroll
            for (int b = 0; b < 2; ++b)
#pragma unroll
                for (int m = 0; m < 4; ++m)
#pragma unroll
                    for (int n = 0; n < 2; ++n) acc[a][b][m][n] = (f32x4){0.f, 0.f, 0.f, 0.f};
        cur = nxt; cB = nB; ++ui;
#pragma unroll
        for (int h = 0; h < 2; ++h)
#pragma unroll
            for (int i = 0; i < 2; ++i) va[h][i] = vn[h][i];
        if constexpr (ALIGN_EPI) { if (wr == 1) PG8_BAR; }
    }
    PG8_WAIT_V(0);
    if constexpr (!ALIGN_EPI) { if (wr == 0) PG8_BAR; }
    PG8_BAR;

}
__device__ __forceinline__ __amdgpu_buffer_rsrc_t make_rsrc_uniform(const char* p, int bytes) {
    const unsigned long long a = (unsigned long long)p;
    const unsigned lo = __builtin_amdgcn_readfirstlane((unsigned)a), hi = __builtin_amdgcn_readfirstlane((unsigned)(a >> 32));
    return __builtin_amdgcn_make_buffer_rsrc((void*)(((unsigned long long)hi << 32) | lo), 0, bytes, 0x00020000);
}
__device__ __forceinline__ unsigned cvt_pk_bf16_nv(float lo, float hi) { unsigned r; asm("v_cvt_pk_bf16_f32 %0, %1, %2" : "=v"(r) : "v"(lo), "v"(hi)); return r; }
template <class Epi, class Sched, bool WB = false, int ABL = 0>
__device__ __forceinline__ void gemm_phase_f32b(PG8_LAS unsigned char* lds, int wid, const bf16_t* Abase, int lda, int K, int N, const Sched& S, const Epi& E) {
    static_assert(Epi::PERM, "f32-B body: PERM epilogues only");
    const int lane = fresh_lane(), tid = wid * 64 + lane, wr = wid >> 2, wc = wid & 3, fr = lane & 15, fq = lane >> 4;
    const int nt = K / BK;
    const int acol0 = 0;
    const size_t kstep = (size_t)(BK * 2);
    const unsigned ldsw = (unsigned)wid * 1024u;
    const int aoff = lds_byte(wr * 64 + fr, fq * 8), boff = lds_byte(wc * 32 + fr, fq * 8);
    const int n4 = (lane & 15) + 16 * (wid & 3), kq = (lane >> 4) + 4 * (wid >> 2);
    const unsigned vb = (unsigned)(kq * 8 * N + 4 * n4) * 4u;
    const int browb = N * 4, bkstep = BK * browb;
    const int tline = wid * 16 + (lane & 15);
    const unsigned vtouch = (unsigned)((tid >> 3) * browb + (tid & 7) * 128);
    const int bn = 4 * n4, brow0 = ((bn & 127) & ~31) + (((n4 & 1) << 4) | (((n4 & 7) >> 1) << 2));
    const int wb0 = (bn >> 7) * HTB + lds_byte(brow0, kq * 8);
    const unsigned wbaddr = (unsigned)(size_t)lds + (unsigned)wb0;
    const unsigned vwb = (unsigned)((4 * n4) * K + kq * 8) * 2u;
    Unit cur, nxt; int ui = 0;
    if (!S.next(0, cur)) return;
    f32x4 acc[2][2][4][2];
#pragma unroll
    for (int a = 0; a < 2; ++a)
#pragma unroll
        for (int b = 0; b < 2; ++b)
#pragma unroll
            for (int m = 0; m < 4; ++m)
#pragma unroll
                for (int n = 0; n < 2; ++n) acc[a][b][m][n] = (f32x4){0.f, 0.f, 0.f, 0.f};
    bf16x8 At[4][2], B0[2][2], B1[2][2];
    f32x4 RB[8];
    unsigned va[2][2];
    { int sR[2], sC[2];
_Pragma("unroll") for (int i = 0; i < 2; ++i) stage_rc(tid * 16 + i * 8192, sR[i], sC[i]);
      PG8_AOFF0(va, cur); }
    const char* const cA = (const char*)Abase;
    const char* cB = S.bbase(cur);
    __amdgpu_buffer_rsrc_t rC = make_rsrc_uniform(cB, K * browb), rN = rC;
    __amdgpu_buffer_rsrc_t wC = rC, wN = rC;
    if constexpr (WB) { wC = make_rsrc_uniform(S.wbbase(cur), 256 * K * 2); wN = wC; }
#define PG8_LOADB(rs, so) do { if constexpr (ABL & 2) break; _Pragma("unroll") for (int _j = 0; _j < 8; ++_j) { \
        if constexpr (ABL & 128) asm volatile("buffer_load_dword %0, %1, %2, %3 offen" : "=v"(RB[_j][0]) : "v"(vb), "s"(rs), "s"((so) + _j * browb) : "memory"); \
        else if constexpr (ABL & 256) asm volatile("buffer_load_dwordx4 %0, %1, %2, %3 offen" : "=v"(RB[_j]) : "v"(0u), "s"(rs), "s"((so) + _j * browb) : "memory"); \
        else asm volatile("buffer_load_dwordx4 %0, %1, %2, %3 offen" : "=v"(RB[_j]) : "v"(vb), "s"(rs), "s"((so) + _j * browb) : "memory"); } } while (0)
#define PG8_TOUCH(rs, so, q) do { if (lane < 16) { const unsigned _vt = (unsigned)((((q) * 128 + tline) >> 3) * browb + (((q) * 128 + tline) & 7) * 128); \
        asm volatile("buffer_load_dword %0, %1, %2, %3 offen" : "+v"(touchreg) : "v"(_vt), "s"(rs), "s"(so) : "memory"); } } while (0)
#define PG8_WAITB(n) asm volatile("s_waitcnt vmcnt(" #n ")" : "+v"(RB[0]), "+v"(RB[1]), "+v"(RB[2]), "+v"(RB[3]), "+v"(RB[4]), "+v"(RB[5]), "+v"(RB[6]), "+v"(RB[7]) :: "memory")
#define PG8_WRITEB(b, wrs, wso) do { if constexpr (ABL & 16) break; _Pragma("unroll") for (int _i = 0; _i < 4; ++_i) { u32x4 _w; _w.x = cvt_pk_bf16_nv(RB[0][_i], RB[1][_i]); _w.y = cvt_pk_bf16_nv(RB[2][_i], RB[3][_i]); \
        _w.z = cvt_pk_bf16_nv(RB[4][_i], RB[5][_i]); _w.w = cvt_pk_bf16_nv(RB[6][_i], RB[7][_i]); \
        asm volatile("ds_write_b128 %0, %1 offset:%2" :: "v"(wbaddr + PG8_SB(b, 0)), "v"(_w), "n"(64 * _i) : "memory"); \
        if constexpr (WB) asm volatile("buffer_store_dwordx4 %0, %1, %2, %3 offen" :: "v"(_w), "v"(vwb), "s"(wrs), "s"(wso + _i * K * 2) : "memory"); } } while (0)
    PG8_LOADB(rC, 0); PG8_STAGE_AX(PG8_SA(0, 0), cA, va[0]); PG8_STAGE_AX(PG8_SA(0, 1), cA, va[1]);
    PG8_WAITB(4); PG8_WRITEB(0, wC, 0);
    PG8_STAGE_AX(PG8_SA(1, 0), cA + kstep, va[0]); PG8_LOADB(rC, bkstep);
    if (wr == 1) PG8_BAR;
    if constexpr (WB) PG8_WAIT_V(14); else PG8_WAIT_V(10); PG8_WAIT_L(0); PG8_BAR;
    PG8_BAR;
    for (;;) {
        const bool has_next = S.next(ui + 1, nxt);
        rN = rC; wN = wC;
        if (has_next) { rN = make_rsrc_uniform(S.bbase(nxt), K * browb); if constexpr (WB) wN = make_rsrc_uniform(S.wbbase(nxt), 256 * K * 2); S.prefetch(nxt, ui & 1, lds, wid, lane); }
#pragma unroll 1
        for (int t = 0; t < nt; t += 2) {
            const bool last = (t == nt - 2);
            const char* a1 = cA + (size_t)(t + 1) * kstep;
            const char* a2 = last ? cA : cA + (size_t)(t + 2) * kstep; const char* a3 = a2 + kstep;
            const __amdgpu_buffer_rsrc_t r2 = last ? rN : rC; const int so2 = last ? 0 : (t + 2) * bkstep;
            const __amdgpu_buffer_rsrc_t w2 = last ? wN : wC; const int wso2 = last ? 0 : (t + 2) * (BK * 2);
            PG8_LDB_X(B0, 0, 0); PG8_LDB_X(B1, 0, 1); PG8_SCHED; PG8_LDA_X(At, 0, 0); if constexpr (!(ABL & 64)) PG8_STAGE_AX(PG8_SA(1, 1), a1, va[1]);
            if (last && has_next) { int sR[2], sC[2]; const int tz = wid * 64 + fresh_lane(); _Pragma("unroll") for (int i = 0; i < 2; ++i) stage_rc(tz * 16 + i * 8192, sR[i], sC[i]); PG8_AOFF1(va, nxt, ui & 1); }
            if constexpr (WB) PG8_WAIT_V(16); else PG8_WAIT_V(12);
            PG8_WAIT_L(0); PG8_BAR; PG8_MMA_X(0, 0, At, B0); PG8_MMA_X(0, 1, At, B1); PG8_BAR; PG8_SCHED;
            PG8_LDA_X(At, 0, 1); PG8_WAITB(2); PG8_WRITEB(1, wC, (t + 1) * (BK * 2)); PG8_STAGE_AX(PG8_SA(0, 0), a2, va[0]); PG8_LOADB(r2, so2);
            PG8_WAIT_L(0); PG8_BAR; PG8_MMA_X(1, 0, At, B0); PG8_MMA_X(1, 1, At, B1); PG8_BAR; PG8_SCHED;
            PG8_LDB_X(B0, 1, 0); PG8_LDB_X(B1, 1, 1); PG8_SCHED; PG8_LDA_X(At, 1, 0); if constexpr (!(ABL & 64)) PG8_STAGE_AX(PG8_SA(0, 1), a2, va[1]);
            if constexpr (WB) PG8_WAIT_V(16); else PG8_WAIT_V(12);
            PG8_WAIT_L(0); PG8_BAR; PG8_MMA_X(0, 0, At, B0); PG8_MMA_X(0, 1, At, B1); PG8_BAR; PG8_SCHED;
            PG8_LDA_X(At, 1, 1); PG8_WAITB(2); PG8_WRITEB(0, w2, wso2); PG8_STAGE_AX(PG8_SA(1, 0), a3, va[0]); PG8_LOADB(r2, so2 + bkstep);
            PG8_WAIT_L(0); PG8_BAR; PG8_MMA_X(1, 0, At, B0); PG8_MMA_X(1, 1, At, B1); PG8_BAR; PG8_SCHED;
        }
        if (wr == 0) PG8_BAR;
        asm volatile("s_nop 15\n\ts_nop 15" : "+v"(acc[1][1][3][1]), "+v"(acc[1][0][3][1]));
        if constexpr (!(ABL & 32)) E(acc, cur, wr, wc, fr, fq);
        if (!has_next) break;
#pragma unroll
        for (int a = 0; a < 2; ++a)
#pragma unroll
            for (int b = 0; b < 2; ++b)
#pragma unroll
                for (int m = 0; m < 4; ++m)
#pragma unroll
                    for (int n = 0; n < 2; ++n) acc[a][b][m][n] = (f32x4){0.f, 0.f, 0.f, 0.f};
        cur = nxt; rC = rN; wC = wN; ++ui;
        S.round_sync(ui, wid, lane);
        if (wr == 1) PG8_BAR;
    }
    PG8_WAIT_V(0);
    asm volatile("" :: "v"(RB[0]), "v"(RB[1]), "v"(RB[2]), "v"(RB[3]), "v"(RB[4]), "v"(RB[5]), "v"(RB[6]), "v"(RB[7]));
    PG8_BAR;
#undef PG8_LOADB
#undef PG8_WAITB
#undef PG8_TOUCH
#undef PG8_TOUCH
#undef PG8_WRITEB
}

template <class Epi, class Sched>
__device__ __forceinline__ void gemm_phase_f32b_half(PG8_LAS unsigned char* lds, int wid, const bf16_t* Abase, int lda, int K, int N, const Sched& S, const Epi& E) {
    static_assert(Epi::PERM, "f32-B body: PERM epilogues only");
    const int lane = fresh_lane(), tid = wid * 64 + lane, wr = wid >> 2, wc = wid & 3, fr = lane & 15, fq = lane >> 4;
    const int nt = K / BK;
    const int acol0 = 0;
    const size_t kstep = (size_t)(BK * 2);
    const unsigned ldsw = (unsigned)wid * 1024u;
    const int aoff = lds_byte(wr * 64 + fr, fq * 8), boff = lds_byte(wc * 32 + fr, fq * 8);
    const int n4 = (lane & 15) + 16 * (wid & 1), kq = (lane >> 4) + 4 * (wid >> 1);
    const unsigned vb = (unsigned)(kq * 4 * N + 4 * n4) * 4u;
    const int browb = N * 4, bkstep = BK * browb;
    const int bn = 4 * n4, brow0 = (bn & ~31) + (((n4 & 1) << 4) | (((n4 & 7) >> 1) << 2));
    const unsigned wbaddr = (unsigned)(size_t)lds + (unsigned)lds_byte(brow0, kq * 4);
    Unit cur, nxt; int ui = 0;
    if (!S.next(0, cur)) return;
    f32x4 acc[2][2][4][2];
#pragma unroll
    for (int a = 0; a < 2; ++a)
#pragma unroll
        for (int b = 0; b < 2; ++b)
#pragma unroll
            for (int m = 0; m < 4; ++m)
#pragma unroll
                for (int n = 0; n < 2; ++n) acc[a][b][m][n] = (f32x4){0.f, 0.f, 0.f, 0.f};
    bf16x8 At[4][2], B0[2][2];
    f32x4 RB[4];
    unsigned va[2][2];
    { int sR[2], sC[2];
_Pragma("unroll") for (int i = 0; i < 2; ++i) stage_rc(tid * 16 + i * 8192, sR[i], sC[i]);
      PG8_AOFF0(va, cur); }
    const char* const cA = (const char*)Abase;
    __amdgpu_buffer_rsrc_t rC = make_rsrc_uniform(S.bbase(cur), K * browb), rN = rC;
#define PG8_HLOADB(rs, so) do { _Pragma("unroll") for (int _j = 0; _j < 4; ++_j) asm volatile("buffer_load_dwordx4 %0, %1, %2, %3 offen" : "=v"(RB[_j]) : "v"(vb), "s"(rs), "s"((so) + _j * browb) : "memory"); } while (0)
#define PG8_HWAITB(n) asm volatile("s_waitcnt vmcnt(" #n ")" : "+v"(RB[0]), "+v"(RB[1]), "+v"(RB[2]), "+v"(RB[3]) :: "memory")
#define PG8_HWRITEB(b) do { _Pragma("unroll") for (int _i = 0; _i < 4; ++_i) { u32x2 _w; _w.x = cvt_pk_bf16_nv(RB[0][_i], RB[1][_i]); _w.y = cvt_pk_bf16_nv(RB[2][_i], RB[3][_i]); \
        asm volatile("ds_write_b64 %0, %1 offset:%2" :: "v"(wbaddr + PG8_SB(b, 0)), "v"(_w), "n"(64 * _i) : "memory"); } } while (0)
    PG8_HLOADB(rC, 0); PG8_STAGE_A(PG8_SA(0, 0), cA, va[0]); PG8_STAGE_A(PG8_SA(0, 1), cA, va[1]);
    PG8_HWAITB(4); PG8_HWRITEB(0);
    PG8_STAGE_A(PG8_SA(1, 0), cA + kstep, va[0]); PG8_HLOADB(rC, bkstep);
    if (wr == 1) PG8_BAR;
    PG8_WAIT_V(6); PG8_WAIT_L(0); PG8_BAR;
    PG8_BAR;
    for (;;) {
        const bool has_next = S.next(ui + 1, nxt);
        rN = rC;
        if (has_next) { rN = make_rsrc_uniform(S.bbase(nxt), K * browb); S.prefetch(nxt, ui & 1, lds, wid, lane); }
#pragma unroll 1
        for (int t = 0; t < nt; t += 2) {
            const bool last = (t == nt - 2);
            const char* a1 = cA + (size_t)(t + 1) * kstep;
            const char* a2 = last ? cA : cA + (size_t)(t + 2) * kstep; const char* a3 = a2 + kstep;
            const __amdgpu_buffer_rsrc_t r2 = last ? rN : rC; const int so2 = last ? 0 : (t + 2) * bkstep;
            PG8_LDB(B0, 0, 0); PG8_SCHED; PG8_LDA(At, 0, 0); PG8_STAGE_A(PG8_SA(1, 1), a1, va[1]);
            if (last && has_next) { int sR[2], sC[2]; const int tz = wid * 64 + fresh_lane(); _Pragma("unroll") for (int i = 0; i < 2; ++i) stage_rc(tz * 16 + i * 8192, sR[i], sC[i]); PG8_AOFF1(va, nxt, ui & 1); }
            PG8_WAIT_V(8); PG8_WAIT_L(0); PG8_BAR; PG8_MMA(0, 0, At, B0); PG8_BAR; PG8_SCHED;
            PG8_LDA(At, 0, 1); PG8_HWAITB(2); PG8_HWRITEB(1); PG8_STAGE_A(PG8_SA(0, 0), a2, va[0]); PG8_HLOADB(r2, so2);
            PG8_WAIT_L(0); PG8_BAR; PG8_MMA(1, 0, At, B0); PG8_BAR; PG8_SCHED;
            PG8_LDB(B0, 1, 0); PG8_SCHED; PG8_LDA(At, 1, 0); PG8_STAGE_A(PG8_SA(0, 1), a2, va[1]);
            PG8_WAIT_V(8); PG8_WAIT_L(0); PG8_BAR; PG8_MMA(0, 0, At, B0); PG8_BAR; PG8_SCHED;
            PG8_LDA(At, 1, 1); PG8_HWAITB(2); PG8_HWRITEB(0); PG8_STAGE_A(PG8_SA(1, 0), a3, va[0]); PG8_HLOADB(r2, so2 + bkstep);
            PG8_WAIT_L(0); PG8_BAR; PG8_MMA(1, 0, At, B0); PG8_BAR; PG8_SCHED;
        }
        if (wr == 0) PG8_BAR;
        asm volatile("s_nop 15\n\ts_nop 15" : "+v"(acc[1][1][3][1]), "+v"(acc[1][0][3][1]));
        E.half(acc, cur, wr, wc, fr, fq);
        if (!has_next) break;
#pragma unroll
        for (int a = 0; a < 2; ++a)
#pragma unroll
            for (int m = 0; m < 4; ++m)
#pragma unroll
                for (int n = 0; n < 2; ++n) acc[a][0][m][n] = (f32x4){0.f, 0.f, 0.f, 0.f};
        cur = nxt; rC = rN; ++ui;
        if (wr == 1) PG8_BAR;
    }
    PG8_WAIT_V(0);
    asm volatile("" :: "v"(RB[0]), "v"(RB[1]), "v"(RB[2]), "v"(RB[3]));
    PG8_BAR;
#undef PG8_HLOADB
#undef PG8_HWAITB
#undef PG8_HWRITEB
}
template <class Epi, class Sched, bool F8 = false>
__device__ __forceinline__ void gemm_phase_half(PG8_LAS unsigned char* lds, int wid, const bf16_t* Abase, int lda, int acol0, int K, const Sched& S, const Epi& E) {
    const int lane = fresh_lane(), tid = wid * 64 + lane, wr = wid >> 2, wc = wid & 3, fr = lane & 15, fq = lane >> 4;
    const int nt = K / BK;
    int sR[2], sC[2]; unsigned voffB[2];
#pragma unroll
    for (int i = 0; i < 2; ++i) { stage_rc(tid * 16 + i * 8192, sR[i], sC[i]); const int Rb = Epi::PERM ? ((sR[i] & ~31) + perm32(sR[i] & 31)) : sR[i];
        voffB[i] = (unsigned)(Rb * K + sC[i]) * 2u; }
    const size_t kstep = (size_t)(BK * 2);
    const unsigned ldsw = (unsigned)wid * 1024u;
    const int aoff = lds_byte(wr * 64 + fr, fq * 8), boff = lds_byte(wc * 32 + fr, fq * 8);
    Unit cur, nxt; int ui = 0;
    if (!S.next(0, cur)) return;
    f32x4 acc[2][2][4][2];
#pragma unroll
    for (int a = 0; a < 2; ++a)
#pragma unroll
        for (int b = 0; b < 2; ++b)
#pragma unroll
            for (int m = 0; m < 4; ++m)
#pragma unroll
                for (int n = 0; n < 2; ++n) acc[a][b][m][n] = (f32x4){0.f, 0.f, 0.f, 0.f};
    bf16x8 At[4][2], B0[2][2];
    unsigned va[2][2], vn[2][2];
    PG8_AOFF0(va, cur);
    const char* const cA = (const char*)Abase;
    const char* cB = S.bbase(cur);
    PG8_STAGEX(PG8_SB(0, 0), cB, voffB); PG8_STAGEX(PG8_SA(0, 0), cA, va[0]); PG8_STAGEX(PG8_SA(0, 1), cA, va[1]);
    if (wr == 1) PG8_BAR;
    PG8_WAIT_V(2); PG8_BAR;
    PG8_STAGEX(PG8_SB(1, 0), cB + kstep, voffB); PG8_STAGEX(PG8_SA(1, 0), cA + kstep, va[0]);
    PG8_WAIT_V(4); PG8_BAR;
    for (;;) {
        const bool has_next = S.next(ui + 1, nxt);
        const char* nB = cB;
        if (has_next) { nB = S.bbase(nxt); S.prefetch(nxt, ui & 1, lds, wid, lane); }
#pragma unroll
        for (int h = 0; h < 2; ++h)
#pragma unroll
            for (int i = 0; i < 2; ++i) vn[h][i] = va[h][i];
#pragma unroll 1
        for (int t = 0; t < nt; t += 2) {
            const bool last = (t == nt - 2);
            const char* a1 = cA + (size_t)(t + 1) * kstep;
            const char* a2 = last ? cA : cA + (size_t)(t + 2) * kstep; const char* b2 = last ? nB : cB + (size_t)(t + 2) * kstep;
            const char* a3 = a2 + kstep; const char* b3 = b2 + kstep;
            if (last && has_next) PG8_AOFF1(vn, nxt, ui & 1);
            unsigned w0[2], w1[2];
            w0[0] = last ? vn[0][0] : va[0][0]; w0[1] = last ? vn[0][1] : va[0][1]; w1[0] = last ? vn[1][0] : va[1][0]; w1[1] = last ? vn[1][1] : va[1][1];
            PG8_LDB(B0, 0, 0); PG8_SCHED; PG8_LDA(At, 0, 0); PG8_STAGEX(PG8_SA(1, 1), a1, va[1]);
            PG8_WAIT_V(6); PG8_WAIT_L(0); PG8_BAR; PG8_MMAF(0, 0, At, B0); PG8_BAR; PG8_SCHED;
            PG8_LDA(At, 0, 1); PG8_STAGEX(PG8_SB(0, 0), b2, voffB); PG8_STAGEX(PG8_SA(0, 0), a2, w0);
            PG8_WAIT_V(6); PG8_WAIT_L(0); PG8_BAR; PG8_MMAF(1, 0, At, B0); PG8_BAR; PG8_SCHED;
            PG8_LDB(B0, 1, 0); PG8_SCHED; PG8_LDA(At, 1, 0); PG8_STAGEX(PG8_SA(0, 1), a2, w1);
            PG8_WAIT_V(6); PG8_WAIT_L(0); PG8_BAR; PG8_MMAF(0, 0, At, B0); PG8_BAR; PG8_SCHED;
            PG8_LDA(At, 1, 1); PG8_STAGEX(PG8_SB(1, 0), b3, voffB); PG8_STAGEX(PG8_SA(1, 0), a3, w0);
            PG8_WAIT_V(6); PG8_WAIT_L(0); PG8_BAR; PG8_MMAF(1, 0, At, B0); PG8_BAR; PG8_SCHED;
        }
        if (wr == 0) PG8_BAR;
        asm volatile("s_nop 15\n\ts_nop 15" : "+v"(acc[1][1][3][1]), "+v"(acc[1][0][3][1]));
        E.half(acc, cur, wr, wc, fr, fq);
        if (!has_next) break;
#pragma unroll
        for (int a = 0; a < 2; ++a)
#pragma unroll
            for (int m = 0; m < 4; ++m)
#pragma unroll
                for (int n = 0; n < 2; ++n) acc[a][0][m][n] = (f32x4){0.f, 0.f, 0.f, 0.f};
        cur = nxt; cB = nB; ++ui;
#pragma unroll
        for (int h = 0; h < 2; ++h)
#pragma unroll
            for (int i = 0; i < 2; ++i) va[h][i] = vn[h][i];
        if (wr == 1) PG8_BAR;
    }
    PG8_WAIT_V(0);
    PG8_BAR;
}
template <class Epi, class Sched>
__device__ __forceinline__ void gemm_phase_f8(PG8_LAS unsigned char* lds, int wid, const unsigned char* Abase, int K, int N, float wscale, const Sched& S, const Epi& E) {
    static_assert(Epi::PERM, "fp8 body: PERM epilogues only");
    const int lane = fresh_lane(), tid = wid * 64 + lane, wr = wid >> 2, wc = wid & 3, fr = lane & 15, fq = lane >> 4;
    const int nt = K / 128;
    const int lda = K / 2, acol0 = 0;
    const size_t kstep = 128;
    const unsigned ldsw = (unsigned)wid * 1024u;
    const int aoff = lds_byte(wr * 64 + fr, fq * 8), boff = lds_byte(wc * 32 + fr, fq * 8);
    const int n4 = (lane & 15) + 16 * (wid & 3), kq = (lane >> 4) + 4 * (wid >> 2);
    const unsigned vb = (unsigned)(kq * 8 * N + 4 * n4) * 4u;
    const int browb = N * 4, bhstep = 64 * browb, bkstep = 128 * browb;
    const int bn = 4 * n4, brow0 = ((bn & 127) & ~31) + (((n4 & 1) << 4) | (((n4 & 7) >> 1) << 2));
    const unsigned wbaddr = (unsigned)(size_t)lds + (unsigned)(4 * HTB + (bn >> 7) * HTB + lds_byte(brow0, kq * 4));
    const unsigned ldsm0 = (unsigned)(size_t)lds + ldsw;
    Unit cur, nxt; int ui = 0;
    if (!S.next(0, cur)) return;
    nxt = cur;
    f32x4 acc[2][2][4][2];
#pragma unroll
    for (int a = 0; a < 2; ++a)
#pragma unroll
        for (int b = 0; b < 2; ++b)
#pragma unroll
            for (int m = 0; m < 4; ++m)
#pragma unroll
                for (int n = 0; n < 2; ++n) acc[a][b][m][n] = (f32x4){0.f, 0.f, 0.f, 0.f};
    bf16x8 Aa[2], B0[2][2], B1[2][2];
    f32x4 RB[8];
    unsigned va[2][2];
    { int sR[2], sC[2];
_Pragma("unroll") for (int i = 0; i < 2; ++i) stage_rc(tid * 16 + i * 8192, sR[i], sC[i]);
      PG8_AOFF0(va, cur); }
    const char* const cA = (const char*)Abase;
    __amdgpu_buffer_rsrc_t rC = make_rsrc_uniform(S.bbase(cur), K * browb), rN = rC;
#define PG8_STAGE_A8(bufoff, gbase, voff) do { _Pragma("unroll") for (int _i = 0; _i < 2; ++_i) { unsigned _m0s; \
        asm volatile("s_mov_b32 %0, m0\n\ts_mov_b32 m0, %3\n\ts_nop 0\n\tglobal_load_lds_dwordx4 %1, %2\n\ts_mov_b32 m0, %0" : "=&s"(_m0s) : "v"((voff)[_i]), "s"(gbase), "s"(ldsm0 + (unsigned)((bufoff) + _i * 8192)) : "memory"); } } while (0)
#define PG8_FLOADB(rs, so) do { _Pragma("unroll") for (int _j = 0; _j < 8; ++_j) asm volatile("buffer_load_dwordx4 %0, %1, %2, %3 offen" : "=v"(RB[_j]) : "v"(vb), "s"(rs), "s"((so) + _j * browb) : "memory"); } while (0)
#define PG8_FWAITB(n) asm volatile("s_waitcnt vmcnt(" #n ")" : "+v"(RB[0]), "+v"(RB[1]), "+v"(RB[2]), "+v"(RB[3]), "+v"(RB[4]), "+v"(RB[5]), "+v"(RB[6]), "+v"(RB[7]) :: "memory")
#define PG8_FWRITEB(b, h) do { _Pragma("unroll") for (int _i = 0; _i < 4; ++_i) { u32x2 _w; v2i16 _lo, _hi; \
        _lo = __builtin_amdgcn_cvt_scalef32_pk_fp8_f32(_lo, RB[0][_i], RB[1][_i], 1.0f / wscale, false); _lo = __builtin_amdgcn_cvt_scalef32_pk_fp8_f32(_lo, RB[2][_i], RB[3][_i], 1.0f / wscale, true); \
        _hi = __builtin_amdgcn_cvt_scalef32_pk_fp8_f32(_hi, RB[4][_i], RB[5][_i], 1.0f / wscale, false); _hi = __builtin_amdgcn_cvt_scalef32_pk_fp8_f32(_hi, RB[6][_i], RB[7][_i], 1.0f / wscale, true); \
        _w.x = __builtin_bit_cast(unsigned, _lo); _w.y = __builtin_bit_cast(unsigned, _hi); \
        asm volatile("ds_write_b64 %0, %1 offset:%2" :: "v"(wbaddr), "v"(_w), "n"((b) * 2 * HTB + (h) * 1024 + 64 * _i) : "memory"); } } while (0)
#define PG8_LDA1(dst, b, h, m) do { dst[0] = *(const PG8_LAS bf16x8*)(lds + PG8_SA(b, h) + aoff + (m) * 2048); dst[1] = *(const PG8_LAS bf16x8*)(lds + PG8_SA(b, h) + aoff + (m) * 2048 + 1024); } while (0)
#if defined(F8_SCALED)
#define PG8_MM1(ai, m, A) do { _Pragma("unroll") for (int n = 0; n < 2; ++n) { \
        acc[ai][0][m][n] = __builtin_amdgcn_mfma_scale_f32_16x16x128_f8f6f4(cat8(B0[n][0], B0[n][1]), cat8(A[0], A[1]), acc[ai][0][m][n], 0, 0, 0, 0x7f7f7f7f, 0, 0x7f7f7f7f); \
        acc[ai][1][m][n] = __builtin_amdgcn_mfma_scale_f32_16x16x128_f8f6f4(cat8(B1[n][0], B1[n][1]), cat8(A[0], A[1]), acc[ai][1][m][n], 0, 0, 0, 0x7f7f7f7f, 0, 0x7f7f7f7f); } } while (0)
#else
#define PG8_MM1(ai, m, A) do { _Pragma("unroll") for (int n = 0; n < 2; ++n) _Pragma("unroll") for (int k = 0; k < 2; ++k) { \
        const v2i64 _a = __builtin_bit_cast(v2i64, A[k]), _b0 = __builtin_bit_cast(v2i64, B0[n][k]), _b1 = __builtin_bit_cast(v2i64, B1[n][k]); \
        acc[ai][0][m][n] = __builtin_amdgcn_mfma_f32_16x16x32_fp8_fp8(_b0[0], _a[0], acc[ai][0][m][n], 0, 0, 0); \
        acc[ai][0][m][n] = __builtin_amdgcn_mfma_f32_16x16x32_fp8_fp8(_b0[1], _a[1], acc[ai][0][m][n], 0, 0, 0); \
        acc[ai][1][m][n] = __builtin_amdgcn_mfma_f32_16x16x32_fp8_fp8(_b1[0], _a[0], acc[ai][1][m][n], 0, 0, 0); \
        acc[ai][1][m][n] = __builtin_amdgcn_mfma_f32_16x16x32_fp8_fp8(_b1[1], _a[1], acc[ai][1][m][n], 0, 0, 0); } } while (0)
#endif
#define PG8_MMA8(ai, b) do { __builtin_amdgcn_s_setprio(1); \
        PG8_MM1(ai, 0, Aa); PG8_SCHED; PG8_LDA1(Aa, b, ai, 1); PG8_MM1(ai, 1, Aa); PG8_SCHED; \
        PG8_LDA1(Aa, b, ai, 2); PG8_MM1(ai, 2, Aa); PG8_SCHED; \
        PG8_LDA1(Aa, b, ai, 3); PG8_MM1(ai, 3, Aa); __builtin_amdgcn_s_setprio(0); } while (0)
    PG8_FLOADB(rC, 0); PG8_FWAITB(0); PG8_FWRITEB(0, 0);
    PG8_FLOADB(rC, bhstep); PG8_STAGE_A8(PG8_SA(0, 0), cA, va[0]); PG8_STAGE_A8(PG8_SA(0, 1), cA, va[1]);
    PG8_FWAITB(4); PG8_FWRITEB(0, 1);
    PG8_FLOADB(rC, bkstep); PG8_STAGE_A8(PG8_SA(1, 0), cA + kstep, va[0]);
    if (wr == 1) PG8_BAR;
    PG8_WAIT_V(10); PG8_WAIT_L(0); PG8_BAR;
    PG8_BAR;
    for (;;) {
        const bool has_next = S.next(ui + 1, nxt);
        rN = rC;
        if (has_next) { rN = make_rsrc_uniform(S.bbase(nxt), K * browb); S.prefetch(nxt, ui & 1, lds, wid, lane); }
        E.prefetch(cur, ui & 1, lds, wid, lane);
#pragma unroll 1
        for (int t = 0; t < nt; t += 2) {
            const bool last = (t == nt - 2);
            const char* a1 = cA + (size_t)(t + 1) * kstep;
            const char* a2 = last ? cA : cA + (size_t)(t + 2) * kstep; const char* a3 = a2 + kstep;
            const __amdgpu_buffer_rsrc_t r2 = last ? rN : rC; const int so2 = last ? 0 : (t + 2) * bkstep;
            PG8_LDA1(Aa, 0, 0, 0);
            PG8_FWAITB(2); PG8_FWRITEB(1, 0); PG8_FLOADB(rC, (t + 1) * bkstep + bhstep);
            PG8_SCHED; PG8_LDB(B0, 0, 0); PG8_LDB(B1, 0, 1);
            PG8_WAIT_L(0); PG8_BAR; PG8_STAGE_A8(PG8_SA(1, 1), a1, va[1]); PG8_MMA8(0, 0); PG8_BAR; PG8_SCHED;
            { unsigned vt[2][2]; int sR[2], sC[2]; const int tz = wid * 64 + fresh_lane(); const bool sw = last && has_next;
_Pragma("unroll") for (int i = 0; i < 2; ++i) stage_rc(tz * 16 + i * 8192, sR[i], sC[i]);
              PG8_AOFF1(vt, nxt, ui & 1);
_Pragma("unroll") for (int h = 0; h < 2; ++h) _Pragma("unroll") for (int i = 0; i < 2; ++i) va[h][i] = sw ? vt[h][i] : va[h][i]; }
            PG8_LDA1(Aa, 0, 1, 0);
            PG8_FWAITB(2); PG8_FWRITEB(1, 1); PG8_FLOADB(r2, so2);
            PG8_WAIT_L(0); PG8_BAR; PG8_STAGE_A8(PG8_SA(0, 0), a2, va[0]); PG8_MMA8(1, 0); PG8_BAR; PG8_SCHED;
            PG8_LDA1(Aa, 1, 0, 0);
            PG8_FWAITB(2); PG8_FWRITEB(0, 0); PG8_FLOADB(r2, so2 + bhstep);
            PG8_SCHED; PG8_LDB(B0, 1, 0); PG8_LDB(B1, 1, 1);
            PG8_WAIT_L(0); PG8_BAR; PG8_STAGE_A8(PG8_SA(0, 1), a2, va[1]); PG8_MMA8(0, 1); PG8_BAR; PG8_SCHED;
            PG8_LDA1(Aa, 1, 1, 0);
            PG8_FWAITB(2); PG8_FWRITEB(0, 1); PG8_FLOADB(r2, so2 + bkstep);
            PG8_WAIT_L(0); PG8_BAR; PG8_STAGE_A8(PG8_SA(1, 0), a3, va[0]); PG8_MMA8(1, 1); PG8_BAR; PG8_SCHED;
        }
        if (wr == 0) PG8_BAR;
        asm volatile("s_nop 15\n\ts_nop 15" : "+v"(acc[1][1][3][1]), "+v"(acc[1][0][3][1]));
        cur.par = ui & 1; E(acc, cur, wr, wc, fr, fq);
        if (!has_next) break;
#pragma unroll
        for (int a = 0; a < 2; ++a)
#pragma unroll
            for (int b = 0; b < 2; ++b)
#pragma unroll
                for (int m = 0; m < 4; ++m)
#pragma unroll
                    for (int n = 0; n < 2; ++n) acc[a][b][m][n] = (f32x4){0.f, 0.f, 0.f, 0.f};
        cur = nxt; rC = rN; ++ui;
        if (wr == 1) PG8_BAR;
    }
    PG8_WAIT_V(0);
    asm volatile("" :: "v"(RB[0]), "v"(RB[1]), "v"(RB[2]), "v"(RB[3]), "v"(RB[4]), "v"(RB[5]), "v"(RB[6]), "v"(RB[7]));
    PG8_BAR;
#undef PG8_FLOADB
#undef PG8_STAGE_A8
#undef PG8_FWAITB
#undef PG8_FWRITEB
#undef PG8_MMA8
#undef PG8_MM1
#undef PG8_LDA1
}
template <class Epi, class Sched>
__device__ __forceinline__ void gemm_phase_f8_half(PG8_LAS unsigned char* lds, int wid, const unsigned char* Abase, int K, int N, float wscale, const Sched& S, const Epi& E) {
    static_assert(Epi::PERM, "fp8 body: PERM epilogues only");
    const int lane = fresh_lane(), tid = wid * 64 + lane, wr = wid >> 2, wc = wid & 3, fr = lane & 15, fq = lane >> 4;
    const int nt = K / 128;
    const int lda = K / 2, acol0 = 0;
    const size_t kstep = 128;
    const unsigned ldsw = (unsigned)wid * 1024u;
    const int aoff = lds_byte(wr * 64 + fr, fq * 8), boff = lds_byte(wc * 32 + fr, fq * 8);
    const int n4 = (lane & 15) + 16 * (wid & 1), kq = (lane >> 4) + 4 * (wid >> 1);
    const unsigned vb = (unsigned)(kq * 4 * N + 4 * n4) * 4u;
    const int browb = N * 4, bhstep = 64 * browb, bkstep = 128 * browb;
    const int bn = 4 * n4, brow0 = (bn & ~31) + (((n4 & 1) << 4) | (((n4 & 7) >> 1) << 2));
    const unsigned wbaddr = (unsigned)(size_t)lds + (unsigned)(4 * HTB + lds_byte(brow0, kq * 2));
    const unsigned ldsm0 = (unsigned)(size_t)lds + ldsw;
    Unit cur, nxt; int ui = 0;
    if (!S.next(0, cur)) return;
    f32x4 acc[2][2][4][2];
#pragma unroll
    for (int a = 0; a < 2; ++a)
#pragma unroll
        for (int b = 0; b < 2; ++b)
#pragma unroll
            for (int m = 0; m < 4; ++m)
#pragma unroll
                for (int n = 0; n < 2; ++n) acc[a][b][m][n] = (f32x4){0.f, 0.f, 0.f, 0.f};
    bf16x8 Aa[2], Ab[2], B0[2][2];
    f32x4 RB[4];
    unsigned va[2][2];
    { int sR[2], sC[2];
_Pragma("unroll") for (int i = 0; i < 2; ++i) stage_rc(tid * 16 + i * 8192, sR[i], sC[i]);
      PG8_AOFF0(va, cur); }
    const char* const cA = (const char*)Abase;
    __amdgpu_buffer_rsrc_t rC = make_rsrc_uniform(S.bbase(cur), K * browb), rN = rC;
#define PG8_STAGE_A8(bufoff, gbase, voff) do { _Pragma("unroll") for (int _i = 0; _i < 2; ++_i) { unsigned _m0s; \
        asm volatile("s_mov_b32 %0, m0\n\ts_mov_b32 m0, %3\n\ts_nop 0\n\tglobal_load_lds_dwordx4 %1, %2\n\ts_mov_b32 m0, %0" : "=&s"(_m0s) : "v"((voff)[_i]), "s"(gbase), "s"(ldsm0 + (unsigned)((bufoff) + _i * 8192)) : "memory"); } } while (0)
#define PG8_FLOADB(rs, so) do { _Pragma("unroll") for (int _j = 0; _j < 4; ++_j) asm volatile("buffer_load_dwordx4 %0, %1, %2, %3 offen" : "=v"(RB[_j]) : "v"(vb), "s"(rs), "s"((so) + _j * browb) : "memory"); } while (0)
#define PG8_FWAITB(n) asm volatile("s_waitcnt vmcnt(" #n ")" : "+v"(RB[0]), "+v"(RB[1]), "+v"(RB[2]), "+v"(RB[3]) :: "memory")
#define PG8_FWRITEB(b, h) do { _Pragma("unroll") for (int _i = 0; _i < 4; ++_i) { v2i16 _lo; \
        _lo = __builtin_amdgcn_cvt_scalef32_pk_fp8_f32(_lo, RB[0][_i], RB[1][_i], 1.0f / wscale, false); _lo = __builtin_amdgcn_cvt_scalef32_pk_fp8_f32(_lo, RB[2][_i], RB[3][_i], 1.0f / wscale, true); \
        asm volatile("ds_write_b32 %0, %1 offset:%2" :: "v"(wbaddr), "v"(__builtin_bit_cast(unsigned, _lo)), "n"((b) * 2 * HTB + (h) * 1024 + 64 * _i) : "memory"); } } while (0)
#define PG8_LDA1(dst, b, h, m) do { dst[0] = *(const PG8_LAS bf16x8*)(lds + PG8_SA(b, h) + aoff + (m) * 2048); dst[1] = *(const PG8_LAS bf16x8*)(lds + PG8_SA(b, h) + aoff + (m) * 2048 + 1024); } while (0)
#define PG8_MM1(ai, m, A) do { _Pragma("unroll") for (int n = 0; n < 2; ++n) \
        acc[ai][0][m][n] = __builtin_amdgcn_mfma_scale_f32_16x16x128_f8f6f4(cat8(B0[n][0], B0[n][1]), cat8(A[0], A[1]), acc[ai][0][m][n], 0, 0, 0, 0x7f7f7f7f, 0, 0x7f7f7f7f); } while (0)
#define PG8_MMA8(ai, b) do { __builtin_amdgcn_s_setprio(1); \
        PG8_LDA1(Ab, b, ai, 1); PG8_MM1(ai, 0, Aa); PG8_SCHED; \
        PG8_LDA1(Aa, b, ai, 2); PG8_MM1(ai, 1, Ab); PG8_SCHED; \
        PG8_LDA1(Ab, b, ai, 3); PG8_MM1(ai, 2, Aa); PG8_SCHED; \
        PG8_MM1(ai, 3, Ab); __builtin_amdgcn_s_setprio(0); } while (0)
    PG8_FLOADB(rC, 0); PG8_FWAITB(0); PG8_FWRITEB(0, 0);
    PG8_FLOADB(rC, bhstep); PG8_STAGE_A8(PG8_SA(0, 0), cA, va[0]); PG8_STAGE_A8(PG8_SA(0, 1), cA, va[1]);
    PG8_FWAITB(4); PG8_FWRITEB(0, 1);
    PG8_FLOADB(rC, bkstep); PG8_STAGE_A8(PG8_SA(1, 0), cA + kstep, va[0]);
    if (wr == 1) PG8_BAR;
    PG8_WAIT_V(6); PG8_WAIT_L(0); PG8_BAR;
    PG8_BAR;
    for (;;) {
        const bool has_next = S.next(ui + 1, nxt);
        rN = rC;
        if (has_next) { rN = make_rsrc_uniform(S.bbase(nxt), K * browb); S.prefetch(nxt, ui & 1, lds, wid, lane); }
        E.prefetch(cur, ui & 1, lds, wid, lane);
#pragma unroll 1
        for (int t = 0; t < nt; t += 2) {
            const bool last = (t == nt - 2);
            const char* a1 = cA + (size_t)(t + 1) * kstep;
            const char* a2 = last ? cA : cA + (size_t)(t + 2) * kstep; const char* a3 = a2 + kstep;
            const __amdgpu_buffer_rsrc_t r2 = last ? rN : rC; const int so2 = last ? 0 : (t + 2) * bkstep;
            unsigned vn[2][2];
_Pragma("unroll") for (int h = 0; h < 2; ++h) _Pragma("unroll") for (int i = 0; i < 2; ++i) vn[h][i] = va[h][i];
            if (last && has_next) { int sR[2], sC[2]; const int tz = wid * 64 + fresh_lane(); _Pragma("unroll") for (int i = 0; i < 2; ++i) stage_rc(tz * 16 + i * 8192, sR[i], sC[i]); PG8_AOFF1(vn, nxt, ui & 1); }
            PG8_LDA1(Aa, 0, 0, 0);
            PG8_FWAITB(2); PG8_FWRITEB(1, 0); PG8_FLOADB(rC, (t + 1) * bkstep + bhstep);
            PG8_SCHED; PG8_LDB(B0, 0, 0);
            PG8_WAIT_L(0); PG8_BAR; PG8_STAGE_A8(PG8_SA(1, 1), a1, va[1]); PG8_MMA8(0, 0); PG8_BAR; PG8_SCHED;
_Pragma("unroll") for (int h = 0; h < 2; ++h) _Pragma("unroll") for (int i = 0; i < 2; ++i) va[h][i] = vn[h][i];
            PG8_LDA1(Aa, 0, 1, 0);
            PG8_FWAITB(2); PG8_FWRITEB(1, 1); PG8_FLOADB(r2, so2);
            PG8_WAIT_L(0); PG8_BAR; PG8_STAGE_A8(PG8_SA(0, 0), a2, va[0]); PG8_MMA8(1, 0); PG8_BAR; PG8_SCHED;
            PG8_LDA1(Aa, 1, 0, 0);
            PG8_FWAITB(2); PG8_FWRITEB(0, 0); PG8_FLOADB(r2, so2 + bhstep);
            PG8_SCHED; PG8_LDB(B0, 1, 0);
            PG8_WAIT_L(0); PG8_BAR; PG8_STAGE_A8(PG8_SA(0, 1), a2, va[1]); PG8_MMA8(0, 1); PG8_BAR; PG8_SCHED;
            PG8_LDA1(Aa, 1, 1, 0);
            PG8_FWAITB(2); PG8_FWRITEB(0, 1); PG8_FLOADB(r2, so2 + bkstep);
            PG8_WAIT_L(0); PG8_BAR; PG8_STAGE_A8(PG8_SA(1, 0), a3, va[0]); PG8_MMA8(1, 1); PG8_BAR; PG8_SCHED;
        }
        if (wr == 0) PG8_BAR;
        asm volatile("s_nop 15\n\ts_nop 15" : "+v"(acc[1][0][3][1]), "+v"(acc[0][0][3][1]));
        cur.par = ui & 1; E.half(acc, cur, wr, wc, fr, fq);
        if (!has_next) break;
#pragma unroll
        for (int a = 0; a < 2; ++a)
#pragma unroll
            for (int m = 0; m < 4; ++m)
#pragma unroll
                for (int n = 0; n < 2; ++n) acc[a][0][m][n] = (f32x4){0.f, 0.f, 0.f, 0.f};
        cur = nxt; rC = rN; ++ui;
        if (wr == 1) PG8_BAR;
    }
    PG8_WAIT_V(0);
    asm volatile("" :: "v"(RB[0]), "v"(RB[1]), "v"(RB[2]), "v"(RB[3]));
    PG8_BAR;
#undef PG8_FLOADB
#undef PG8_STAGE_A8
#undef PG8_FWAITB
#undef PG8_FWRITEB
#undef PG8_MMA8
#undef PG8_MM1
#undef PG8_LDA1
}
template <class Epi, class Sched>
__device__ __forceinline__ void gemm_phase_f8d(PG8_LAS unsigned char* lds, int wid, const unsigned char* Abase, int K, const Sched& S, const Epi& E) {
    static_assert(Epi::PERM, "fp8 body: PERM epilogues only");
    const int lane = fresh_lane(), tid = wid * 64 + lane, wr = wid >> 2, wc = wid & 3, fr = lane & 15, fq = lane >> 4;
    const int nt = K / 128;
    const int lda = K / 2, acol0 = 0;
    const size_t kstep = 128;
    const unsigned ldsw = (unsigned)wid * 1024u;
    const int aoff = lds_byte(wr * 64 + fr, fq * 8), boff = lds_byte(wc * 32 + fr, fq * 8);
    unsigned voffB[2];
    { int sR[2], sC[2];
_Pragma("unroll") for (int i = 0; i < 2; ++i) { stage_rc(tid * 16 + i * 8192, sR[i], sC[i]); voffB[i] = (unsigned)(((sR[i] & ~31) + perm32(sR[i] & 31)) * K + sC[i] * 2); } }
    const size_t hstepB = (size_t)HALF * K;
    const unsigned ldsm0 = (unsigned)(size_t)lds + ldsw;
    Unit cur, nxt; int ui = 0;
    if (!S.next(0, cur)) return;
    nxt = cur;
    f32x4 acc[2][2][4][2];
#pragma unroll
    for (int a = 0; a < 2; ++a)
#pragma unroll
        for (int b = 0; b < 2; ++b)
#pragma unroll
            for (int m = 0; m < 4; ++m)
#pragma unroll
                for (int n = 0; n < 2; ++n) acc[a][b][m][n] = (f32x4){0.f, 0.f, 0.f, 0.f};
    bf16x8 Aa[2], Ab[2], Ac[2], B0[2][2], B1[2][2];
    unsigned va[2][2];
    { int sR[2], sC[2];
_Pragma("unroll") for (int i = 0; i < 2; ++i) stage_rc(tid * 16 + i * 8192, sR[i], sC[i]);
      PG8_AOFF0(va, cur); }
    const char* const cA = (const char*)Abase;
    const char* cB = S.bbase(cur);
#define PG8_STAGE_A8(bufoff, gbase, voff) do { _Pragma("unroll") for (int _i = 0; _i < 2; ++_i) { unsigned _m0s; \
        asm volatile("s_mov_b32 %0, m0\n\ts_mov_b32 m0, %3\n\ts_nop 0\n\tglobal_load_lds_dwordx4 %1, %2\n\ts_mov_b32 m0, %0" : "=&s"(_m0s) : "v"((voff)[_i]), "s"(gbase), "s"(ldsm0 + (unsigned)((bufoff) + _i * 8192)) : "memory"); } } while (0)
#define PG8_LDA1(dst, b, h, m) do { dst[0] = *(const PG8_LAS bf16x8*)(lds + PG8_SA(b, h) + aoff + (m) * 2048); dst[1] = *(const PG8_LAS bf16x8*)(lds + PG8_SA(b, h) + aoff + (m) * 2048 + 1024); } while (0)
#if defined(F8_SCALED)
#define PG8_MM1(ai, m, A) do { _Pragma("unroll") for (int n = 0; n < 2; ++n) { \
        acc[ai][0][m][n] = __builtin_amdgcn_mfma_scale_f32_16x16x128_f8f6f4(cat8(B0[n][0], B0[n][1]), cat8(A[0], A[1]), acc[ai][0][m][n], 0, 0, 0, 0x7f7f7f7f, 0, 0x7f7f7f7f); \
        acc[ai][1][m][n] = __builtin_amdgcn_mfma_scale_f32_16x16x128_f8f6f4(cat8(B1[n][0], B1[n][1]), cat8(A[0], A[1]), acc[ai][1][m][n], 0, 0, 0, 0x7f7f7f7f, 0, 0x7f7f7f7f); } } while (0)
#else
#define PG8_MM1(ai, m, A) do { _Pragma("unroll") for (int n = 0; n < 2; ++n) _Pragma("unroll") for (int k = 0; k < 2; ++k) { \
        const v2i64 _a = __builtin_bit_cast(v2i64, A[k]), _b0 = __builtin_bit_cast(v2i64, B0[n][k]), _b1 = __builtin_bit_cast(v2i64, B1[n][k]); \
        acc[ai][0][m][n] = __builtin_amdgcn_mfma_f32_16x16x32_fp8_fp8(_b0[0], _a[0], acc[ai][0][m][n], 0, 0, 0); \
        acc[ai][0][m][n] = __builtin_amdgcn_mfma_f32_16x16x32_fp8_fp8(_b0[1], _a[1], acc[ai][0][m][n], 0, 0, 0); \
        acc[ai][1][m][n] = __builtin_amdgcn_mfma_f32_16x16x32_fp8_fp8(_b1[0], _a[0], acc[ai][1][m][n], 0, 0, 0); \
        acc[ai][1][m][n] = __builtin_amdgcn_mfma_f32_16x16x32_fp8_fp8(_b1[1], _a[1], acc[ai][1][m][n], 0, 0, 0); } } while (0)
#endif
#define PG8_MMA8(ai, b) do { __builtin_amdgcn_s_setprio(1); \
        PG8_LDA1(Ac, b, ai, 2); PG8_MM1(ai, 0, Aa); PG8_SCHED; \
        PG8_LDA1(Aa, b, ai, 3); PG8_MM1(ai, 1, Ab); PG8_SCHED; \
        PG8_MM1(ai, 2, Ac); PG8_SCHED; \
        PG8_MM1(ai, 3, Aa); __builtin_amdgcn_s_setprio(0); } while (0)
    PG8_STAGE_A8(PG8_SB(0, 0), cB, voffB); PG8_STAGE_A8(PG8_SB(0, 1), cB + hstepB, voffB); PG8_STAGE_A8(PG8_SA(0, 0), cA, va[0]); PG8_STAGE_A8(PG8_SA(0, 1), cA, va[1]);
    PG8_STAGE_A8(PG8_SB(1, 0), cB + kstep, voffB); PG8_STAGE_A8(PG8_SB(1, 1), cB + hstepB + kstep, voffB); PG8_STAGE_A8(PG8_SA(1, 0), cA + kstep, va[0]);
    if (wr == 1) PG8_BAR;
    PG8_WAIT_V(6); PG8_BAR;
    PG8_BAR;
    for (;;) {
        const bool has_next = S.next(ui + 1, nxt);
        const char* nB = cB;
        if (has_next) { nB = S.bbase(nxt); S.prefetch(nxt, ui & 1, lds, wid, lane); }
#pragma unroll 1
        for (int t = 0; t < nt; t += 2) {
            const bool last = (t == nt - 2);
            const char* a1 = cA + (size_t)(t + 1) * kstep;
            const char* a2 = last ? cA : cA + (size_t)(t + 2) * kstep; const char* a3 = a2 + kstep;
            const char* b2 = last ? nB : cB + (size_t)(t + 2) * kstep; const char* b3 = b2 + kstep;
            PG8_LDA1(Aa, 0, 0, 0); PG8_LDA1(Ab, 0, 0, 1); PG8_LDB(B0, 0, 0); PG8_LDB(B1, 0, 1);
            PG8_WAIT_V(6); PG8_WAIT_L(0); PG8_BAR; PG8_STAGE_A8(PG8_SA(1, 1), a1, va[1]); PG8_MMA8(0, 0); PG8_BAR; PG8_SCHED;
            { unsigned vt[2][2]; int sR[2], sC[2]; const int tz = wid * 64 + fresh_lane(); const bool sw = last && has_next;
_Pragma("unroll") for (int i = 0; i < 2; ++i) stage_rc(tz * 16 + i * 8192, sR[i], sC[i]);
              PG8_AOFF1(vt, nxt, ui & 1);
_Pragma("unroll") for (int h = 0; h < 2; ++h) _Pragma("unroll") for (int i = 0; i < 2; ++i) va[h][i] = sw ? vt[h][i] : va[h][i]; }
            PG8_LDA1(Aa, 0, 1, 0); PG8_LDA1(Ab, 0, 1, 1);
            PG8_WAIT_V(2); PG8_WAIT_L(0); PG8_BAR; PG8_STAGE_A8(PG8_SB(0, 0), b2, voffB); PG8_STAGE_A8(PG8_SB(0, 1), b2 + hstepB, voffB); PG8_STAGE_A8(PG8_SA(0, 0), a2, va[0]); PG8_MMA8(1, 0); PG8_BAR; PG8_SCHED;
            PG8_LDA1(Aa, 1, 0, 0); PG8_LDA1(Ab, 1, 0, 1); PG8_LDB(B0, 1, 0); PG8_LDB(B1, 1, 1);
            PG8_WAIT_V(6); PG8_WAIT_L(0); PG8_BAR; PG8_STAGE_A8(PG8_SA(0, 1), a2, va[1]); PG8_MMA8(0, 1); PG8_BAR; PG8_SCHED;
            PG8_LDA1(Aa, 1, 1, 0); PG8_LDA1(Ab, 1, 1, 1);
            PG8_WAIT_V(2); PG8_WAIT_L(0); PG8_BAR; PG8_STAGE_A8(PG8_SB(1, 0), b3, voffB); PG8_STAGE_A8(PG8_SB(1, 1), b3 + hstepB, voffB); PG8_STAGE_A8(PG8_SA(1, 0), a3, va[0]); PG8_MMA8(1, 1); PG8_BAR; PG8_SCHED;
        }
        if (wr == 0) PG8_BAR;
        asm volatile("s_nop 15\n\ts_nop 15" : "+v"(acc[1][1][3][1]), "+v"(acc[1][0][3][1]));
        E(acc, cur, wr, wc, fr, fq);
        if (!has_next) break;
#pragma unroll
        for (int a = 0; a < 2; ++a)
#pragma unroll
            for (int b = 0; b < 2; ++b)
#pragma unroll
                for (int m = 0; m < 4; ++m)
#pragma unroll
                    for (int n = 0; n < 2; ++n) acc[a][b][m][n] = (f32x4){0.f, 0.f, 0.f, 0.f};
        cur = nxt; cB = nB; ++ui;
        if (wr == 1) PG8_BAR;
    }
    PG8_WAIT_V(0);
    PG8_BAR;
#undef PG8_STAGE_A8
#undef PG8_MMA8
#undef PG8_MM1
#undef PG8_LDA1
}
#undef PG8_SA
#undef PG8_SB
#undef PG8_STAGE
#undef PG8_STAGEX
#undef PG8_STAGE_A
#undef PG8_LDA
#undef PG8_LDB
#undef PG8_MMA
#undef PG8_MMAF
#undef PG8_WAIT_V
#undef PG8_WAIT_L
#undef PG8_BAR
#undef PG8_SCHED
#undef PG8_AOFF0
#undef PG8_AOFF1

struct DenseOrder {
    int nM, nN, nwg, G, c; const bf16_t* Bt; int K; const float* Wf;
    int mode;
    __device__ __forceinline__ void init(int M, int N, int G_, int c_, const bf16_t* Bt_, int K_, const float* Wf_ = nullptr, int mode_ = 0) { nM = M / BM; nN = N / BM; nwg = nM * nN; G = G_; c = c_; Bt = Bt_; K = K_; Wf = Wf_; mode = mode_; }
    __device__ __forceinline__ bool next(int i, Unit& u) const {
        const int full = (nwg / G) * G, rem = nwg - full; const bool use_half = rem > 0 && 2 * rem <= G;
        long L = (long)i * G + c; int hn = 0;
        if (mode == 2) { if (!use_half || L >= 2 * rem) return false; hn = (int)(L & 1); L = full + (L >> 1); }
        else if (L >= ((mode == 1 && use_half) ? full : nwg)) return false;
        const int wgid = xcd_remap((int)L, nwg);
        const int nig = 8 * nN, gid = wgid / nig, fm = gid * 8, gsz = (nM - fm) < 8 ? (nM - fm) : 8;
        u.pm = fm + ((wgid % nig) % gsz); u.pn = (wgid % nig) / gsz; u.e = 0; u.lm = u.pm; u.aux = 0; u.hn = hn; return true;
    }
    __device__ __forceinline__ int arow0(const Unit& u, int r) const { return u.pm * BM + r; }
    __device__ __forceinline__ int arow1(const Unit& u, int r, int, PG8_LAS unsigned char*) const { return u.pm * BM + r; }
    __device__ __forceinline__ void prefetch(const Unit&, int, PG8_LAS unsigned char*, int, int) const {}
    __device__ __forceinline__ void round_sync(int, int, int) const {}
    __device__ __forceinline__ const char* bbase(const Unit& u) const { if (Wf) return (const char*)Wf + ((size_t)u.pn * BM + (size_t)u.hn * HALF) * 4; return (const char*)Bt + ((size_t)u.pn * BM + (size_t)u.hn * HALF) * K * 2; }
    __device__ __forceinline__ const char* wbbase(const Unit& u) const { return (const char*)Bt + (size_t)u.pn * BM * K * 2; }
};

struct EpiBf16 {
    static constexpr bool PERM = true;
    bf16_t* O; int ldc; int ocol0; const float* cscale;
    __device__ __forceinline__ void operator()(const f32x4 (&acc)[2][2][4][2], const Unit& u, int wr, int wc, int fr, int fq) const { apply<2>(acc, u, wr, wc, fr, fq, 0); }
    __device__ __forceinline__ void half(const f32x4 (&acc)[2][2][4][2], const Unit& u, int wr, int wc, int fr, int fq) const { apply<1>(acc, u, wr, wc, fr, fq, u.hn * HALF); }
    template <int NBJ> __device__ __forceinline__ void apply(const f32x4 (&acc)[2][2][4][2], const Unit& u, int wr, int wc, int fr, int fq, int cofs) const {
        const int row0 = u.pm * BM + wr * 64 + fr; const int col0 = u.pn * BM + cofs + wc * 32 + 8 * fq;
        f32x4 sv[2][2];
#pragma unroll
        for (int bj = 0; bj < NBJ; ++bj)
#pragma unroll
            for (int n = 0; n < 2; ++n) sv[bj][n] = cscale ? *(const f32x4*)(cscale + col0 + bj * HALF + 4 * n) : (f32x4){1.f, 1.f, 1.f, 1.f};
#pragma unroll
        for (int ai = 0; ai < 2; ++ai)
#pragma unroll
            for (int m = 0; m < 4; ++m) { bf16_t* rowp = O + (size_t)(row0 + ai * HALF + m * 16) * ldc + ocol0 + col0;
#pragma unroll
                for (int bj = 0; bj < NBJ; ++bj) { const f32x4 v0 = acc[ai][bj][m][0] * sv[bj][0], v1 = acc[ai][bj][m][1] * sv[bj][1];
                    u32x4 w; w.x = cvt_pk_bf16(v0[0], v0[1]); w.y = cvt_pk_bf16(v0[2], v0[3]); w.z = cvt_pk_bf16(v1[0], v1[1]); w.w = cvt_pk_bf16(v1[2], v1[3]);
                    *(u32x4*)(rowp + bj * HALF) = w; } }
    }
};
struct EpiF32 {
    static constexpr bool PERM = false;
    float* C; int ldc;
    __device__ __forceinline__ void operator()(const f32x4 (&acc)[2][2][4][2], const Unit& u, int wr, int wc, int fr, int fq) const {
        const int row0 = u.pm * BM + wr * 64 + fr, col0 = u.pn * BM + wc * 32 + 4 * fq;
#pragma unroll
        for (int ai = 0; ai < 2; ++ai)
#pragma unroll
            for (int m = 0; m < 4; ++m) { float* rowp = C + (size_t)(row0 + ai * HALF + m * 16) * ldc + col0;
#pragma unroll
                for (int bj = 0; bj < 2; ++bj)
#pragma unroll
                    for (int n = 0; n < 2; ++n) *(f32x4*)(rowp + bj * HALF + n * 16) = acc[ai][bj][m][n]; }
    }
};
__device__ __forceinline__ float swiglu1(float g, float l) {
    const float gl = fminf(g, 7.0f), li = fminf(fmaxf(l, -7.0f), 7.0f);
    const float sg = __builtin_amdgcn_rcpf(1.0f + __builtin_amdgcn_exp2f(-1.702f * 1.4426950408889634f * gl));
    return gl * sg * (li + 1.0f);
}
template <int KNOB> struct EpiSwigluT {
    static constexpr bool PERM = true;
    bf16_t* O; const float* bias;
    __device__ __forceinline__ void operator()(const f32x4 (&acc)[2][2][4][2], const Unit& u, int wr, int wc, int fr, int fq) const { apply<2>(acc, u, wr, wc, fr, fq, 0); }
    __device__ __forceinline__ void half(const f32x4 (&acc)[2][2][4][2], const Unit& u, int wr, int wc, int fr, int fq) const { apply<1>(acc, u, wr, wc, fr, fq, u.hn * HALF); }
    template <int NBJ> __device__ __forceinline__ void apply(const f32x4 (&acc)[2][2][4][2], const Unit& u, int wr, int wc, int fr, int fq, int cofs) const {
        const int row0 = u.pm * BM + wr * 64 + fr; const int col0 = u.pn * BM + cofs + wc * 32 + 8 * fq;
        const float* bp = bias + (size_t)u.e * 4096 + col0;
        f32x4 bv[2][2];
#pragma unroll
        for (int bj = 0; bj < NBJ; ++bj)
#pragma unroll
            for (int n = 0; n < 2; ++n) bv[bj][n] = *(const f32x4*)(bp + bj * HALF + 4 * n);
#pragma unroll
        for (int ai = 0; ai < 2; ++ai)
#pragma unroll
            for (int m = 0; m < 4; ++m) { bf16_t* rowp = O + (size_t)(row0 + ai * HALF + m * 16) * 2048 + (col0 >> 1);
#pragma unroll
                for (int bj = 0; bj < NBJ; ++bj) { const f32x4 v0 = acc[ai][bj][m][0] + bv[bj][0], v1 = acc[ai][bj][m][1] + bv[bj][1];
#if 0
                    u32x2 w; w.x = cvt_pk_bf16(v0[0] + v0[1], v0[2] + v0[3]); w.y = cvt_pk_bf16(v1[0] + v1[1], v1[2] + v1[3]);
#else
                    u32x2 w; w.x = cvt_pk_bf16(swiglu1(v0[0], v0[1]), swiglu1(v0[2], v0[3])); w.y = cvt_pk_bf16(swiglu1(v1[0], v1[1]), swiglu1(v1[2], v1[3]));
#endif
                    if (KNOB == 2) { w.x = cvt_pk_bf16(v0[0] + v0[1], v0[2] + v0[3]); w.y = cvt_pk_bf16(v1[0] + v1[1], v1[2] + v1[3]); }
                    if (KNOB != 1 || u.aux < 0) *(u32x2*)(rowp + bj * (HALF / 2)) = w; } }
    }
};
typedef EpiSwigluT<0> EpiSwiglu;
struct EpiDown {
    static constexpr bool PERM = true;
    bf16_t* O; const float* bias; const float* gate;
    __device__ __forceinline__ void operator()(const f32x4 (&acc)[2][2][4][2], const Unit& u, int wr, int wc, int fr, int fq) const { apply<2>(acc, u, wr, wc, fr, fq, 0); }
    __device__ __forceinline__ void half(const f32x4 (&acc)[2][2][4][2], const Unit& u, int wr, int wc, int fr, int fq) const { apply<1>(acc, u, wr, wc, fr, fq, u.hn * HALF); }
    template <int NBJ> __device__ __forceinline__ void apply(const f32x4 (&acc)[2][2][4][2], const Unit& u, int wr, int wc, int fr, int fq, int cofs) const {
        const int lrow0 = u.lm * BM + wr * 64 + fr;
        const int row0 = u.pm * BM + wr * 64 + fr; const int col0 = u.pn * BM + cofs + wc * 32 + 8 * fq;
        const float* bp = bias + (size_t)u.e * 2048 + col0; const float* gp = gate + (size_t)u.e * 8192 + lrow0;
        f32x4 bv[2][2];
#pragma unroll
        for (int bj = 0; bj < NBJ; ++bj)
#pragma unroll
            for (int n = 0; n < 2; ++n) bv[bj][n] = *(const f32x4*)(bp + bj * HALF + 4 * n);
#pragma unroll
        for (int ai = 0; ai < 2; ++ai)
#pragma unroll
            for (int m = 0; m < 4; ++m) { bf16_t* rowp = O + (size_t)(row0 + ai * HALF + m * 16) * 2048 + col0; const float gt = gp[ai * HALF + m * 16];
#pragma unroll
                for (int bj = 0; bj < NBJ; ++bj) { const f32x4 v0 = (acc[ai][bj][m][0] + bv[bj][0]) * gt, v1 = (acc[ai][bj][m][1] + bv[bj][1]) * gt;
                    u32x4 w; w.x = cvt_pk_bf16(v0[0], v0[1]); w.y = cvt_pk_bf16(v0[2], v0[3]); w.z = cvt_pk_bf16(v1[0], v1[1]); w.w = cvt_pk_bf16(v1[2], v1[3]);
                    *(u32x4*)(rowp + bj * HALF) = w; } }
    }
};
struct EpiSwiglu8 {
    static constexpr bool PERM = true;
    unsigned char* O; const float* bias; float sc; PG8_LAS unsigned char* lds;
    __device__ __forceinline__ void prefetch(const Unit& u, int par, PG8_LAS unsigned char* l, int wid, int) const {
        const int lane = fresh_lane();
        if (wid < 4) __builtin_amdgcn_global_load_lds((const unsigned*)(bias + (size_t)u.e * 4096 + u.pn * BM + wid * 64 + lane), (PG8_LAS unsigned*)(l + 131072 + par * 1024 + wid * 256), 4, 0, 0);
    }
    __device__ __forceinline__ void operator()(const f32x4 (&acc)[2][2][4][2], const Unit& u, int wr, int wc, int fr, int fq) const { apply<2>(acc, u, wr, wc, fr, fq, 0); }
    __device__ __forceinline__ void half(const f32x4 (&acc)[2][2][4][2], const Unit& u, int wr, int wc, int fr, int fq) const { apply<1>(acc, u, wr, wc, fr, fq, u.hn * HALF); }
    template <int NBJ> __device__ __forceinline__ void apply(const f32x4 (&acc)[2][2][4][2], const Unit& u, int wr, int wc, int fr, int fq, int cofs) const {
        const int row0 = u.pm * BM + wr * 64 + fr; const int col0 = u.pn * BM + cofs + wc * 32 + 8 * fq;
        const PG8_LAS float* bp = (const PG8_LAS float*)(lds + 131072 + u.par * 1024) + cofs + wc * 32 + 8 * fq;
        f32x4 bv[2][2];
#pragma unroll
        for (int bj = 0; bj < NBJ; ++bj)
#pragma unroll
            for (int n = 0; n < 2; ++n) bv[bj][n] = *(const PG8_LAS f32x4*)(bp + bj * HALF + 4 * n);
#pragma unroll
        for (int ai = 0; ai < 2; ++ai)
#pragma unroll
            for (int m = 0; m < 4; ++m) { unsigned char* rowp = O + (size_t)(row0 + ai * HALF + m * 16) * 2048 + (col0 >> 1);
#pragma unroll
                for (int bj = 0; bj < NBJ; ++bj) { const f32x4 v0 = acc[ai][bj][m][0] * sc + bv[bj][0], v1 = acc[ai][bj][m][1] * sc + bv[bj][1];
                    int w = __builtin_amdgcn_cvt_pk_fp8_f32(swiglu1(v0[0], v0[1]), swiglu1(v0[2], v0[3]), 0, false);
                    w = __builtin_amdgcn_cvt_pk_fp8_f32(swiglu1(v1[0], v1[1]), swiglu1(v1[2], v1[3]), w, true);
                    *(int*)(rowp + bj * (HALF / 2)) = w; } }
    }
};
struct EpiDown8 {
    static constexpr bool PERM = true;
    bf16_t* O; const float* bias; const float* gate; float sc; PG8_LAS unsigned char* lds;
    __device__ __forceinline__ void prefetch(const Unit& u, int par, PG8_LAS unsigned char* l, int wid, int) const {
        const int lane = fresh_lane();
        if (wid < 4) __builtin_amdgcn_global_load_lds((const unsigned*)(bias + (size_t)u.e * 2048 + u.pn * BM + wid * 64 + lane), (PG8_LAS unsigned*)(l + 131072 + par * 1024 + wid * 256), 4, 0, 0);
        else __builtin_amdgcn_global_load_lds((const unsigned*)(gate + (size_t)u.e * 8192 + u.lm * BM + (wid - 4) * 64 + lane), (PG8_LAS unsigned*)(l + 133120 + par * 1024 + (wid - 4) * 256), 4, 0, 0);
    }
    __device__ __forceinline__ void operator()(const f32x4 (&acc)[2][2][4][2], const Unit& u, int wr, int wc, int fr, int fq) const { apply<2>(acc, u, wr, wc, fr, fq, 0); }
    __device__ __forceinline__ void half(const f32x4 (&acc)[2][2][4][2], const Unit& u, int wr, int wc, int fr, int fq) const { apply<1>(acc, u, wr, wc, fr, fq, u.hn * HALF); }
    template <int NBJ> __device__ __forceinline__ void apply(const f32x4 (&acc)[2][2][4][2], const Unit& u, int wr, int wc, int fr, int fq, int cofs) const {
        const int lrow0 = u.lm * BM + wr * 64 + fr;
        const int row0 = u.pm * BM + wr * 64 + fr; const int col0 = u.pn * BM + cofs + wc * 32 + 8 * fq;
        const PG8_LAS float* bp = (const PG8_LAS float*)(lds + 131072 + u.par * 1024) + cofs + wc * 32 + 8 * fq; const PG8_LAS float* gp = (const PG8_LAS float*)(lds + 133120 + u.par * 1024) + wr * 64 + fr;
        f32x4 bv[2][2];
#pragma unroll
        for (int bj = 0; bj < NBJ; ++bj)
#pragma unroll
            for (int n = 0; n < 2; ++n) bv[bj][n] = *(const PG8_LAS f32x4*)(bp + bj * HALF + 4 * n);
#pragma unroll
        for (int ai = 0; ai < 2; ++ai)
#pragma unroll
            for (int m = 0; m < 4; ++m) { bf16_t* rowp = O + (size_t)(row0 + ai * HALF + m * 16) * 2048 + col0; const float gt = gp[ai * HALF + m * 16];
#pragma unroll
                for (int bj = 0; bj < NBJ; ++bj) { const f32x4 v0 = (acc[ai][bj][m][0] * sc + bv[bj][0]) * gt, v1 = (acc[ai][bj][m][1] * sc + bv[bj][1]) * gt;
                    u32x4 w; w.x = cvt_pk_bf16(v0[0], v0[1]); w.y = cvt_pk_bf16(v0[2], v0[3]); w.z = cvt_pk_bf16(v1[0], v1[1]); w.w = cvt_pk_bf16(v1[2], v1[3]);
                    *(u32x4*)(rowp + bj * HALF) = w; } }
    }
};
}
namespace fk {
constexpr int NWAVES = 8, NTHR = 512;
constexpr int S_ = 2048, D_ = 2048, T_ = 8192, INW = 5120, RW = 1024, NH = 8, DH = 128, NE = 32, FF = 2048, NCH = 16;
constexpr float ALPHA = 1.189207115002721f;
constexpr float LOG2E = 1.4426950408889634f;

constexpr size_t MiB = 1ull << 20;
constexpr size_t WS_CTL = 0, CTL_ZERO_BYTES = 1 * MiB;
constexpr size_t WS_WIN_T = 2 * MiB, WS_WOUT_T = 22 * MiB, WS_POOLW_T = 30 * MiB, WS_ROPE = 31 * MiB, WS_XB = 32 * MiB, WS_PROJB = 64 * MiB,
                 WS_KVT = 144 * MiB, WS_PB = 176 * MiB, WS_MIXEDB = 192 * MiB, WS_MIX = 224 * MiB, WS_H = 288 * MiB, WS_HB = 352 * MiB,
                 WS_STOK = 384 * MiB, WS_SGATE = 385 * MiB, WS_TOKE = 386 * MiB, WS_TOKR = 387 * MiB, WS_ACTB = 392 * MiB, WS_OUTS = 552 * MiB,
                 WS_WGU_T = 768 * MiB, WS_WD_T = 1280 * MiB, WS_END = 1536 * MiB;
constexpr size_t WS_HB8 = 768 * MiB, WS_ACT8 = 800 * MiB, WS_WGU8 = 1024 * MiB, WS_WD8 = 1280 * MiB;
constexpr int PAD_ROWS = 40960;
constexpr int CW_TMO = 0, CW_CODE = 1, CW_BAR = 4096, CW_CNT = 8192, CW_XSYNC = 12288;

constexpr int RING_BYTES = 131072;
constexpr int RT_LD = 136, RT_BYTES = 128 * RT_LD * 2;
constexpr int REG0 = 0, REG1 = RT_BYTES, REG2 = 2 * RT_BYTES, REG3 = 3 * RT_BYTES;
constexpr int LDSCTL_OFF = 4 * RT_BYTES;
constexpr int MISC_OFF = LDSCTL_OFF, TS_OFF = LDSCTL_OFF + 256, TOKBUF_OFF = LDSCTL_OFF + 1024, EX_OFF = LDSCTL_OFF + 3072;
constexpr int LDS_BYTES = 147456;
static_assert(LDSCTL_OFF >= RING_BYTES && EX_OFF + 2048 <= LDS_BYTES, "LDS map");

#define GAS __attribute__((address_space(1)))
#define LAS __attribute__((address_space(3)))
typedef unsigned short bf16;
typedef unsigned v4u __attribute__((ext_vector_type(4)));
typedef unsigned v2u __attribute__((ext_vector_type(2)));
typedef float f32x4 __attribute__((ext_vector_type(4)));
typedef float f32x2 __attribute__((ext_vector_type(2)));
typedef short bf16x8 __attribute__((ext_vector_type(8)));
typedef GAS unsigned gu32;
#define RLX_AGENT __ATOMIC_RELAXED, __HIP_MEMORY_SCOPE_AGENT
#define LDS_WAIT() asm volatile("s_waitcnt lgkmcnt(0)" ::: "memory")
#define VM_WAIT() asm volatile("s_waitcnt vmcnt(0)" ::: "memory")
__device__ __forceinline__ unsigned f2bf(float f) { unsigned u = __builtin_bit_cast(unsigned, f); return (u + 0x7fffu + ((u >> 16) & 1u)) >> 16; }
__device__ __forceinline__ unsigned pk2(float lo, float hi) { unsigned r; asm("v_cvt_pk_bf16_f32 %0, %1, %2" : "=v"(r) : "v"(lo), "v"(hi)); return r; }
__device__ __forceinline__ float bflo(unsigned w) { return __builtin_bit_cast(float, w << 16); }
__device__ __forceinline__ float bfhi(unsigned w) { return __builtin_bit_cast(float, w & 0xffff0000u); }

#define XB_TMO      128
#define XB_XCNT(j)  (256  + 64 * (j))
#define XB_XSUB(j)  (1280 + 64 * (j))
#define XB_XGEN(j)  (2304 + 64 * (j))
#define XB_TOP      3328
#define XB_TOPGEN   3392
#define XCD_BAR_WORDS 3456
#define XB_SPIN_CAP (1u << 18)
__device__ __forceinline__ unsigned xb_ld(unsigned* p)              { return __hip_atomic_load(p, __ATOMIC_RELAXED, __HIP_MEMORY_SCOPE_AGENT); }
__device__ __forceinline__ unsigned xb_add(unsigned* p, unsigned v) { return __hip_atomic_fetch_add(p, v, __ATOMIC_RELAXED, __HIP_MEMORY_SCOPE_AGENT); }
__device__ __forceinline__ unsigned xb_xcc_id() { return (unsigned)__builtin_amdgcn_s_getreg((3 << 11) | 20) & 0xFu; }
#define XB_SPIN(cond, bar) do { unsigned _sp = 0; while (cond) { __builtin_amdgcn_s_sleep(1); \
    if ((++_sp & 255u) == 0u) { if (xb_ld(&(bar)[XB_TMO])) break; if (_sp > XB_SPIN_CAP) { atomicAdd(&(bar)[XB_TMO], 1u); break; } } } } while (0)
struct XcdBarrier { unsigned* bar; unsigned x; volatile LAS unsigned* st; int wave; };
__device__ __forceinline__ XcdBarrier xcd_barrier_post(unsigned* bar, volatile LAS unsigned* st) {
    XcdBarrier b; b.bar = bar; b.x = xb_xcc_id(); b.st = st; b.wave = __builtin_amdgcn_readfirstlane(threadIdx.x >> 6);
    if (threadIdx.x == 0) st[2] = xb_add(&bar[XB_XCNT(b.x)], 1u);
    return b;
}
__device__ __forceinline__ void xcd_barrier_complete(unsigned* bar, unsigned x, unsigned& nloc, unsigned& nx) {
    const unsigned G = gridDim.x * gridDim.y * gridDim.z;
    unsigned sum, cnt, mine, sp = 0u;
    for (;;) {
        sum = 0u; cnt = 0u; mine = 0u;
#pragma unroll
        for (unsigned j = 0; j < 16; ++j) { const unsigned c = xb_ld(&bar[XB_XCNT(j)]); sum += c; cnt += (c > 0u) ? 1u : 0u; mine = (j == x) ? c : mine; }
        if (sum == G) break;
        __builtin_amdgcn_s_sleep(1);
        if ((++sp & 255u) == 0u) { if (xb_ld(&bar[XB_TMO])) break; if (sp > XB_SPIN_CAP) { atomicAdd(&bar[XB_TMO], 1u); break; } }
    }
    nloc = mine > 0u ? mine : 1u; nx = cnt > 0u ? cnt : 1u;
}
__device__ __forceinline__ void xcd_barrier(const XcdBarrier& b) {
    asm volatile("s_waitcnt vmcnt(0)" ::: "memory");
    __syncthreads();
    if (b.wave == 0 && pg8::fresh_lane() == 0) {
        unsigned* bar = b.bar;
        __builtin_amdgcn_s_waitcnt(0);
        unsigned nloc = b.st[0], nx = b.st[1];
        if (nloc == 0u) { xcd_barrier_complete(bar, b.x, nloc, nx); b.st[0] = nloc; b.st[1] = nx; }
        const unsigned old = xb_add(&bar[XB_XSUB(b.x)], 1u);
        const unsigned gen = old / nloc;
        if (old + 1u == (gen + 1u) * nloc) {
            __builtin_amdgcn_fence(__ATOMIC_RELEASE, "agent");
            asm volatile("s_waitcnt vmcnt(0)" ::: "memory");
            const unsigned og = xb_add(&bar[XB_TOP], 1u);
            const unsigned tg = og / nx;
            if (og + 1u == (tg + 1u) * nx) xb_add(&bar[XB_TOPGEN], 1u);
            else XB_SPIN(xb_ld(&bar[XB_TOPGEN]) == tg, bar);
            __builtin_amdgcn_fence(__ATOMIC_ACQUIRE, "agent");
            xb_add(&bar[XB_XGEN(b.x)], 1u);
            asm volatile("s_waitcnt vmcnt(0)" ::: "memory");
        } else {
            XB_SPIN(xb_ld(&bar[XB_XGEN(b.x)]) == gen, bar);
            __builtin_amdgcn_fence(__ATOMIC_ACQUIRE, "agent");
            asm volatile("s_waitcnt vmcnt(0)" ::: "memory");
        }
    }
    __syncthreads();
}

struct Frame {
    LAS unsigned char* lds;
    unsigned* ctl;
    int wave, G, bx, cntoff;
    const float *x, *w_in, *gn_gain, *pool_w, *pool_scale, *w_out, *ln1g, *ln1b, *rw, *rb, *wgu, *bgu, *wd, *bd, *ln2g, *ln2b;
    float* out;
    bf16 *WinT, *WoutT, *PoolT, *XB, *PROJB, *PB, *MIXEDB, *HB, *ACTB, *OUTS, *WguT, *WdT;
    float *ROPE, *KVT, *MIX, *H, *SGATE;
    int *STOK, *TOKE, *TOKR;
    unsigned char *HB8, *ACT8, *Wgu8, *Wd8;
};
__device__ __forceinline__ float wave_sum(float v) {
#pragma unroll
    for (int o = 1; o < 64; o <<= 1) v += __shfl_xor(v, o);
    return v;
}

__device__ __forceinline__ void p0_transpose_item(const float* W, int K, int N, bf16* WT, int item, int wave, int lane) {
    const int nblk = N / 256, kb = item / nblk, nb = item % nblk, k0 = 64 * kb, n0 = 256 * nb;
    const int n4 = (lane & 15) + 16 * (wave & 3), kq = (lane >> 4) + 4 * (wave >> 2);
    const float* src = W + (size_t)(k0 + kq * 8) * N + n0 + 4 * n4;
    f32x4 r[8];
#pragma unroll
    for (int q = 0; q < 8; ++q) r[q] = *(const GAS f32x4*)(src + (size_t)q * N);
    bf16* dst = WT + (size_t)(n0 + 4 * n4) * K + k0 + kq * 8;
#pragma unroll
    for (int c = 0; c < 4; ++c) { v4u o; o.x = pk2(r[0][c], r[1][c]); o.y = pk2(r[2][c], r[3][c]); o.z = pk2(r[4][c], r[5][c]); o.w = pk2(r[6][c], r[7][c]);
        *(GAS v4u*)(dst + (size_t)c * K) = o; }
}
__device__ __forceinline__ void p0_cvt8_load(const float* W, int N, int item, int wave, int lane, f32x4 (&r)[8]) {
    const int nblk = N / 128, kb = item / nblk, nb = item % nblk;
    const int n4 = (lane & 15) + 16 * (wave & 1), kq = (lane >> 4) + 4 * (wave >> 1);
    const float* src = W + (size_t)(128 * kb + kq * 8) * N + 128 * nb + 4 * n4;
#pragma unroll
    for (int q = 0; q < 8; ++q) r[q] = __builtin_nontemporal_load((const GAS f32x4*)(src + (size_t)q * N));
}
__device__ __forceinline__ void p0_cvt8_store(unsigned char* WT, int K, int N, int item, int wave, int lane, const f32x4 (&r)[8], float scale) {
    const int nblk = N / 128, kb = item / nblk, nb = item % nblk;
    const int n4 = (lane & 15) + 16 * (wave & 1), kq = (lane >> 4) + 4 * (wave >> 1);
    unsigned char* dst = WT + (size_t)(128 * nb + 4 * n4) * K + 128 * kb + kq * 8;
#pragma unroll
    for (int c = 0; c < 4; ++c) {
        int lo = __builtin_amdgcn_cvt_pk_fp8_f32(r[0][c] * scale, r[1][c] * scale, 0, false); lo = __builtin_amdgcn_cvt_pk_fp8_f32(r[2][c] * scale, r[3][c] * scale, lo, true);
        int hi = __builtin_amdgcn_cvt_pk_fp8_f32(r[4][c] * scale, r[5][c] * scale, 0, false); hi = __builtin_amdgcn_cvt_pk_fp8_f32(r[6][c] * scale, r[7][c] * scale, hi, true);
        *(GAS v2u*)(dst + (size_t)c * K) = (v2u){(unsigned)lo, (unsigned)hi}; }
}
__device__ __forceinline__ void p0_cvt8_experts(const float* W, unsigned char* WT, int N, int bx, int G, int wave, int lane) {
    const int per = (D_ / 128) * (N / 128), total = 32 * per;
    for (int it = bx; it < total; it += 2 * G) {
        const int it2 = it + G; const bool two = it2 < total;
        const int e0 = it / per, i0 = it % per, e1 = two ? it2 / per : e0, i1 = two ? it2 % per : i0;
        f32x4 r0[8], r1[8];
        p0_cvt8_load(W + (size_t)e0 * D_ * N, N, i0, wave, lane, r0);
        p0_cvt8_load(W + (size_t)e1 * D_ * N, N, i1, wave, lane, r1);
        p0_cvt8_store(WT + (size_t)e0 * D_ * N, D_, N, i0, wave, lane, r0, 64.0f);
        if (two) p0_cvt8_store(WT + (size_t)e1 * D_ * N, D_, N, i1, wave, lane, r1, 64.0f);
    }
}
__device__ __forceinline__ void p0_prologue(Frame& F) {
    const int lane = pg8::fresh_lane(), tid = F.wave * 64 + lane;
    constexpr int I_IN = (D_ / 64) * (INW / 256);
    for (int it = F.bx; it < I_IN; it += F.G) p0_transpose_item(F.w_in, D_, INW, F.WinT, it, F.wave, lane);
    const int gt = F.bx * NTHR + tid, NGT = F.G * NTHR;
    for (int i = gt; i < T_ * D_ / 8; i += NGT) {
        const f32x4 a = *(const GAS f32x4*)(F.x + (size_t)i * 8), b = *(const GAS f32x4*)(F.x + (size_t)i * 8 + 4);
        v4u o; o.x = pk2(a.x, a.y); o.y = pk2(a.z, a.w); o.z = pk2(b.x, b.y); o.w = pk2(b.z, b.w);
        *(GAS v4u*)(F.XB + (size_t)i * 8) = o;
    }
}
__device__ __forceinline__ void p0_late(Frame& F, int r, int nw) {
    const int lane = pg8::fresh_lane(), tid = F.wave * 64 + lane;
    constexpr int I_OUT = (D_ / 64) * (D_ / 256), I_POOL = 4 * (256 / 64);
    for (int it = r; it < I_OUT + I_POOL; it += nw) {
        if (it < I_OUT) { p0_transpose_item(F.w_out, D_, D_, F.WoutT, it, F.wave, lane); continue; }
        const int q = it - I_OUT, g = q >> 2; p0_transpose_item(F.pool_w + (size_t)g * 65536, 256, 256, F.PoolT + (size_t)g * 65536, q & 3, F.wave, lane);
    }
    for (int i = r * NTHR + tid; i < S_ * 64; i += nw * NTHR) {
        const int pos = i >> 6, fi = i & 63;
        const float inv = powf(10000.0f, -(float)fi / 64.0f);
        float sn, cs; sincosf((float)pos * inv, &sn, &cs);
        *(GAS f32x2*)(F.ROPE + (size_t)i * 2) = (f32x2){cs, sn};
    }
}

__device__ __forceinline__ void rt_mma128(f32x4 (&acc)[2][4], const LAS unsigned char* Mop, const LAS unsigned char* Nop, int m0, int n0, int fr, int fq) {
#pragma unroll
    for (int ks = 0; ks < 4; ++ks) {
        bf16x8 a[2], b[4];
#pragma unroll
        for (int mi = 0; mi < 2; ++mi) a[mi] = *(const LAS bf16x8*)(Mop + ((m0 + mi * 16 + fr) * RT_LD + ks * 32 + fq * 8) * 2);
#pragma unroll
        for (int ni = 0; ni < 4; ++ni) b[ni] = *(const LAS bf16x8*)(Nop + ((n0 + ni * 16 + fr) * RT_LD + ks * 32 + fq * 8) * 2);
#pragma unroll
        for (int mi = 0; mi < 2; ++mi)
#pragma unroll
            for (int ni = 0; ni < 4; ++ni) acc[mi][ni] = __builtin_amdgcn_mfma_f32_16x16x32_bf16(b[ni], a[mi], acc[mi][ni], 0, 0, 0);
    }
}
__device__ __forceinline__ void rt_stage_vt(Frame& F, int tid, LAS unsigned char* dst, int tok0, int h) {
    const int rp = tid & 63;
#pragma unroll
    for (int it = 0; it < 2; ++it) {
        const int cg = (tid >> 6) + 8 * it;
        const bf16* p = F.PROJB + (size_t)(tok0 + 2 * rp) * INW + 2 * RW + h * DH + cg * 8;
        const v4u a = *(const GAS v4u*)p, b = *(const GAS v4u*)(p + INW);
        const unsigned aw[4] = {a.x, a.y, a.z, a.w}, bw[4] = {b.x, b.y, b.z, b.w};
#pragma unroll
        for (int j = 0; j < 4; ++j) {
            *(LAS unsigned*)(dst + ((cg * 8 + 2 * j) * RT_LD + 2 * rp) * 2) = (aw[j] & 0xffffu) | (bw[j] << 16);
            *(LAS unsigned*)(dst + ((cg * 8 + 2 * j + 1) * RT_LD + 2 * rp) * 2) = (aw[j] >> 16) | (bw[j] & 0xffff0000u);
        }
    }
}
__device__ __forceinline__ void unpack8(const v4u v, float (&o)[8]) {
    o[0] = bflo(v.x); o[1] = bfhi(v.x); o[2] = bflo(v.y); o[3] = bfhi(v.y); o[4] = bflo(v.z); o[5] = bfhi(v.z); o[6] = bflo(v.w); o[7] = bfhi(v.w);
}
__device__ __forceinline__ void rot8(const float (&t1)[8], const float (&t2)[8], const float* rp, float sc, float (&o1)[8], float (&o2)[8]) {
#pragma unroll
    for (int q = 0; q < 4; ++q) { const f32x4 cs = *(const GAS f32x4*)(rp + 4 * q);
        o1[2 * q] = (t1[2 * q] * cs.x - t2[2 * q] * cs.y) * sc; o2[2 * q] = (t1[2 * q] * cs.y + t2[2 * q] * cs.x) * sc;
        o1[2 * q + 1] = (t1[2 * q + 1] * cs.z - t2[2 * q + 1] * cs.w) * sc; o2[2 * q + 1] = (t1[2 * q + 1] * cs.w + t2[2 * q + 1] * cs.z) * sc; }
}

__device__ __forceinline__ void r1_unit(Frame& F, int unit) {
    const int lane = pg8::fresh_lane(), tid = F.wave * 64 + lane;
    const int h = (unit >> 4) & 7, n = unit & 15, b = unit >> 7, tok0 = b * S_ + n * 128;
    const float log2g = log2f(1.0f - exp2f(-5.0f - (float)h));
    LAS unsigned char* ZKt = F.lds + REG1; LAS unsigned char* Vt = F.lds + REG2;
    {
        const int rp = tid & 63, ig = tid >> 6;
        float k1[2][8], k2[2][8];
#pragma unroll
        for (int rr = 0; rr < 2; ++rr) {
            const int r = 2 * rp + rr;
            const bf16* p = F.PROJB + (size_t)(tok0 + r) * INW + RW + h * DH + ig * 8;
            float t1[8], t2[8]; unpack8(*(const GAS v4u*)p, t1); unpack8(*(const GAS v4u*)(p + 64), t2);
            const float sc = 0.08838834764831845f * exp2f(log2g * (float)(127 - r));
            rot8(t1, t2, F.ROPE + (size_t)(n * 128 + r) * 128 + ig * 16, sc, k1[rr], k2[rr]);
        }
#pragma unroll
        for (int j = 0; j < 8; ++j) {
            *(LAS unsigned*)(ZKt + ((ig * 8 + j) * RT_LD + 2 * rp) * 2) = pk2(k1[0][j], k1[1][j]);
            *(LAS unsigned*)(ZKt + ((64 + ig * 8 + j) * RT_LD + 2 * rp) * 2) = pk2(k2[0][j], k2[1][j]);
        }
    }
    rt_stage_vt(F, tid, Vt, tok0, h);
    __syncthreads();
    const int fr = lane & 15, fq = lane >> 4, m0 = (F.wave >> 1) * 32, n0 = (F.wave & 1) * 64;
    f32x4 acc[2][4];
#pragma unroll
    for (int mi = 0; mi < 2; ++mi)
#pragma unroll
        for (int ni = 0; ni < 4; ++ni) acc[mi][ni] = (f32x4){0.f, 0.f, 0.f, 0.f};
    rt_mma128(acc, Vt, ZKt, m0, n0, fr, fq);
    bf16* dst = (bf16*)F.KVT + (size_t)unit * 16384;
    asm volatile("s_nop 15\n\ts_nop 15" : "+v"(acc[0][0]), "+v"(acc[0][1]), "+v"(acc[0][2]), "+v"(acc[0][3]), "+v"(acc[1][0]), "+v"(acc[1][1]), "+v"(acc[1][2]), "+v"(acc[1][3]));
#pragma unroll
    for (int mi = 0; mi < 2; ++mi)
#pragma unroll
        for (int ni = 0; ni < 4; ++ni) { v2u w; w.x = pk2(acc[mi][ni].x, acc[mi][ni].y); w.y = pk2(acc[mi][ni].z, acc[mi][ni].w);
            *(GAS v2u*)(dst + (m0 + mi * 16 + fr) * 128 + n0 + ni * 16 + fq * 4) = w; }
    __syncthreads();
}
template <int W> __device__ __forceinline__ void pool_item(Frame& F, int tok, int g, int cgl) {
    const int t = tok & (S_ - 1), c0 = g * 256 + cgl * 8;
    const bf16* up = F.PROJB + (size_t)tok * INW + 4 * RW + c0;
    v4u raw[W];
#pragma unroll
    for (int q = 0; q < W; ++q) { const int qq = q <= t ? q : 0; raw[q] = *(const GAS v4u*)(up - (size_t)qq * INW); }
    float s[8], u0[8];
    unpack8(raw[0], u0);
#pragma unroll
    for (int j = 0; j < 8; ++j) s[j] = u0[j];
#pragma unroll
    for (int q = 1; q < W; ++q) { float v[8]; unpack8(raw[q], v); const float wq = q <= t ? 1.0f : 0.0f;
#pragma unroll
        for (int j = 0; j < 8; ++j) s[j] = fmaf(wq, v[j], s[j]); }
    const float rn = 1.0f / (float)((t + 1 < W) ? t + 1 : W);
    v4u o; o.x = pk2(s[0] * rn - u0[0], s[1] * rn - u0[1]); o.y = pk2(s[2] * rn - u0[2], s[3] * rn - u0[3]);
    o.z = pk2(s[4] * rn - u0[4], s[5] * rn - u0[5]); o.w = pk2(s[6] * rn - u0[6], s[7] * rn - u0[7]);
    *(GAS v4u*)(F.PB + ((size_t)g * T_ + tok) * 256 + cgl * 8) = o;
}
__device__ __forceinline__ void pool_means(Frame& F) {
    const int gt = F.bx * NTHR + F.wave * 64 + pg8::fresh_lane(), NGT = F.G * NTHR;
    for (int it = gt; it < T_ * 128; it += NGT) {
        const int cgl = it & 31, tok = ((it >> 8) << 1) | ((it >> 5) & 1), g = __builtin_amdgcn_readfirstlane((it >> 6) & 3);
        if (g == 0) pool_item<2>(F, tok, 0, cgl); else if (g == 1) pool_item<4>(F, tok, 1, cgl); else if (g == 2) pool_item<8>(F, tok, 2, cgl); else pool_item<16>(F, tok, 3, cgl);
    }
}

__device__ __forceinline__ void r3_unit(Frame& F, int unit) {
    const int lane = pg8::fresh_lane(), tid = F.wave * 64 + lane;
    const int h = (unit >> 4) & 7, n = unit & 15, b = unit >> 7, tok0 = b * S_ + n * 128;
    const float log2g = log2f(1.0f - exp2f(-5.0f - (float)h));
    LAS unsigned char* Qs = F.lds + REG0; LAS unsigned char* Ks = F.lds + REG1; LAS unsigned char* Vt = F.lds + REG2; LAS unsigned char* Rt = F.lds + REG3;
    LAS float* EX = (LAS float*)(F.lds + EX_OFF);
#pragma unroll
    for (int it = 0; it < 2; ++it) {
        const int item = tid + 512 * it, r = item >> 3, ig = item & 7;
        const bf16* pq = F.PROJB + (size_t)(tok0 + r) * INW + h * DH + ig * 8;
        const float* rp = F.ROPE + (size_t)(n * 128 + r) * 128 + ig * 16;
        float t1[8], t2[8], o1[8], o2[8];
        unpack8(*(const GAS v4u*)pq, t1); unpack8(*(const GAS v4u*)(pq + 64), t2);
        rot8(t1, t2, rp, 1.0f, o1, o2);
        v4u w1, w2; w1.x = pk2(o1[0], o1[1]); w1.y = pk2(o1[2], o1[3]); w1.z = pk2(o1[4], o1[5]); w1.w = pk2(o1[6], o1[7]);
        w2.x = pk2(o2[0], o2[1]); w2.y = pk2(o2[2], o2[3]); w2.z = pk2(o2[4], o2[5]); w2.w = pk2(o2[6], o2[7]);
        *(LAS v4u*)(Qs + (r * RT_LD + ig * 8) * 2) = w1; *(LAS v4u*)(Qs + (r * RT_LD + 64 + ig * 8) * 2) = w2;
        unpack8(*(const GAS v4u*)(pq + RW), t1); unpack8(*(const GAS v4u*)(pq + RW + 64), t2);
        rot8(t1, t2, rp, 0.08838834764831845f, o1, o2);
        w1.x = pk2(o1[0], o1[1]); w1.y = pk2(o1[2], o1[3]); w1.z = pk2(o1[4], o1[5]); w1.w = pk2(o1[6], o1[7]);
        w2.x = pk2(o2[0], o2[1]); w2.y = pk2(o2[2], o2[3]); w2.z = pk2(o2[4], o2[5]); w2.w = pk2(o2[6], o2[7]);
        *(LAS v4u*)(Ks + (r * RT_LD + ig * 8) * 2) = w1; *(LAS v4u*)(Ks + (r * RT_LD + 64 + ig * 8) * 2) = w2;
    }
    rt_stage_vt(F, tid, Vt, tok0, h);
    {
        const float gch = exp2f(log2g * 128.0f);
        f32x4 R[8];
#pragma unroll
        for (int i = 0; i < 8; ++i) R[i] = (f32x4){0.f, 0.f, 0.f, 0.f};
        const bf16* src = (const bf16*)F.KVT + (size_t)(unit - n) * 16384 + tid * 4;
        int m = 0;
        for (; m + 1 < n; m += 2) {
            v2u w0[8], w1[8];
#pragma unroll
            for (int i = 0; i < 8; ++i) { w0[i] = *(const GAS v2u*)(src + (size_t)m * 16384 + i * 2048); w1[i] = *(const GAS v2u*)(src + (size_t)(m + 1) * 16384 + i * 2048); }
#pragma unroll
            for (int i = 0; i < 8; ++i) { const f32x4 v0 = (f32x4){bflo(w0[i].x), bfhi(w0[i].x), bflo(w0[i].y), bfhi(w0[i].y)}, v1 = (f32x4){bflo(w1[i].x), bfhi(w1[i].x), bflo(w1[i].y), bfhi(w1[i].y)};
                R[i] = (R[i] * gch + v0) * gch + v1; }
        }
        if (m < n) {
#pragma unroll
            for (int i = 0; i < 8; ++i) { const v2u w = *(const GAS v2u*)(src + (size_t)m * 16384 + i * 2048);
                const f32x4 v = (f32x4){bflo(w.x), bfhi(w.x), bflo(w.y), bfhi(w.y)}; R[i] = R[i] * gch + v; }
        }
#pragma unroll
        for (int i = 0; i < 8; ++i) { const int f = i * 512 + tid, e = f >> 5, d4 = (f & 31) * 4;
            v2u w; w.x = pk2(R[i].x, R[i].y); w.y = pk2(R[i].z, R[i].w);
            *(LAS v2u*)(Rt + (e * RT_LD + d4) * 2) = w; }
    }
    __syncthreads();
    const int fr = lane & 15, fq = lane >> 4, m0 = (F.wave >> 1) * 32, n0 = (F.wave & 1) * 64;
    f32x4 acc[2][4];
#pragma unroll
    for (int mi = 0; mi < 2; ++mi)
#pragma unroll
        for (int ni = 0; ni < 4; ++ni) acc[mi][ni] = (f32x4){0.f, 0.f, 0.f, 0.f};
    rt_mma128(acc, Qs, Ks, m0, n0, fr, fq);
    __syncthreads();
#pragma unroll
    for (int mi = 0; mi < 2; ++mi)
#pragma unroll
        for (int ni = 0; ni < 4; ++ni) {
            const int c = m0 + mi * 16 + fr, mm = n0 + ni * 16 + fq * 4;
            float v[4];
#pragma unroll
            for (int j = 0; j < 4; ++j) v[j] = (mm + j <= c) ? acc[mi][ni][j] * exp2f(-log2g * (float)(mm + j + 1)) : 0.f;
            v2u w; w.x = pk2(v[0], v[1]); w.y = pk2(v[2], v[3]);
            *(LAS v2u*)(Ks + (c * RT_LD + mm) * 2) = w;
            acc[mi][ni] = (f32x4){0.f, 0.f, 0.f, 0.f};
        }
    __syncthreads();
    rt_mma128(acc, Ks, Vt, m0, n0, fr, fq);
    rt_mma128(acc, Qs, Rt, m0, n0, fr, fq);
    float mean[2], rstd[2];
#pragma unroll
    for (int mi = 0; mi < 2; ++mi) {
        const int c = m0 + mi * 16 + fr; const float xi = exp2f(log2g * (float)(c + 1)); float s = 0.f;
#pragma unroll
        for (int ni = 0; ni < 4; ++ni) { acc[mi][ni] = acc[mi][ni] * xi; s += (acc[mi][ni].x + acc[mi][ni].y) + (acc[mi][ni].z + acc[mi][ni].w); }
        s += __shfl_xor(s, 16); s += __shfl_xor(s, 32);
        if (fq == 0) EX[c * 2 + (F.wave & 1)] = s;
    }
    __syncthreads();
#pragma unroll
    for (int mi = 0; mi < 2; ++mi) {
        const int c = m0 + mi * 16 + fr; mean[mi] = (EX[c * 2] + EX[c * 2 + 1]) * (1.0f / 128.0f); float q = 0.f;
#pragma unroll
        for (int ni = 0; ni < 4; ++ni) { const f32x4 d = acc[mi][ni] - mean[mi]; q += (d.x * d.x + d.y * d.y) + (d.z * d.z + d.w * d.w); }
        q += __shfl_xor(q, 16); q += __shfl_xor(q, 32);
        if (fq == 0) EX[256 + c * 2 + (F.wave & 1)] = q;
    }
    __syncthreads();
#pragma unroll
    for (int mi = 0; mi < 2; ++mi) {
        const int c = m0 + mi * 16 + fr; rstd[mi] = 1.0f / sqrtf((EX[256 + c * 2] + EX[256 + c * 2 + 1]) * (1.0f / 128.0f) + 1e-6f);
#pragma unroll
        for (int ni = 0; ni < 4; ++ni) {
            const int e = n0 + ni * 16 + fq * 4;
            const v2u gw = *(const GAS v2u*)(F.PROJB + (size_t)(tok0 + c) * INW + 3 * RW + h * DH + e);
            const f32x4 gain = *(const GAS f32x4*)(F.gn_gain + h * DH + e);
            const float g[4] = {bflo(gw.x), bfhi(gw.x), bflo(gw.y), bfhi(gw.y)};
            float o[4];
#pragma unroll
            for (int j = 0; j < 4; ++j) { const float sg = g[j] / (1.0f + __expf(-g[j])); o[j] = sg * ((acc[mi][ni][j] - mean[mi]) * rstd[mi] * gain[j]); }
            v2u w; w.x = pk2(o[0], o[1]); w.y = pk2(o[2], o[3]);
            *(GAS v2u*)(F.MIXEDB + (size_t)(tok0 + c) * D_ + h * DH + e) = w;
        }
    }
    __syncthreads();
}
struct PoolOrder {
    int G, c; const bf16* Bt;
    __device__ __forceinline__ bool next(int i, pg8::Unit& u) const { const int L = i * G + c; if (L >= 128) return false; u.pm = L >> 2; u.e = L & 3; u.pn = 0; u.lm = u.pm; u.aux = 0; u.hn = 0; return true; }
    __device__ __forceinline__ int arow0(const pg8::Unit& u, int r) const { return u.e * T_ + u.pm * 256 + r; }
    __device__ __forceinline__ int arow1(const pg8::Unit& u, int r, int, LAS unsigned char*) const { return u.e * T_ + u.pm * 256 + r; }
    __device__ __forceinline__ void prefetch(const pg8::Unit&, int, LAS unsigned char*, int, int) const {}
    __device__ __forceinline__ void round_sync(int, int, int) const {}
    __device__ __forceinline__ const char* bbase(const pg8::Unit& u) const { return (const char*)Bt + (size_t)u.e * 65536 * 2; }
};
struct EpiPool {
    static constexpr bool PERM = true;
    bf16* O; const float* cscale;
    __device__ __forceinline__ void operator()(const f32x4 (&acc)[2][2][4][2], const pg8::Unit& u, int wr, int wc, int fr, int fq) const {
        const int row0 = u.pm * 256 + wr * 64 + fr; const int col0 = u.e * 256 + wc * 32 + 8 * fq;
        f32x4 sv[2][2];
#pragma unroll
        for (int bj = 0; bj < 2; ++bj)
#pragma unroll
            for (int n = 0; n < 2; ++n) sv[bj][n] = *(const f32x4*)(cscale + col0 + bj * 128 + 4 * n);
#pragma unroll
        for (int ai = 0; ai < 2; ++ai)
#pragma unroll
            for (int m = 0; m < 4; ++m) { bf16* rowp = O + (size_t)(row0 + ai * 128 + m * 16) * D_ + RW + col0;
#pragma unroll
                for (int bj = 0; bj < 2; ++bj) { const f32x4 v0 = acc[ai][bj][m][0] * sv[bj][0], v1 = acc[ai][bj][m][1] * sv[bj][1];
                    v4u w; w.x = pg8::cvt_pk_bf16(v0[0], v0[1]); w.y = pg8::cvt_pk_bf16(v0[2], v0[3]); w.z = pg8::cvt_pk_bf16(v1[0], v1[1]); w.w = pg8::cvt_pk_bf16(v1[2], v1[3]);
                    *(v4u*)(rowp + bj * 128) = w; } }
    }
};

__device__ __forceinline__ void ln1_router(Frame& F) {
    const int lane_outer = pg8::fresh_lane();
    LAS float* HT = (LAS float*)F.lds;
    LAS float* PART = (LAS float*)(F.lds + 65536);
    LAS int* PK_E = (LAS int*)(F.lds + 65536 + 8192);
    LAS float* PK_G = (LAS float*)(F.lds + 65536 + 8192 + 512);
    LAS unsigned* HIST = (LAS unsigned*)(F.lds + 65536 + 8192 + 1024);
    if (F.wave == 0) HIST[lane_outer] = 0u;
    const int lane0 = lane_outer;
    int it = 0, ntok = 0, itbase = 0;
#define LN1_FLUSH() do { const int tid_ = F.wave * 64 + pg8::fresh_lane(); int e_ = 0, lr_ = 0; \
        if (tid_ < 128 && tid_ < 4 * ntok) { e_ = PK_E[tid_]; lr_ = (int)__hip_atomic_fetch_add((LAS unsigned*)&HIST[e_], 1u, __ATOMIC_RELAXED, __HIP_MEMORY_SCOPE_WORKGROUP); } \
        __syncthreads(); \
        if (tid_ < 32) { const unsigned c_ = HIST[tid_]; HIST[32 + tid_] = c_ ? __hip_atomic_fetch_add(F.ctl + F.cntoff + 64 * tid_, c_, RLX_AGENT) : 0u; } \
        __syncthreads(); \
        if (tid_ < 128 && tid_ < 4 * ntok) { \
            const int slot_ = tid_ >> 2, k_ = tid_ & 3, it_ = slot_ >> 3, w_ = slot_ & 7, tok_ = (F.bx + (itbase + it_) * F.G) * 8 + w_; \
            const int r_ = (int)HIST[32 + e_] + lr_; \
            F.STOK[e_ * T_ + r_] = tok_; F.SGATE[e_ * T_ + r_] = PK_G[tid_]; F.TOKE[tok_ * 4 + k_] = e_; F.TOKR[tok_ * 4 + k_] = r_; } \
        __syncthreads(); \
        if (tid_ < 32) HIST[tid_] = 0u; } while (0)
    f32x2 rwr[3][16];
    { const int e0 = lane0 & 31, hf0 = lane0 >> 5; const float* rwp0 = F.rw + (size_t)(F.wave * 256 + hf0 * 128) * 32 + e0;
#pragma unroll
      for (int c = 0; c < 3; ++c)
#pragma unroll
          for (int i = 0; i < 16; ++i) { rwr[c][i].x = rwp0[(c * 32 + 2 * i) * 32]; rwr[c][i].y = rwp0[(c * 32 + 2 * i + 1) * 32]; } }
    f32x4 xa[8]; v2u mb[8];
    {
        const int tok0 = F.bx * 8 + F.wave;
#pragma unroll
        for (int j = 0; j < 8; ++j) { xa[j] = *(const GAS f32x4*)(F.x + (size_t)tok0 * D_ + j * 256 + lane0 * 4); mb[j] = *(const GAS v2u*)((const bf16*)F.MIX + (size_t)tok0 * D_ + j * 256 + lane0 * 4); }
    }
    for (int task = F.bx; task < T_ / 8; task += F.G) {
        int lane = lane0; asm volatile("" : "+v"(lane));
        const int tok = task * 8 + F.wave;
        {
            float v[32]; float s = 0.f;
#pragma unroll
            for (int j = 0; j < 8; ++j) { const f32x4 a = xa[j]; const v2u bw = mb[j];
                const f32x4 b = (f32x4){bflo(bw.x), bfhi(bw.x), bflo(bw.y), bfhi(bw.y)};
                v[4 * j] = ALPHA * a.x + b.x; v[4 * j + 1] = ALPHA * a.y + b.y; v[4 * j + 2] = ALPHA * a.z + b.z; v[4 * j + 3] = ALPHA * a.w + b.w;
                s += (v[4 * j] + v[4 * j + 1]) + (v[4 * j + 2] + v[4 * j + 3]); }
            if (task + F.G < T_ / 8) {
                const int tokn = (task + F.G) * 8 + F.wave;
#pragma unroll
                for (int j = 0; j < 8; ++j) { xa[j] = *(const GAS f32x4*)(F.x + (size_t)tokn * D_ + j * 256 + lane * 4); mb[j] = *(const GAS v2u*)((const bf16*)F.MIX + (size_t)tokn * D_ + j * 256 + lane * 4); }
            }
            const float mu = wave_sum(s) * (1.0f / D_); float q = 0.f;
#pragma unroll
            for (int j = 0; j < 32; ++j) { v[j] -= mu; q += v[j] * v[j]; }
            const float rstd = 1.0f / sqrtf(wave_sum(q) * (1.0f / D_) + 1e-5f);
#pragma unroll
            for (int j = 0; j < 8; ++j) { const int c = j * 256 + lane * 4;
                const f32x4 g = *(const GAS f32x4*)(F.ln1g + c), be = *(const GAS f32x4*)(F.ln1b + c);
                const f32x4 hv = (f32x4){v[4 * j] * rstd * g.x + be.x, v[4 * j + 1] * rstd * g.y + be.y, v[4 * j + 2] * rstd * g.z + be.z, v[4 * j + 3] * rstd * g.w + be.w};
                v2u w; w.x = pk2(hv.x, hv.y); w.y = pk2(hv.z, hv.w);
                *(GAS v2u*)(F.HB + (size_t)tok * D_ + c) = w;
                { int w8 = __builtin_amdgcn_cvt_pk_fp8_f32(hv.x, hv.y, 0, false); w8 = __builtin_amdgcn_cvt_pk_fp8_f32(hv.z, hv.w, w8, true); *(GAS int*)(F.HB8 + (size_t)tok * D_ + c) = w8; }
                *(LAS f32x4*)(HT + F.wave * 2048 + c) = hv; }
        }
        __syncthreads();
        const int e = lane & 31, hf = lane >> 5, k0 = F.wave * 256 + hf * 128;
        f32x2 acc2[8];
#pragma unroll
        for (int t = 0; t < 8; ++t) acc2[t] = (f32x2){0.f, 0.f};
        const float* rwp = F.rw + (size_t)k0 * 32 + e;
        f32x2 rc[16];
#define RT_LOAD(dst, c) _Pragma("unroll") for (int i = 0; i < 16; ++i) { dst[i].x = rwp[((c) * 32 + 2 * i) * 32]; dst[i].y = rwp[((c) * 32 + 2 * i + 1) * 32]; }
#define RT_COMP(src, c) _Pragma("unroll") for (int i4 = 0; i4 < 8; ++i4) { _Pragma("unroll") for (int t = 0; t < 8; ++t) { const f32x4 hv = *(const LAS f32x4*)(HT + t * 2048 + k0 + (c) * 32 + i4 * 4); \
            acc2[t] = __builtin_elementwise_fma((f32x2){hv.x, hv.y}, src[i4 * 2], acc2[t]); acc2[t] = __builtin_elementwise_fma((f32x2){hv.z, hv.w}, src[i4 * 2 + 1], acc2[t]); } \
            asm volatile("" : "+v"(acc2[0]), "+v"(acc2[1]), "+v"(acc2[2]), "+v"(acc2[3]), "+v"(acc2[4]), "+v"(acc2[5]), "+v"(acc2[6]), "+v"(acc2[7]) :: "memory"); }
        RT_LOAD(rc, 3) RT_COMP(rwr[0], 0) RT_COMP(rwr[1], 1) RT_COMP(rwr[2], 2) RT_COMP(rc, 3)
#undef RT_LOAD
#undef RT_COMP
        float acc[8];
#pragma unroll
        for (int t = 0; t < 8; ++t) { acc[t] = acc2[t].x + acc2[t].y; acc[t] += __shfl_xor(acc[t], 32); if (hf == 0) PART[(F.wave * 8 + t) * 32 + e] = acc[t]; }
        __syncthreads();
        float mine = F.rb[e];
#pragma unroll
        for (int sl = 0; sl < 8; ++sl) mine += PART[(sl * 8 + F.wave) * 32 + e];
        float tv[4]; int ti[4]; float cur = mine;
#pragma unroll
        for (int k = 0; k < 4; ++k) {
            float bv = cur; int bi = e;
#pragma unroll
            for (int o = 1; o < 32; o <<= 1) { const float ov = __shfl_xor(bv, o); const int oi = __shfl_xor(bi, o); if (ov > bv || (ov == bv && oi < bi)) { bv = ov; bi = oi; } }
            tv[k] = bv; ti[k] = bi;
            if (e == bi) cur = -INFINITY;
        }
        float ex[4], se = 0.f;
#pragma unroll
        for (int k = 0; k < 4; ++k) { ex[k] = __expf(tv[k] - tv[0]); se += ex[k]; }
        if (lane == 0) {
#pragma unroll
            for (int k = 0; k < 4; ++k) { PK_E[(it * 8 + F.wave) * 4 + k] = ti[k]; PK_G[(it * 8 + F.wave) * 4 + k] = ex[k] / se; }
        }
        __syncthreads();
        ++it; ntok += 8;
        if (it == 4) { LN1_FLUSH(); itbase += 4; it = 0; ntok = 0; }
    }
    if (it > 0) LN1_FLUSH();
#undef LN1_FLUSH
}

__device__ __forceinline__ void build_ts(Frame& F) {
    LAS int* ts = (LAS int*)(F.lds + TS_OFF);
    const int tid = F.wave * 64 + pg8::fresh_lane();
    if (tid < 64) {
        const int e = tid & 31;
        const int c = (int)__hip_atomic_load(F.ctl + F.cntoff + 64 * e, RLX_AGENT);
        int incl = (c + 255) >> 8;
#pragma unroll
        for (int o = 1; o < 32; o <<= 1) { const int v = __shfl_up(incl, o, 32); if ((tid & 31) >= o) incl += v; }
        const int te = (c + 255) >> 8; int inf = te > 0 ? 1 : 0, inr = te > 0 ? te - 1 : 0;
#pragma unroll
        for (int o = 1; o < 32; o <<= 1) { const int v1 = __shfl_up(inf, o, 32), v2 = __shfl_up(inr, o, 32); if ((tid & 31) >= o) { inf += v1; inr += v2; } }
        if (tid < 32) { ts[e + 1] = incl; ts[40 + e] = c; ts[80 + e + 1] = inf; ts[120 + e + 1] = inr; if (e == 0) { ts[0] = 0; ts[80] = 0; ts[120] = 0; } }
    }
    __syncthreads();
}
template <int NN, bool GATHER> struct MoeOrder {
    const LAS int* ts; LAS unsigned char* tokbuf; const int* stok; const bf16* Bt; int G, c, nrowsB; const float* Wf;
    int tpo, lm0;
    unsigned* xs;
    int mode;
    int brow;
    __device__ __forceinline__ bool next(int i, pg8::Unit& u) const {
        const LAS int* tp = ts + tpo;
        const int TM = tp[32], nwg = TM * NN, full = (nwg / G) * G, rem = nwg - full; const bool use_half = rem > 0 && 2 * rem <= G;
        long L = (long)i * G + c; int hn = 0;
        if (mode == 2) { if (!use_half || L >= 2 * rem) return false; hn = (int)(L & 1); L = full + (L >> 1); }
        else if (L >= ((mode == 1 && use_half) ? full : nwg)) return false;
        int w = pg8::xcd_remap((int)L, nwg);
#if defined(PROBE_SCRAMBLE)
        if (mode == 0) w = (int)(((long)w * 37) % nwg);
#endif
        int e = 0;
        for (int k = 0; k < 31; ++k) { if (w >= tp[k + 1] * NN) e = k + 1; }
#if defined(ORDER_PN_FAST)
        const int te = tp[e + 1] - tp[e], r = w - tp[e] * NN, lm = lm0 + r / NN;
        u.e = __builtin_amdgcn_readfirstlane(e); u.pn = __builtin_amdgcn_readfirstlane(r % NN); u.lm = __builtin_amdgcn_readfirstlane(lm);
#else
        const int te = tp[e + 1] - tp[e], r = w - tp[e] * NN, lm = lm0 + r % te;
        u.e = __builtin_amdgcn_readfirstlane(e); u.pn = __builtin_amdgcn_readfirstlane(r / te); u.lm = __builtin_amdgcn_readfirstlane(lm);
#endif
        u.pm = __builtin_amdgcn_readfirstlane(ts[e] + lm); u.aux = __builtin_amdgcn_readfirstlane(ts[40 + e]); u.hn = __builtin_amdgcn_readfirstlane(hn); return true;
    }
    __device__ __forceinline__ void round_sync(int ui, int wid, int lane) const {
        if (!xs) return;
        const LAS int* tp = ts + tpo; const int nwg = tp[32] * NN, full = nwg / G, rem = nwg - full * G; const bool use_half = rem > 0 && 2 * rem <= G;
        const int nfull = (mode == 1 && !use_half && rem > 0) ? full : ((mode == 0 && rem > 0) ? full : full);
        if (ui >= nfull || (G & 7)) return;
        if (wid == 0 && lane == 0) {
            unsigned* w = xs + 64 * (c & 7); const unsigned want = (unsigned)(G >> 3) * (unsigned)ui;
            __hip_atomic_fetch_add(w, 1u, RLX_AGENT);
            unsigned sp = 0; while (__hip_atomic_load(w, RLX_AGENT) < want) { __builtin_amdgcn_s_sleep(1); if (++sp > (1u << 16)) break; }
        }
        __builtin_amdgcn_s_barrier();
    }
    __device__ __forceinline__ const char* wbbase(const pg8::Unit& u) const { return (const char*)Bt + ((size_t)u.e * nrowsB + (size_t)u.pn * 256) * 2048 * 2; }
    __device__ __forceinline__ int arow0(const pg8::Unit& u, int r) const {
        if (!GATHER) return u.pm * 256 + r;
        int rr = u.lm * 256 + r; rr = rr < u.aux ? rr : u.aux - 1; return stok[u.e * T_ + rr];
    }
    __device__ __forceinline__ void prefetch(const pg8::Unit& nx, int par, LAS unsigned char*, int wid, int lane) const {
        if (!GATHER) return;
        const int idx = (wid & 3) * 64 + pg8::fresh_lane();
        int rr = nx.lm * 256 + idx; rr = rr < nx.aux ? rr : nx.aux - 1;
        __builtin_amdgcn_global_load_lds((const unsigned*)(stok + nx.e * T_ + rr), (LAS unsigned*)(tokbuf + par * 1024 + (wid & 3) * 256), 4, 0, 0);
    }
    __device__ __forceinline__ int arow1(const pg8::Unit& u, int r, int par, LAS unsigned char*) const {
        if (!GATHER) return u.pm * 256 + r;
        return *(const LAS int*)(tokbuf + par * 1024 + r * 4);
    }
    __device__ __forceinline__ const char* bbase(const pg8::Unit& u) const {
        if (Wf) return (const char*)Wf + ((size_t)u.e * 2048 * nrowsB + (size_t)u.pn * 256 + (size_t)u.hn * 128) * 4;
        return (const char*)Bt + ((size_t)u.e * nrowsB + (size_t)u.pn * 256 + (size_t)u.hn * 128) * (size_t)brow; }
};

__device__ __forceinline__ void combine_ln2(Frame& F) {
    const LAS int* ts = (const LAS int*)(F.lds + TS_OFF);
    const int gw = F.bx * NWAVES + F.wave, NGW = F.G * NWAVES, lane = pg8::fresh_lane();
    for (int tok = gw; tok < T_; tok += NGW) {
        const bf16* p[4];
#pragma unroll
        for (int k = 0; k < 4; ++k) { const int e = F.TOKE[tok * 4 + k], r = F.TOKR[tok * 4 + k]; p[k] = F.OUTS + (size_t)(ts[e] * 256 + r) * D_; }
        float v[32]; float s = 0.f;
#pragma unroll
        for (int j = 0; j < 8; ++j) { const int c = j * 256 + lane * 4;
            const v2u hw = *(const GAS v2u*)(F.HB + (size_t)tok * D_ + c);
            const f32x4 hh = (f32x4){bflo(hw.x), bfhi(hw.x), bflo(hw.y), bfhi(hw.y)};
            float y[4] = {0.f, 0.f, 0.f, 0.f};
#pragma unroll
            for (int k = 0; k < 4; ++k) { const v2u w = *(const GAS v2u*)(p[k] + c); y[0] += bflo(w.x); y[1] += bfhi(w.x); y[2] += bflo(w.y); y[3] += bfhi(w.y); }
            v[4 * j] = ALPHA * hh.x + y[0]; v[4 * j + 1] = ALPHA * hh.y + y[1]; v[4 * j + 2] = ALPHA * hh.z + y[2]; v[4 * j + 3] = ALPHA * hh.w + y[3];
            s += (v[4 * j] + v[4 * j + 1]) + (v[4 * j + 2] + v[4 * j + 3]); }
        const float mu = wave_sum(s) * (1.0f / D_); float q = 0.f;
#pragma unroll
        for (int j = 0; j < 32; ++j) { v[j] -= mu; q += v[j] * v[j]; }
        const float rstd = 1.0f / sqrtf(wave_sum(q) * (1.0f / D_) + 1e-5f);
#pragma unroll
        for (int j = 0; j < 8; ++j) { const int c = j * 256 + lane * 4;
            const f32x4 g = *(const GAS f32x4*)(F.ln2g + c), be = *(const GAS f32x4*)(F.ln2b + c);
            *(GAS f32x4*)(F.out + (size_t)tok * D_ + c) = (f32x4){v[4 * j] * rstd * g.x + be.x, v[4 * j + 1] * rstd * g.y + be.y, v[4 * j + 2] * rstd * g.z + be.z, v[4 * j + 3] * rstd * g.w + be.w}; }
    }
}

constexpr int N_PHASES = 9;
struct Args { const float* in[16]; float* out; unsigned char* ws; int ph_lo, ph_hi, bar_region, pad; };
__global__ void __launch_bounds__(NTHR, 2) mega_fwd(Args args) {
    extern __shared__ __attribute__((aligned(16))) unsigned char lds_raw[];
    Frame F;
    F.lds = (LAS unsigned char*)lds_raw;
    F.wave = __builtin_amdgcn_readfirstlane(threadIdx.x >> 6); F.G = gridDim.x; F.bx = blockIdx.x;
    unsigned char* ws = args.ws;
    F.ctl = (unsigned*)(ws + WS_CTL);
    F.x = args.in[0]; F.w_in = args.in[1]; F.gn_gain = args.in[2]; F.pool_w = args.in[3]; F.pool_scale = args.in[4]; F.w_out = args.in[5];
    F.ln1g = args.in[6]; F.ln1b = args.in[7]; F.rw = args.in[8]; F.rb = args.in[9]; F.wgu = args.in[10]; F.bgu = args.in[11];
    F.wd = args.in[12]; F.bd = args.in[13]; F.ln2g = args.in[14]; F.ln2b = args.in[15]; F.out = args.out;
    F.WinT = (bf16*)(ws + WS_WIN_T); F.WoutT = (bf16*)(ws + WS_WOUT_T); F.PoolT = (bf16*)(ws + WS_POOLW_T); F.XB = (bf16*)(ws + WS_XB);
    F.PROJB = (bf16*)(ws + WS_PROJB); F.PB = (bf16*)(ws + WS_PB); F.MIXEDB = (bf16*)(ws + WS_MIXEDB); F.HB = (bf16*)(ws + WS_HB);
    F.ACTB = (bf16*)(ws + WS_ACTB); F.OUTS = (bf16*)(ws + WS_OUTS); F.WguT = (bf16*)(ws + WS_WGU_T); F.WdT = (bf16*)(ws + WS_WD_T);
    F.ROPE = (float*)(ws + WS_ROPE); F.KVT = (float*)(ws + WS_KVT); F.MIX = (float*)(ws + WS_MIX); F.H = (float*)(ws + WS_H); F.SGATE = (float*)(ws + WS_SGATE);
    F.HB8 = ws + WS_HB8; F.ACT8 = ws + WS_ACT8; F.Wgu8 = ws + WS_WGU8; F.Wd8 = ws + WS_WD8;
    F.STOK = (int*)(ws + WS_STOK); F.TOKE = (int*)(ws + WS_TOKE); F.TOKR = (int*)(ws + WS_TOKR);
    for (int u = F.wave * 64 + pg8::fresh_lane(); u < (LDS_BYTES - LDSCTL_OFF) / 4; u += NTHR) ((LAS unsigned*)(F.lds + LDSCTL_OFF))[u] = 0u;
    __syncthreads();
    const int lo = args.ph_lo, hi = args.ph_hi;
    XcdBarrier bar; bar.bar = F.ctl + CW_BAR + args.bar_region * XCD_BAR_WORDS; bar.x = 0; bar.st = nullptr; bar.wave = F.wave;
    if (hi - lo > 1) bar = xcd_barrier_post(F.ctl + CW_BAR + args.bar_region * XCD_BAR_WORDS, (volatile LAS unsigned*)(F.lds + MISC_OFF) + 8);
#define IN(k) (lo <= (k) && (k) < hi)
#define SEAM(k) do { if (IN(k) && IN((k) + 1)) xcd_barrier(bar); } while (0)
    LAS unsigned char* ring = F.lds;
#if defined(XCD_ROUND_SYNC)
    unsigned* const XS6 = F.ctl + CW_XSYNC; unsigned* const XS7 = F.ctl + CW_XSYNC + 8 * 64;
#else
    unsigned* const XS6 = nullptr; unsigned* const XS7 = nullptr;
#endif
#define REMAP_BX() do { if (hi - lo > 1) { volatile LAS unsigned* ms = (volatile LAS unsigned*)(F.lds + MISC_OFF) + 8; \
        if (threadIdx.x == 0) { bool ok = (F.G % 8) == 0; for (unsigned j = 0; j < 8; ++j) ok = ok && (xb_ld(&bar.bar[XB_XCNT(j)]) == (unsigned)F.G / 8u); ms[3] = ok ? ms[2] * 8u + bar.x : (unsigned)blockIdx.x; } \
        __syncthreads(); F.bx = __builtin_amdgcn_readfirstlane((int)ms[3]); } } while (0)

#ifndef PROBE_REP
#define PROBE_REP -1
#endif
#define REP(k) if ((k) == PROBE_REP)
    if (IN(0)) { p0_prologue(F);
#if defined(MOE_F8DMA)
        { const int lane0 = pg8::fresh_lane(); p0_cvt8_experts(F.wgu, F.Wgu8, 2 * FF, F.bx, F.G, F.wave, lane0); p0_cvt8_experts(F.wd, F.Wd8, D_, F.bx, F.G, F.wave, lane0); }
#endif
    }
    if (IN(0)) REP(0) { p0_prologue(F); } SEAM(0);
    if (IN(0) && IN(1)) REMAP_BX();
    if (IN(1)) {
#if defined(P1_F32B)
        pg8::DenseOrder S; S.init(T_, INW, F.G, F.bx, F.WinT, D_, F.w_in); pg8::EpiBf16 E{F.PROJB, INW, 0, nullptr};
        pg8::gemm_phase_f32b<pg8::EpiBf16, pg8::DenseOrder, false>(ring, F.wave, F.XB, D_, D_, INW, S, E);
#else
        pg8::DenseOrder S; S.init(T_, INW, F.G, F.bx, F.WinT, D_, nullptr, 1); pg8::EpiBf16 E{F.PROJB, INW, 0, nullptr};
        pg8::gemm_phase<pg8::EpiBf16, pg8::DenseOrder>(ring, F.wave, F.XB, D_, 0, D_, S, E);
        pg8::DenseOrder S2; S2.init(T_, INW, F.G, F.bx, F.WinT, D_, nullptr, 2);
        pg8::gemm_phase_half<pg8::EpiBf16, pg8::DenseOrder>(ring, F.wave, F.XB, D_, 0, D_, S2, E);
#endif
        { const int nunits = (T_ / 256) * (INW / 256), rem = nunits % F.G;
          if (rem == 0 || 2 * rem <= F.G) { const int busy = 2 * rem; if (busy >= F.G) p0_late(F, F.bx, F.G); else if (F.bx >= busy) p0_late(F, F.bx - busy, F.G - busy); }
          else if (F.bx >= rem) p0_late(F, F.bx - rem, F.G - rem); }
    }
    if (IN(1)) REP(1) {
#if defined(P1_F32B)
        pg8::DenseOrder S; S.init(T_, INW, F.G, F.bx, F.WinT, D_, F.w_in); pg8::EpiBf16 E{F.PROJB, INW, 0, nullptr};
        pg8::gemm_phase_f32b<pg8::EpiBf16, pg8::DenseOrder, false>(ring, F.wave, F.XB, D_, D_, INW, S, E);
#else
        pg8::DenseOrder S; S.init(T_, INW, F.G, F.bx, F.WinT, D_, nullptr, 1); pg8::EpiBf16 E{F.PROJB, INW, 0, nullptr};
        pg8::gemm_phase<pg8::EpiBf16, pg8::DenseOrder>(ring, F.wave, F.XB, D_, 0, D_, S, E);
        pg8::DenseOrder S2; S2.init(T_, INW, F.G, F.bx, F.WinT, D_, nullptr, 2);
        pg8::gemm_phase_half<pg8::EpiBf16, pg8::DenseOrder>(ring, F.wave, F.XB, D_, 0, D_, S2, E);
#endif
        { const int nunits = (T_ / 256) * (INW / 256), rem = nunits % F.G;
          if (rem == 0 || 2 * rem <= F.G) { const int busy = 2 * rem; if (busy >= F.G) p0_late(F, F.bx, F.G); else if (F.bx >= busy) p0_late(F, F.bx - busy, F.G - busy); }
          else if (F.bx >= rem) p0_late(F, F.bx - rem, F.G - rem); }
    } SEAM(1);
    if (IN(2)) { for (int u = F.bx; u < 512; u += F.G) r1_unit(F, u); pool_means(F); }
    if (IN(2)) REP(2) { for (int u = F.bx; u < 512; u += F.G) r1_unit(F, u); pool_means(F); } SEAM(2);
    if (IN(3)) {
        for (int u = F.bx, jj = 0; u < 512; u += F.G, ++jj) r3_unit(F, ((jj & 1) && !(F.G & 15)) ? ((u & ~15) | (15 - (u & 15))) : u);
        PoolOrder S{F.G, F.bx, F.PoolT}; EpiPool E{F.MIXEDB, F.pool_scale};
        pg8::gemm_phase<EpiPool, PoolOrder>(ring, F.wave, F.PB, 256, 0, 256, S, E);
    }
    if (IN(3)) REP(3) {
        for (int u = F.bx, jj = 0; u < 512; u += F.G, ++jj) r3_unit(F, ((jj & 1) && !(F.G & 15)) ? ((u & ~15) | (15 - (u & 15))) : u);
        PoolOrder S{F.G, F.bx, F.PoolT}; EpiPool E{F.MIXEDB, F.pool_scale};
        pg8::gemm_phase<EpiPool, PoolOrder>(ring, F.wave, F.PB, 256, 0, 256, S, E);
    } SEAM(3);
    if (IN(4)) {
        pg8::DenseOrder S; S.init(T_, D_, F.G, F.bx, F.WoutT, D_); pg8::EpiBf16 E{(bf16*)F.MIX, D_, 0, nullptr};
        pg8::gemm_phase<pg8::EpiBf16, pg8::DenseOrder>(ring, F.wave, F.MIXEDB, D_, 0, D_, S, E);
    }
    if (IN(4)) REP(4) {
        pg8::DenseOrder S; S.init(T_, D_, F.G, F.bx, F.WoutT, D_); pg8::EpiBf16 E{(bf16*)F.MIX, D_, 0, nullptr};
        pg8::gemm_phase<pg8::EpiBf16, pg8::DenseOrder>(ring, F.wave, F.MIXEDB, D_, 0, D_, S, E);
    } SEAM(4);
    F.cntoff = CW_CNT;
    if (IN(5)) REP(5) { ln1_router(F); xcd_barrier(bar); F.cntoff = CW_CNT + 32; }
    if (IN(5)) { ln1_router(F); } SEAM(5);
    if (IN(6)) {
        build_ts(F);
#if defined(MOE_F8DMA)
#if defined(F8D_PIPE)
        MoeOrder<16, true> S{(const LAS int*)(F.lds + TS_OFF), F.lds + TOKBUF_OFF, F.STOK, (const bf16*)F.Wgu8, F.G, F.bx, 2 * FF, nullptr, 0, 0, nullptr, 0, D_};
        pg8::EpiSwiglu8 E{F.ACT8, F.bgu, 1.0f / 64.0f, F.lds};
        pg8::gemm_phase_f8d<pg8::EpiSwiglu8, MoeOrder<16, true>>(ring, F.wave, F.HB8, D_, S, E);
#else
        MoeOrder<16, true> S{(const LAS int*)(F.lds + TS_OFF), F.lds + TOKBUF_OFF, F.STOK, (const bf16*)F.Wgu8, F.G, F.bx, 2 * FF, nullptr, 0, 0, nullptr, 1, D_};
        pg8::EpiSwiglu8 E{F.ACT8, F.bgu, 1.0f / 64.0f, F.lds};
        pg8::gemm_phase<pg8::EpiSwiglu8, MoeOrder<16, true>, true, true>(ring, F.wave, (const bf16*)F.HB8, D_ / 2, 0, D_ / 2, S, E);
        MoeOrder<16, true> S2{(const LAS int*)(F.lds + TS_OFF), F.lds + TOKBUF_OFF, F.STOK, (const bf16*)F.Wgu8, F.G, F.bx, 2 * FF, nullptr, 0, 0, nullptr, 2, D_};
        pg8::gemm_phase_half<pg8::EpiSwiglu8, MoeOrder<16, true>, true>(ring, F.wave, (const bf16*)F.HB8, D_ / 2, 0, D_ / 2, S2, E);
#endif
#elif defined(MOE_FP8)
        MoeOrder<16, true> S{(const LAS int*)(F.lds + TS_OFF), F.lds + TOKBUF_OFF, F.STOK, F.WguT, F.G, F.bx, 2 * FF, F.wgu, 0, 0, nullptr, 1};
        pg8::EpiSwiglu8 E{F.ACT8, F.bgu, 1.0f / 64.0f, F.lds};
        pg8::gemm_phase_f8<pg8::EpiSwiglu8, MoeOrder<16, true>>(ring, F.wave, F.HB8, D_, 2 * FF, 64.0f, S, E);
        MoeOrder<16, true> S2{(const LAS int*)(F.lds + TS_OFF), F.lds + TOKBUF_OFF, F.STOK, F.WguT, F.G, F.bx, 2 * FF, F.wgu, 0, 0, nullptr, 2};
        pg8::gemm_phase_f8_half<pg8::EpiSwiglu8, MoeOrder<16, true>>(ring, F.wave, F.HB8, D_, 2 * FF, 64.0f, S2, E);
#else
        MoeOrder<16, true> S{(const LAS int*)(F.lds + TS_OFF), F.lds + TOKBUF_OFF, F.STOK, F.WguT, F.G, F.bx, 2 * FF, F.wgu, 0, 0, XS6, 1};
        pg8::EpiSwiglu E{F.ACTB, F.bgu};
        pg8::gemm_phase_f32b<pg8::EpiSwiglu, MoeOrder<16, true>, false>(ring, F.wave, F.HB, D_, D_, 2 * FF, S, E);
        MoeOrder<16, true> S2{(const LAS int*)(F.lds + TS_OFF), F.lds + TOKBUF_OFF, F.STOK, F.WguT, F.G, F.bx, 2 * FF, F.wgu, 0, 0, nullptr, 2};
        pg8::gemm_phase_f32b_half<pg8::EpiSwiglu, MoeOrder<16, true>>(ring, F.wave, F.HB, D_, D_, 2 * FF, S2, E);
#endif
    }
#ifndef PROBE_ABL
#define PROBE_ABL 0
#endif
    if (IN(6)) REP(6) {
        build_ts(F);
        MoeOrder<16, true> S{(const LAS int*)(F.lds + TS_OFF), F.lds + TOKBUF_OFF, F.STOK, F.WguT, F.G, F.bx, 2 * FF, F.wgu, 0, 0, nullptr, 0};
#ifndef PROBE_EPI
#define PROBE_EPI 0
#endif
        pg8::EpiSwigluT<PROBE_EPI> E{F.OUTS, F.bgu};
        pg8::gemm_phase_f32b<pg8::EpiSwigluT<PROBE_EPI>, MoeOrder<16, true>, false, PROBE_ABL>(ring, F.wave, F.HB, D_, D_, 2 * FF, S, E);
    } SEAM(6);
    if (IN(7)) {
        build_ts(F);
#if defined(MOE_F8DMA)
#if defined(F8D_PIPE)
        MoeOrder<8, false> S{(const LAS int*)(F.lds + TS_OFF), F.lds + TOKBUF_OFF, F.STOK, (const bf16*)F.Wd8, F.G, F.bx, D_, nullptr, 0, 0, nullptr, 0, FF};
        pg8::EpiDown8 E{F.OUTS, F.bd, F.SGATE, 1.0f / 64.0f, F.lds};
        pg8::gemm_phase_f8d<pg8::EpiDown8, MoeOrder<8, false>>(ring, F.wave, F.ACT8, FF, S, E);
#else
        MoeOrder<8, false> S{(const LAS int*)(F.lds + TS_OFF), F.lds + TOKBUF_OFF, F.STOK, (const bf16*)F.Wd8, F.G, F.bx, D_, nullptr, 0, 0, nullptr, 1, FF};
        pg8::EpiDown8 E{F.OUTS, F.bd, F.SGATE, 1.0f / 64.0f, F.lds};
        pg8::gemm_phase<pg8::EpiDown8, MoeOrder<8, false>, true, true>(ring, F.wave, (const bf16*)F.ACT8, FF / 2, 0, FF / 2, S, E);
        MoeOrder<8, false> S2{(const LAS int*)(F.lds + TS_OFF), F.lds + TOKBUF_OFF, F.STOK, (const bf16*)F.Wd8, F.G, F.bx, D_, nullptr, 0, 0, nullptr, 2, FF};
        pg8::gemm_phase_half<pg8::EpiDown8, MoeOrder<8, false>, true>(ring, F.wave, (const bf16*)F.ACT8, FF / 2, 0, FF / 2, S2, E);
#endif
#elif defined(MOE_FP8)
        MoeOrder<8, false> S{(const LAS int*)(F.lds + TS_OFF), F.lds + TOKBUF_OFF, F.STOK, F.WdT, F.G, F.bx, D_, F.wd, 0, 0, nullptr, 1};
        pg8::EpiDown8 E{F.OUTS, F.bd, F.SGATE, 1.0f / 64.0f, F.lds};
        pg8::gemm_phase_f8<pg8::EpiDown8, MoeOrder<8, false>>(ring, F.wave, F.ACT8, FF, D_, 64.0f, S, E);
        MoeOrder<8, false> S2{(const LAS int*)(F.lds + TS_OFF), F.lds + TOKBUF_OFF, F.STOK, F.WdT, F.G, F.bx, D_, F.wd, 0, 0, nullptr, 2};
        pg8::gemm_phase_f8_half<pg8::EpiDown8, MoeOrder<8, false>>(ring, F.wave, F.ACT8, FF, D_, 64.0f, S2, E);
#else
        MoeOrder<8, false> S{(const LAS int*)(F.lds + TS_OFF), F.lds + TOKBUF_OFF, F.STOK, F.WdT, F.G, F.bx, D_, F.wd, 0, 0, XS7, 1};
        pg8::EpiDown E{F.OUTS, F.bd, F.SGATE};
        pg8::gemm_phase_f32b<pg8::EpiDown, MoeOrder<8, false>, false>(ring, F.wave, F.ACTB, FF, FF, D_, S, E);
        MoeOrder<8, false> S2{(const LAS int*)(F.lds + TS_OFF), F.lds + TOKBUF_OFF, F.STOK, F.WdT, F.G, F.bx, D_, F.wd, 0, 0, nullptr, 2};
        pg8::gemm_phase_f32b_half<pg8::EpiDown, MoeOrder<8, false>>(ring, F.wave, F.ACTB, FF, FF, D_, S2, E);
#endif
    }
    if (IN(7)) REP(7) {
        build_ts(F);
        MoeOrder<8, false> S{(const LAS int*)(F.lds + TS_OFF), F.lds + TOKBUF_OFF, F.STOK, F.WdT, F.G, F.bx, D_, F.wd, 0, 0, nullptr, 0};
        pg8::EpiDown E{F.OUTS, F.bd, F.SGATE};
        pg8::gemm_phase_f32b<pg8::EpiDown, MoeOrder<8, false>, false>(ring, F.wave, F.ACTB, FF, FF, D_, S, E);
    } SEAM(7);
    if (IN(8)) { build_ts(F); combine_ln2(F); }
    if (IN(8)) REP(8) { build_ts(F); combine_ln2(F); }
#undef IN
#undef SEAM
}

static int g_grid = 0;
static bool setup() {
    if (g_grid) return g_grid > 0;
    int dev = 0, cus = 0, per_cu = 0;
    if (hipGetDevice(&dev) != hipSuccess || hipDeviceGetAttribute(&cus, hipDeviceAttributeMultiprocessorCount, dev) != hipSuccess) { g_grid = -1; return false; }
    if (hipFuncSetAttribute((const void*)mega_fwd, hipFuncAttributeMaxDynamicSharedMemorySize, LDS_BYTES) != hipSuccess) { fprintf(stderr, "hipFuncSetAttribute failed\n"); g_grid = -1; return false; }
    if (hipOccupancyMaxActiveBlocksPerMultiprocessor(&per_cu, (const void*)mega_fwd, NTHR, LDS_BYTES) != hipSuccess || per_cu < 1) fprintf(stderr, "occupancy query: %d per CU\n", per_cu);
    (void)hipGetLastError();
    g_grid = cus;
    return true;
}
static void launch(void* const* d_in, float* out, unsigned char* ws, hipStream_t st, int lo, int hi, int region) {
    Args a{};
    for (int i = 0; i < 16; ++i) a.in[i] = (const float*)d_in[i];
    a.out = out; a.ws = ws; a.ph_lo = lo; a.ph_hi = hi; a.bar_region = region; a.pad = 0;
    hipLaunchKernelGGL(mega_fwd, dim3(g_grid), dim3(NTHR), LDS_BYTES, st, a);
}
}
extern "C" void kernel_launch(void* const* d_in, const int* in_sizes, int n_in, void* d_out, int out_size, void* d_ws, size_t ws_size, hipStream_t stream) {
    (void)in_sizes; (void)n_in; (void)out_size; (void)ws_size;
    unsigned char* ws = (unsigned char*)d_ws;
    if (!fk::setup()) return;
    (void)hipMemsetAsync(ws + fk::WS_CTL, 0, fk::CTL_ZERO_BYTES, stream);
    fk::launch(d_in, (float*)d_out, ws, stream, 0, fk::N_PHASES, 0);
}
```
